# Optimizing an MI355X kernel written in HIP

```python
import jax, jax.numpy as jnp
from jax import lax
import numpy as np

D_MODEL = 1024
BATCH = 4
SEQ = 4096
DEPTH = 1
DEC_BATCH = 128
DEC_SEQ = 8
PAST_LEN = 16384
PAGE_SIZE = 128

HEAD_DIM = 64
ATTN_WIDTH = D_MODEL // 2
N_HEADS = ATTN_WIDTH // HEAD_DIM
N_KV_HEADS = N_HEADS // 4
GROUP = N_HEADS // N_KV_HEADS
KV_WIDTH = N_KV_HEADS * HEAD_DIM
WINDOW = 128
BLOCK = WINDOW
POOL_WIDTH = D_MODEL - ATTN_WIDTH
POOL_WINDOWS = (2, 4, 8, 16)
N_POOL_GROUPS = len(POOL_WINDOWS)
POOL_GROUP_WIDTH = POOL_WIDTH // N_POOL_GROUPS
POOL_HIST = max(POOL_WINDOWS) - 1
IN_WIDTH = ATTN_WIDTH + 2 * KV_WIDTH + POOL_WIDTH
N_MEM = 256
N_CROSS_HEADS = 4
CROSS_HEAD_DIM = D_MODEL // N_CROSS_HEADS
D_FF = 4 * D_MODEL
RMS_EPS = 1e-5
NEG_INF = -1e30

kernel_name = 'hymba_swa_sink_pool_memxattn_step'


def _rmsnorm(x, g):
    xf = x.astype(jnp.float32)
    xf = xf * lax.rsqrt(jnp.mean(xf * xf, axis=-1, keepdims=True) + RMS_EPS)
    return (xf * g.astype(jnp.float32)).astype(x.dtype)


def _alibi_slopes():
    return 2.0 ** (-8.0 * jnp.arange(1, N_HEADS + 1, dtype=jnp.float32) / N_HEADS)


def _mixer_in(x, g_mix, w_in):
    B, L, _ = x.shape
    h = _rmsnorm(x, g_mix)
    proj = h @ w_in
    q = proj[..., :ATTN_WIDTH].reshape(B, L, N_KV_HEADS, GROUP, HEAD_DIM)
    k = proj[..., ATTN_WIDTH:ATTN_WIDTH + KV_WIDTH].reshape(B, L, N_KV_HEADS, HEAD_DIM)
    v = proj[..., ATTN_WIDTH + KV_WIDTH:ATTN_WIDTH + 2 * KV_WIDTH].reshape(B, L, N_KV_HEADS, HEAD_DIM)
    u = proj[..., ATTN_WIDTH + 2 * KV_WIDTH:]
    return q, k, v, u


def _window_probs(scores, qpos, kpos, sinks):
    dist = qpos[..., :, None] - kpos[..., None, :]
    valid = (dist >= 0) & (dist <= WINDOW) & (kpos[..., None, :] >= 0)
    dist = dist[..., None, None, :, :].astype(jnp.float32)
    valid = valid[..., None, None, :, :]
    slopes = _alibi_slopes().reshape(N_KV_HEADS, GROUP, 1, 1)
    logits = jnp.where(valid, scores - slopes * dist, NEG_INF)
    sink = jnp.broadcast_to(sinks.astype(jnp.float32).reshape(N_KV_HEADS, GROUP, 1, 1),
                            logits.shape[:-1] + (1,))
    p = jax.nn.softmax(jnp.concatenate([logits, sink], axis=-1), axis=-1)
    return p[..., :-1]


def _window_attn_prompt(q, k, v, sinks):
    B, S = q.shape[:2]
    nb = S // BLOCK
    qb = q.reshape(B, nb, BLOCK, N_KV_HEADS, GROUP, HEAD_DIM)
    kb = k.reshape(B, nb, BLOCK, N_KV_HEADS, HEAD_DIM)
    vb = v.reshape(B, nb, BLOCK, N_KV_HEADS, HEAD_DIM)
    pad = jnp.zeros_like(kb[:, :1])
    k2 = jnp.concatenate([jnp.concatenate([pad, kb[:, :-1]], axis=1), kb], axis=2)
    v2 = jnp.concatenate([jnp.concatenate([pad, vb[:, :-1]], axis=1), vb], axis=2)
    scores = jnp.einsum('bnqkgd,bnskd->bnkgqs', qb, k2).astype(jnp.float32) * (HEAD_DIM ** -0.5)
    blk = jnp.arange(nb, dtype=jnp.int32)[:, None] * BLOCK
    qpos = blk + jnp.arange(BLOCK, dtype=jnp.int32)[None, :]
    kpos = blk - BLOCK + jnp.arange(2 * BLOCK, dtype=jnp.int32)[None, :]
    p = _window_probs(scores, qpos, kpos, sinks)
    o = jnp.einsum('bnkgqs,bnskd->bnqkgd', p.astype(v.dtype), v2)
    return o.reshape(B, S, ATTN_WIDTH)


def _window_attn_sample(q, k, v, cache_k, cache_v, sinks):
    B, T = q.shape[:2]
    kc = jnp.concatenate([cache_k, k], axis=1)
    vc = jnp.concatenate([cache_v, v], axis=1)
    n_keys = kc.shape[1]
    scores = jnp.einsum('btkgd,bskd->bkgts', q, kc).astype(jnp.float32) * (HEAD_DIM ** -0.5)
    qpos = PAST_LEN + jnp.arange(T, dtype=jnp.int32)
    kpos = PAST_LEN - cache_k.shape[1] + jnp.arange(n_keys, dtype=jnp.int32)
    p = _window_probs(scores, qpos, kpos, sinks)
    o = jnp.einsum('bkgts,bskd->btkgd', p.astype(v.dtype), vc)
    return o.reshape(B, T, ATTN_WIDTH), kc[:, -WINDOW:], vc[:, -WINDOW:]


def _pool_mix(u, u_prev, start_pos, w_pool, pool_scale):
    B, L, _ = u.shape
    full = jnp.concatenate([u_prev, u], axis=1)
    cs = jnp.cumsum(full.astype(jnp.float32), axis=1)
    cs = jnp.pad(cs, ((0, 0), (1, 0), (0, 0)))
    hi = cs[:, POOL_HIST + 1:]
    pos = start_pos + jnp.arange(L, dtype=jnp.int32)
    means = []
    for g, w in enumerate(POOL_WINDOWS):
        ch = slice(g * POOL_GROUP_WIDTH, (g + 1) * POOL_GROUP_WIDTH)
        lo = cs[:, POOL_HIST + 1 - w:POOL_HIST + 1 - w + L, ch]
        cnt = jnp.minimum(pos + 1, w).astype(jnp.float32)[None, :, None]
        means.append((hi[..., ch] - lo) / cnt)
    d = (jnp.concatenate(means, axis=-1) - u.astype(jnp.float32)).astype(u.dtype)
    d = d.reshape(B, L, N_POOL_GROUPS, POOL_GROUP_WIDTH)
    y = jnp.einsum('blgc,gce->blge', d, w_pool).reshape(B, L, POOL_WIDTH)
    return y * pool_scale, full[:, -POOL_HIST:]


def _mem_kv(mem, g_mem, w_ck, w_cv):
    B = mem.shape[0]
    hm = _rmsnorm(mem, g_mem)
    k = (hm @ w_ck).reshape(B, N_MEM, N_CROSS_HEADS, CROSS_HEAD_DIM)
    v = (hm @ w_cv).reshape(B, N_MEM, N_CROSS_HEADS, CROSS_HEAD_DIM)
    return k, v


def _layer_tail(x, attn_o, pool_o, mem_k, mem_v, w_out, g_cross, w_cq, w_co, g_ffn, w_up, w_down):
    B, L, _ = x.shape
    x = x + jnp.concatenate([attn_o, pool_o], axis=-1) @ w_out
    h = _rmsnorm(x, g_cross)
    q = (h @ w_cq).reshape(B, L, N_CROSS_HEADS, CROSS_HEAD_DIM)
    s = jnp.einsum('blhd,bmhd->bhlm', q, mem_k).astype(jnp.float32) * (CROSS_HEAD_DIM ** -0.5)
    p = jax.nn.softmax(s, axis=-1)
    o = jnp.einsum('bhlm,bmhd->blhd', p.astype(mem_v.dtype), mem_v).reshape(B, L, D_MODEL)
    x = x + o @ w_co
    h = _rmsnorm(x, g_ffn)
    x = x + jnp.square(jax.nn.relu(h @ w_up)) @ w_down
    return x


def setup_inputs(seed: int = 0) -> dict:
    key = jax.random.key(seed)
    ks = jax.random.split(key, 26)
    f32 = jnp.float32

    def nrm(k, shape, scale=1.0):
        return jax.random.normal(k, shape, f32) * scale

    def gain(k, shape):
        return 1.0 + 0.05 * jax.random.normal(k, shape, f32)

    return {
        'x_prompt': nrm(ks[0], (BATCH, SEQ, D_MODEL)),
        'x_sample': nrm(ks[1], (DEC_BATCH, DEC_SEQ, D_MODEL)),
        'cache_win_k': nrm(ks[2], (DEPTH, DEC_BATCH, WINDOW, N_KV_HEADS, HEAD_DIM)),
        'cache_win_v': nrm(ks[3], (DEPTH, DEC_BATCH, WINDOW, N_KV_HEADS, HEAD_DIM)),
        'state_pool': nrm(ks[4], (DEPTH, DEC_BATCH, POOL_HIST, POOL_WIDTH)),
        'cache_mem_k': nrm(ks[5], (DEPTH, DEC_BATCH, N_MEM, N_CROSS_HEADS, CROSS_HEAD_DIM)),
        'cache_mem_v': nrm(ks[6], (DEPTH, DEC_BATCH, N_MEM, N_CROSS_HEADS, CROSS_HEAD_DIM)),
        'mem_prompt': nrm(ks[7], (BATCH, N_MEM, D_MODEL)),
        'g_mix': gain(ks[8], (DEPTH, D_MODEL)),
        'w_in': nrm(ks[9], (DEPTH, D_MODEL, IN_WIDTH), D_MODEL ** -0.5),
        'attn_sinks': nrm(ks[10], (DEPTH, N_HEADS)),
        'w_pool': nrm(ks[11], (DEPTH, N_POOL_GROUPS, POOL_GROUP_WIDTH, POOL_GROUP_WIDTH), POOL_GROUP_WIDTH ** -0.5),
        'pool_scale': gain(ks[12], (DEPTH, POOL_WIDTH)),
        'w_out': nrm(ks[13], (DEPTH, D_MODEL, D_MODEL), D_MODEL ** -0.5),
        'g_cross': gain(ks[14], (DEPTH, D_MODEL)),
        'g_mem': gain(ks[15], (DEPTH, D_MODEL)),
        'w_cq': nrm(ks[16], (DEPTH, D_MODEL, D_MODEL), D_MODEL ** -0.5),
        'w_ck': nrm(ks[17], (DEPTH, D_MODEL, D_MODEL), D_MODEL ** -0.5),
        'w_cv': nrm(ks[18], (DEPTH, D_MODEL, D_MODEL), D_MODEL ** -0.5),
        'w_co': nrm(ks[19], (DEPTH, D_MODEL, D_MODEL), D_MODEL ** -0.5),
        'g_ffn': gain(ks[20], (DEPTH, D_MODEL)),
        'w_up': nrm(ks[21], (DEPTH, D_MODEL, D_FF), D_MODEL ** -0.5),
        'w_down': nrm(ks[22], (DEPTH, D_FF, D_MODEL), D_FF ** -0.5),
        'g_final': gain(ks[23], (D_MODEL,)),
    }


def reference(x_prompt, x_sample, cache_win_k, cache_win_v, state_pool, cache_mem_k, cache_mem_v,
              mem_prompt, g_mix, w_in, attn_sinks, w_pool, pool_scale, w_out, g_cross, g_mem,
              w_cq, w_ck, w_cv, w_co, g_ffn, w_up, w_down, g_final):
    xp, xs = x_prompt, x_sample
    wk_p, wv_p, pool_p, mk_p, mv_p = [], [], [], [], []
    wk_s, wv_s, pool_s = [], [], []
    for l in range(DEPTH):
        q, k, v, u = _mixer_in(xp, g_mix[l], w_in[l])
        attn_o = _window_attn_prompt(q, k, v, attn_sinks[l])
        u_prev = jnp.zeros((u.shape[0], POOL_HIST, POOL_WIDTH), u.dtype)
        pool_o, pool_new = _pool_mix(u, u_prev, 0, w_pool[l], pool_scale[l])
        mem_k, mem_v = _mem_kv(mem_prompt, g_mem[l], w_ck[l], w_cv[l])
        xp = _layer_tail(xp, attn_o, pool_o, mem_k, mem_v, w_out[l], g_cross[l], w_cq[l], w_co[l],
                         g_ffn[l], w_up[l], w_down[l])
        wk_p.append(k[:, -WINDOW:])
        wv_p.append(v[:, -WINDOW:])
        pool_p.append(pool_new)
        mk_p.append(mem_k)
        mv_p.append(mem_v)
        q, k, v, u = _mixer_in(xs, g_mix[l], w_in[l])
        attn_o, k_buf, v_buf = _window_attn_sample(q, k, v, cache_win_k[l], cache_win_v[l], attn_sinks[l])
        pool_o, pool_new = _pool_mix(u, state_pool[l], PAST_LEN, w_pool[l], pool_scale[l])
        xs = _layer_tail(xs, attn_o, pool_o, cache_mem_k[l], cache_mem_v[l], w_out[l], g_cross[l],
                         w_cq[l], w_co[l], g_ffn[l], w_up[l], w_down[l])
        wk_s.append(k_buf)
        wv_s.append(v_buf)
        pool_s.append(pool_new)
    y_prompt = _rmsnorm(xp, g_final)
    y_sample = _rmsnorm(xs, g_final)
    return (y_prompt, y_sample,
            jnp.stack(wk_p), jnp.stack(wv_p), jnp.stack(pool_p), jnp.stack(mk_p), jnp.stack(mv_p),
            jnp.stack(wk_s), jnp.stack(wv_s), jnp.stack(pool_s))
```

```cpp
#include <hip/hip_runtime.h>
#include <cstdio>
#include <cstdint>

#ifndef MK_N_LAUNCHES
#define MK_N_LAUNCHES 0
#endif

constexpr int D = 1024, BATCH = 4, SEQ = 4096, DEC_B = 128, DEC_T = 8, PAST = 16384;
constexpr int HD = 64, AW = 512, NH = 8, NKV = 2, KVW = 128, WIN = 128, PW = 512, PHIST = 15, INW = 1280;
constexpr int NMEM = 256, NCH = 4, CHD = 256, DFF = 4096;
constexpr int MP = BATCH * SEQ, MS = DEC_B * DEC_T, M = MP + MS;
constexpr float EPS = 1e-5f;
constexpr float LOG2E = 1.4426950408889634f;

constexpr size_t O_YP = 0, O_YS = O_YP + (size_t)MP * D, O_WKP = O_YS + (size_t)MS * D, O_WVP = O_WKP + (size_t)BATCH * WIN * KVW,
                 O_PP = O_WVP + (size_t)BATCH * WIN * KVW, O_MKP = O_PP + (size_t)BATCH * PHIST * PW, O_MVP = O_MKP + (size_t)BATCH * NMEM * D,
                 O_WKS = O_MVP + (size_t)BATCH * NMEM * D, O_WVS = O_WKS + (size_t)DEC_B * WIN * KVW, O_PS = O_WVS + (size_t)DEC_B * WIN * KVW,
                 O_END = O_PS + (size_t)DEC_B * PHIST * PW;
static_assert(O_END == 25262080, "output size");

constexpr size_t MiB = 1u << 20;
constexpr size_t WS_CTL = 0, CTL_ZERO_BYTES = 1 * MiB;
constexpr size_t WS_WIN = 2 * MiB;
constexpr size_t WS_WCKV = 5 * MiB;
constexpr size_t WS_WO2 = 9 * MiB;
constexpr size_t WS_WCQ = 11 * MiB, WS_WCO = 13 * MiB;
constexpr size_t WS_WUP = 15 * MiB;
constexpr size_t WS_WDN = 23 * MiB;
constexpr size_t WS_HM = 31 * MiB;
constexpr size_t WS_MK = 33 * MiB, WS_MV = 35 * MiB;
constexpr size_t WS_XN0 = 38 * MiB;
constexpr size_t WS_Q = 72 * MiB;
constexpr size_t WS_K = 89 * MiB, WS_V = 94 * MiB;
constexpr size_t WS_U = 99 * MiB;
constexpr size_t WS_A2 = 116 * MiB;
constexpr size_t WS_XB = 150 * MiB;
constexpr size_t WS_CQ = 184 * MiB;
constexpr size_t WS_OC = 218 * MiB;
constexpr size_t WS_H = 252 * MiB;
constexpr size_t WS_END = 388 * MiB;
constexpr int CW_BAR = 4096;
constexpr int CW_RSS1 = 32768, CW_RSS2 = CW_RSS1 + M, CW_RSS3 = CW_RSS2 + M;
static_assert((CW_RSS3 + M) * 4 <= (int)CTL_ZERO_BYTES, "ctl");

constexpr int LDS_BYTES = 147456;
constexpr int NTHREADS = 512, NWAVES = 8;

typedef unsigned short bf16_t;
typedef short bf16x8 __attribute__((ext_vector_type(8)));
typedef float f32x4 __attribute__((ext_vector_type(4)));
typedef unsigned u32x2 __attribute__((ext_vector_type(2)));
typedef unsigned u32x4 __attribute__((ext_vector_type(4)));
#define LAS __attribute__((address_space(3)))

__device__ __forceinline__ unsigned f2bf(float f) { unsigned u = __builtin_bit_cast(unsigned, f); return (u + 0x7fffu + ((u >> 16) & 1u)) >> 16; }
__device__ __forceinline__ unsigned pk2(float lo, float hi) { return f2bf(lo) | (f2bf(hi) << 16); }
__device__ __forceinline__ float bf2f(bf16_t h) { return __builtin_bit_cast(float, (unsigned)h << 16); }
__device__ __forceinline__ float wave_sum(float v) {
#pragma unroll
    for (int o = 1; o < 64; o <<= 1) v += __shfl_xor(v, o);
    return v;
}
__device__ __forceinline__ float wave_max(float v) {
#pragma unroll
    for (int o = 1; o < 64; o <<= 1) v = fmaxf(v, __shfl_xor(v, o));
    return v;
}

#define XB_TMO      128
#define XB_XCNT(j)  (256  + 64 * (j))
#define XB_XSUB(j)  (1280 + 64 * (j))
#define XB_XGEN(j)  (2304 + 64 * (j))
#define XB_TOP      3328
#define XB_TOPGEN   3392
#define XCD_BAR_WORDS 3456
#define XB_SPIN_CAP (1u << 18)
__device__ __forceinline__ unsigned xb_ld(unsigned* p)              { return __hip_atomic_load(p, __ATOMIC_RELAXED, __HIP_MEMORY_SCOPE_AGENT); }
__device__ __forceinline__ unsigned xb_add(unsigned* p, unsigned v) { return __hip_atomic_fetch_add(p, v, __ATOMIC_RELAXED, __HIP_MEMORY_SCOPE_AGENT); }
__device__ __forceinline__ unsigned xb_xcc_id() { return (unsigned)__builtin_amdgcn_s_getreg((3 << 11) | 20) & 0xFu; }
#define XB_SPIN(cond, bar) do { unsigned _sp = 0; while (cond) { __builtin_amdgcn_s_sleep(1); \
    if ((++_sp & 255u) == 0u) { if (xb_ld(&(bar)[XB_TMO])) break; if (_sp > XB_SPIN_CAP) { atomicAdd(&(bar)[XB_TMO], 1u); break; } } } } while (0)
struct XcdBarrier { unsigned* bar; unsigned x; volatile LAS unsigned* st; };
__device__ __forceinline__ XcdBarrier xcd_barrier_post(unsigned* bar, volatile LAS unsigned* st) {
    XcdBarrier b; b.bar = bar; b.x = xb_xcc_id(); b.st = st;
    if (threadIdx.x == 0) (void)xb_add(&bar[XB_XCNT(b.x)], 1u);
    return b;
}
__device__ __forceinline__ void xcd_barrier_complete(unsigned* bar, unsigned x, unsigned& nloc, unsigned& nx) {
    const unsigned G = gridDim.x * gridDim.y * gridDim.z;
    unsigned sum, cnt, mine, sp = 0u;
    for (;;) {
        sum = 0u; cnt = 0u; mine = 0u;
#pragma unroll
        for (unsigned j = 0; j < 16; ++j) { const unsigned c = xb_ld(&bar[XB_XCNT(j)]); sum += c; cnt += (c > 0u) ? 1u : 0u; mine = (j == x) ? c : mine; }
        if (sum == G) break;
        __builtin_amdgcn_s_sleep(1);
        if ((++sp & 255u) == 0u) { if (xb_ld(&bar[XB_TMO])) break; if (sp > XB_SPIN_CAP) { atomicAdd(&bar[XB_TMO], 1u); break; } }
    }
    nloc = mine > 0u ? mine : 1u; nx = cnt > 0u ? cnt : 1u;
}
__device__ __forceinline__ void xcd_barrier(const XcdBarrier& b) {
    asm volatile("s_waitcnt vmcnt(0)" ::: "memory");
    __syncthreads();
    if (threadIdx.x == 0) {
        unsigned* bar = b.bar;
        __builtin_amdgcn_s_waitcnt(0);
        unsigned nloc = b.st[0], nx = b.st[1];
        if (nloc == 0u) { xcd_barrier_complete(bar, b.x, nloc, nx); b.st[0] = nloc; b.st[1] = nx; }
        const unsigned old = xb_add(&bar[XB_XSUB(b.x)], 1u);
        const unsigned gen = old / nloc;
        if (old + 1u == (gen + 1u) * nloc) {
            __builtin_amdgcn_fence(__ATOMIC_RELEASE, "agent");
            asm volatile("s_waitcnt vmcnt(0)" ::: "memory");
            const unsigned og = xb_add(&bar[XB_TOP], 1u);
            const unsigned tg = og / nx;
            if (og + 1u == (tg + 1u) * nx) xb_add(&bar[XB_TOPGEN], 1u);
            else XB_SPIN(xb_ld(&bar[XB_TOPGEN]) == tg, bar);
            __builtin_amdgcn_fence(__ATOMIC_ACQUIRE, "agent");
            xb_add(&bar[XB_XGEN(b.x)], 1u);
            asm volatile("s_waitcnt vmcnt(0)" ::: "memory");
        } else {
            XB_SPIN(xb_ld(&bar[XB_XGEN(b.x)]) == gen, bar);
            __builtin_amdgcn_fence(__ATOMIC_ACQUIRE, "agent");
            asm volatile("s_waitcnt vmcnt(0)" ::: "memory");
        }
    }
    __syncthreads();
}

struct Args {
    const float *x_prompt, *x_sample, *cache_win_k, *cache_win_v, *state_pool, *cache_mem_k, *cache_mem_v, *mem_prompt;
    const float *g_mix, *w_in, *attn_sinks, *w_pool, *pool_scale, *w_out, *g_cross, *g_mem, *w_cq, *w_ck, *w_cv, *w_co, *g_ffn, *w_up, *w_down, *g_final;
    float* out; unsigned char* ws; int ph_lo, ph_hi;
};

template <class Epi>
__device__ __forceinline__ void gemm_naive(const bf16_t* A, int lda, const bf16_t* Bt, int ldb, int Mr, int N, int K, const Epi& epi) {
    const int wid = threadIdx.x >> 6, lane = threadIdx.x & 63, wr = wid >> 2, wc = wid & 3, fr = lane & 15, fq = lane >> 4;
    const int tn_n = N / 256, ntiles = (Mr / 128) * tn_n;
    for (int t = blockIdx.x; t < ntiles; t += gridDim.x) {
        const int tm = t / tn_n, tn = t % tn_n;
        const int r0 = tm * 128 + wr * 64, c0 = tn * 256 + wc * 64;
        f32x4 acc[4][4];
#pragma unroll
        for (int i = 0; i < 4; ++i)
#pragma unroll
            for (int j = 0; j < 4; ++j) acc[i][j] = (f32x4){0.f, 0.f, 0.f, 0.f};
        const bf16_t* ap = A + (size_t)(r0 + fr) * lda + fq * 8;
        const bf16_t* bp = Bt + (size_t)(c0 + fr) * ldb + fq * 8;
        for (int k0 = 0; k0 < K; k0 += 32) {
            bf16x8 a[4], b[4];
#pragma unroll
            for (int i = 0; i < 4; ++i) a[i] = *(const bf16x8*)(ap + (size_t)(i * 16) * lda + k0);
#pragma unroll
            for (int j = 0; j < 4; ++j) b[j] = *(const bf16x8*)(bp + (size_t)(j * 16) * ldb + k0);
#pragma unroll
            for (int i = 0; i < 4; ++i)
#pragma unroll
                for (int j = 0; j < 4; ++j) acc[i][j] = __builtin_amdgcn_mfma_f32_16x16x32_bf16(b[j], a[i], acc[i][j], 0, 0, 0);
        }
        epi(acc, r0 + fr, c0 + 4 * fq, fq);
    }
}

struct EpiProj {
    bf16_t *Q, *Kb, *Vb, *U; float* out;
    __device__ __forceinline__ void operator()(const f32x4 (&acc)[4][4], int row0, int col0, int) const {
#pragma unroll
        for (int i = 0; i < 4; ++i) {
            const int row = row0 + 16 * i;
            const bool samp = row >= MP;
            int b, t; if (!samp) { b = row / SEQ; t = row % SEQ; } else { b = (row - MP) / DEC_T; t = (row - MP) % DEC_T; }
#pragma unroll
            for (int j = 0; j < 4; ++j) {
                const int col = col0 + 16 * j; const f32x4 v = acc[i][j];
                if (col < AW) {
                    const float s = 0.125f * LOG2E;
                    *(u32x2*)(Q + (size_t)row * AW + col) = (u32x2){pk2(v[0] * s, v[1] * s), pk2(v[2] * s, v[3] * s)};
                } else if (col < AW + 2 * KVW) {
                    const bool isv = col >= AW + KVW; const int c = col - AW - (isv ? KVW : 0);
                    *(u32x2*)((isv ? Vb : Kb) + (size_t)row * KVW + c) = (u32x2){pk2(v[0], v[1]), pk2(v[2], v[3])};
                    if (!samp) { if (t >= SEQ - WIN) *(f32x4*)(out + (isv ? O_WVP : O_WKP) + ((size_t)b * WIN + (t - (SEQ - WIN))) * KVW + c) = v; }
                    else *(f32x4*)(out + (isv ? O_WVS : O_WKS) + ((size_t)b * WIN + (WIN - DEC_T + t)) * KVW + c) = v;
                } else {
                    const int c = col - AW - 2 * KVW;
                    *(u32x2*)(U + (size_t)row * PW + c) = (u32x2){pk2(v[0], v[1]), pk2(v[2], v[3])};
                    if (!samp) { if (t >= SEQ - PHIST) *(f32x4*)(out + O_PP + ((size_t)b * PHIST + (t - (SEQ - PHIST))) * PW + c) = v; }
                    else *(f32x4*)(out + O_PS + ((size_t)b * PHIST + (PHIST - DEC_T + t)) * PW + c) = v;
                }
            }
        }
    }
};
struct EpiMemKV {
    bf16_t *MK, *MV; float* out;
    __device__ __forceinline__ void operator()(const f32x4 (&acc)[4][4], int row0, int col0, int) const {
#pragma unroll
        for (int i = 0; i < 4; ++i)
#pragma unroll
            for (int j = 0; j < 4; ++j) {
                const int row = row0 + 16 * i, col = col0 + 16 * j; const f32x4 v = acc[i][j];
                const bool isv = col >= D; const int c = col - (isv ? D : 0);
                *(f32x4*)(out + (isv ? O_MVP : O_MKP) + (size_t)row * D + c) = v;
                *(u32x2*)((isv ? MV : MK) + (size_t)row * D + c) = (u32x2){pk2(v[0], v[1]), pk2(v[2], v[3])};
            }
    }
};
struct EpiResid {
    const float* base; float* X; bf16_t* XB; float* rss;
    __device__ __forceinline__ void operator()(const f32x4 (&acc)[4][4], int row0, int col0, int fq) const {
#pragma unroll
        for (int i = 0; i < 4; ++i) {
            const int row = row0 + 16 * i; float s = 0.f;
#pragma unroll
            for (int j = 0; j < 4; ++j) {
                const int col = col0 + 16 * j;
                const f32x4 v = *(const f32x4*)(base + (size_t)row * D + col) + acc[i][j];
                *(f32x4*)(X + (size_t)row * D + col) = v;
                if (XB) *(u32x2*)(XB + (size_t)row * D + col) = (u32x2){pk2(v[0], v[1]), pk2(v[2], v[3])};
                s += (v[0] * v[0] + v[1] * v[1]) + (v[2] * v[2] + v[3] * v[3]);
            }
            s += __shfl_xor(s, 16); s += __shfl_xor(s, 32);
            if (fq == 0) atomicAdd(rss + row, s);
        }
    }
};
template <int ACT>
struct EpiRowScale {
    bf16_t* O; int ldo; const float* rss; float scale;
    __device__ __forceinline__ void operator()(const f32x4 (&acc)[4][4], int row0, int col0, int) const {
#pragma unroll
        for (int i = 0; i < 4; ++i) {
            const int row = row0 + 16 * i; const float rs = rsqrtf(rss[row] * (1.0f / D) + EPS);
#pragma unroll
            for (int j = 0; j < 4; ++j) {
                const int col = col0 + 16 * j; f32x4 v = acc[i][j] * rs;
                if (ACT == 1) {
#pragma unroll
                    for (int e = 0; e < 4; ++e) { const float r = fmaxf(v[e], 0.f); v[e] = r * r; }
                }
                v = v * scale;
                *(u32x2*)(O + (size_t)row * ldo + col) = (u32x2){pk2(v[0], v[1]), pk2(v[2], v[3])};
            }
        }
    }
};

__device__ __forceinline__ void conv_weight(const float* W, const float* g, int K, int N, bf16_t* Wt, size_t gt, size_t GT) {
    for (size_t i = gt; i < (size_t)K * N; i += GT) { const int k = (int)(i / N), n = (int)(i % N); Wt[(size_t)n * K + k] = (bf16_t)f2bf(W[i] * (g ? g[k] : 1.f)); }
}
__device__ __forceinline__ void norm_rows(const float* X, bf16_t* O, int rows, int gw, int NGW, int lane) {
    for (int r = gw; r < rows; r += NGW) {
        const f32x4* xr = (const f32x4*)(X + (size_t)r * D) + lane; f32x4 v[4]; float s = 0.f;
#pragma unroll
        for (int j = 0; j < 4; ++j) { v[j] = xr[64 * j]; s += (v[j][0] * v[j][0] + v[j][1] * v[j][1]) + (v[j][2] * v[j][2] + v[j][3] * v[j][3]); }
        const float rs = rsqrtf(wave_sum(s) * (1.f / D) + EPS);
        u32x2* o = (u32x2*)(O + (size_t)r * D) + lane;
#pragma unroll
        for (int j = 0; j < 4; ++j) o[64 * j] = (u32x2){pk2(v[j][0] * rs, v[j][1] * rs), pk2(v[j][2] * rs, v[j][3] * rs)};
    }
}

__global__ void __launch_bounds__(NTHREADS, 2) fwd(Args a) {
    extern __shared__ __attribute__((aligned(16))) unsigned char lds[];
    const int tid = threadIdx.x, lane = tid & 63, wave = tid >> 6;
    const int G = gridDim.x, bx = blockIdx.x;
    const size_t gt = (size_t)bx * NTHREADS + tid, GT = (size_t)G * NTHREADS;
    const int gw = bx * NWAVES + wave, NGW = G * NWAVES;
    unsigned char* ws = a.ws;
    unsigned* ctl = (unsigned*)(ws + WS_CTL);
    float* rss1 = (float*)(ctl + CW_RSS1); float* rss2 = (float*)(ctl + CW_RSS2); float* rss3 = (float*)(ctl + CW_RSS3);
    bf16_t* Win_t = (bf16_t*)(ws + WS_WIN); bf16_t* Wckv_t = (bf16_t*)(ws + WS_WCKV); bf16_t* Wo2_t = (bf16_t*)(ws + WS_WO2);
    bf16_t* Wcq_t = (bf16_t*)(ws + WS_WCQ); bf16_t* Wco_t = (bf16_t*)(ws + WS_WCO); bf16_t* Wup_t = (bf16_t*)(ws + WS_WUP); bf16_t* Wdn_t = (bf16_t*)(ws + WS_WDN);
    bf16_t* HM = (bf16_t*)(ws + WS_HM); bf16_t* MK = (bf16_t*)(ws + WS_MK); bf16_t* MV = (bf16_t*)(ws + WS_MV);
    bf16_t* XN0 = (bf16_t*)(ws + WS_XN0); bf16_t* Qb = (bf16_t*)(ws + WS_Q); bf16_t* Kb = (bf16_t*)(ws + WS_K); bf16_t* Vb = (bf16_t*)(ws + WS_V); bf16_t* Ub = (bf16_t*)(ws + WS_U);
    bf16_t* A2 = (bf16_t*)(ws + WS_A2); bf16_t* XB = (bf16_t*)(ws + WS_XB); bf16_t* CQ = (bf16_t*)(ws + WS_CQ); bf16_t* OC = (bf16_t*)(ws + WS_OC); bf16_t* Hb = (bf16_t*)(ws + WS_H);
    float* X = a.out;

    volatile LAS unsigned* MISC = (volatile LAS unsigned*)((LAS unsigned char*)lds + 131072);
    if (tid < 32) MISC[tid] = 0u;
    __syncthreads();
    XcdBarrier bar; bar.bar = ctl + CW_BAR; bar.x = 0; bar.st = nullptr;
    if (MK_N_LAUNCHES == 1) bar = xcd_barrier_post(ctl + CW_BAR, MISC + 8);
    const int lo = a.ph_lo, hi = a.ph_hi;
#define IN(k) (lo <= (k) && (k) < hi)
#define SEAM(k) do { if (IN(k) && IN((k) + 1)) xcd_barrier(bar); } while (0)

    if (IN(0)) {
        conv_weight(a.w_in, a.g_mix, D, INW, Win_t, gt, GT);
        conv_weight(a.w_ck, a.g_mem, D, D, Wckv_t, gt, GT);
        conv_weight(a.w_cv, a.g_mem, D, D, Wckv_t + (size_t)D * D, gt, GT);
        conv_weight(a.w_cq, a.g_cross, D, D, Wcq_t, gt, GT);
        conv_weight(a.w_co, nullptr, D, D, Wco_t, gt, GT);
        conv_weight(a.w_up, a.g_ffn, D, DFF, Wup_t, gt, GT);
        conv_weight(a.w_down, nullptr, DFF, D, Wdn_t, gt, GT);
        for (size_t i = gt; i < (size_t)AW * D; i += GT) { const int k = (int)(i / D), n = (int)(i % D); Wo2_t[(size_t)n * D + k] = (bf16_t)f2bf(a.w_out[i]); }
        for (size_t i = gt; i < (size_t)PW * D; i += GT) {
            const int cc = (int)(i / D), n = (int)(i % D), g = cc / 128, c = cc % 128; float s = 0.f;
            for (int e = 0; e < 128; ++e) s += a.w_pool[((size_t)g * 128 + c) * 128 + e] * a.pool_scale[g * 128 + e] * a.w_out[(size_t)(AW + g * 128 + e) * D + n];
            Wo2_t[(size_t)n * D + AW + cc] = (bf16_t)f2bf(s);
        }
        norm_rows(a.x_prompt, XN0, MP, gw, NGW, lane);
        norm_rows(a.x_sample, XN0 + (size_t)MP * D, MS, gw, NGW, lane);
        norm_rows(a.mem_prompt, HM, BATCH * NMEM, gw, NGW, lane);
        for (size_t i = gt; i < (size_t)DEC_B * (WIN - DEC_T) * KVW; i += GT) {
            const int b = (int)(i / ((WIN - DEC_T) * KVW)), r = (int)(i % ((WIN - DEC_T) * KVW));
            a.out[O_WKS + (size_t)b * WIN * KVW + r] = a.cache_win_k[(size_t)b * WIN * KVW + DEC_T * KVW + r];
            a.out[O_WVS + (size_t)b * WIN * KVW + r] = a.cache_win_v[(size_t)b * WIN * KVW + DEC_T * KVW + r];
        }
        for (size_t i = gt; i < (size_t)DEC_B * (PHIST - DEC_T) * PW; i += GT) {
            const int b = (int)(i / ((PHIST - DEC_T) * PW)), r = (int)(i % ((PHIST - DEC_T) * PW));
            a.out[O_PS + (size_t)b * PHIST * PW + r] = a.state_pool[(size_t)b * PHIST * PW + DEC_T * PW + r];
        }
    }
    SEAM(0);
    if (IN(1)) {
        gemm_naive(XN0, D, Win_t, D, M, INW, D, EpiProj{Qb, Kb, Vb, Ub, a.out});
        gemm_naive(HM, D, Wckv_t, D, BATCH * NMEM, 2 * D, D, EpiMemKV{MK, MV, a.out});
    }
    SEAM(1);
    if (IN(2)) {
        for (size_t task = gt; task < (size_t)NH * M; task += GT) {
            const int h = (int)(task / M), row = (int)(task % M), kvh = h / 4;
            const float slope = exp2f(-(float)(h + 1)) * LOG2E, sink = a.attn_sinks[h] * LOG2E;
            float q[HD], o[HD];
#pragma unroll
            for (int d = 0; d < HD; ++d) { q[d] = bf2f(Qb[(size_t)row * AW + h * HD + d]); o[d] = 0.f; }
            float m = sink, l = 1.f;
            const bool samp = row >= MP;
            int b, t; if (!samp) { b = row / SEQ; t = row % SEQ; } else { b = (row - MP) / DEC_T; t = (row - MP) % DEC_T; }
            for (int i = 0; i <= WIN; ++i) {
                if (!samp && t - i < 0) break;
                const bool cached = samp && i > t;
                const int j = WIN + t - i;
                const bf16_t* kp = Kb + (size_t)(cached ? row : row - i) * KVW + kvh * HD; const bf16_t* vp = Vb + (size_t)(cached ? row : row - i) * KVW + kvh * HD;
                const float* kc = a.cache_win_k + ((size_t)b * WIN + (cached ? j : 0)) * KVW + kvh * HD; const float* vc = a.cache_win_v + ((size_t)b * WIN + (cached ? j : 0)) * KVW + kvh * HD;
                float s = 0.f;
                if (cached) {
#pragma unroll
                    for (int d = 0; d < HD; ++d) s += q[d] * kc[d];
                } else {
#pragma unroll
                    for (int d = 0; d < HD; ++d) s += q[d] * bf2f(kp[d]);
                }
                s -= slope * (float)i;
                if (s > m) { const float f = exp2f(m - s); l *= f;
#pragma unroll
                    for (int d = 0; d < HD; ++d) o[d] *= f;
                    m = s; }
                const float p = exp2f(s - m); l += p;
                if (cached) {
#pragma unroll
                    for (int d = 0; d < HD; ++d) o[d] += p * vc[d];
                } else {
#pragma unroll
                    for (int d = 0; d < HD; ++d) o[d] += p * bf2f(vp[d]);
                }
            }
            const float il = 1.f / l;
#pragma unroll
            for (int d = 0; d < HD; d += 2) *(unsigned*)(A2 + (size_t)row * D + h * HD + d) = pk2(o[d] * il, o[d + 1] * il);
        }
        for (size_t task = gt; task < (size_t)M * PW; task += GT) {
            const int row = (int)(task / PW), c = (int)(task % PW), w = 2 << (c / 128);
            const bool samp = row >= MP; float s = 0.f, cnt;
            if (!samp) { const int t = row % SEQ; for (int i = 0; i < w; ++i) if (t - i >= 0) s += bf2f(Ub[(size_t)(row - i) * PW + c]); cnt = (float)(t + 1 < w ? t + 1 : w); }
            else { const int b = (row - MP) / DEC_T, t = (row - MP) % DEC_T;
                for (int i = 0; i < w; ++i) { const int ti = t - i; s += ti >= 0 ? bf2f(Ub[(size_t)(row - i) * PW + c]) : a.state_pool[((size_t)b * PHIST + (PHIST + ti)) * PW + c]; } cnt = (float)w; }
            A2[(size_t)row * D + AW + c] = (bf16_t)f2bf(s / cnt - bf2f(Ub[(size_t)row * PW + c]));
        }
    }
    SEAM(2);
    if (IN(3)) {
        gemm_naive(A2, D, Wo2_t, D, MP, D, D, EpiResid{a.x_prompt, X, XB, rss1});
        gemm_naive(A2 + (size_t)MP * D, D, Wo2_t, D, MS, D, D, EpiResid{a.x_sample, X + (size_t)MP * D, XB + (size_t)MP * D, rss1 + MP});
    }
    SEAM(3);
    if (IN(4)) gemm_naive(XB, D, Wcq_t, D, M, D, D, EpiRowScale<0>{CQ, D, rss1, (1.0f / 16.0f) * LOG2E});
    SEAM(4);
    if (IN(5)) {
        LAS float* qs = (LAS float*)lds + wave * 512; LAS float* ps = qs + 256;
        for (int task = gw; task < M * NCH; task += NGW) {
            const int row = task / NCH, h = task % NCH; const bool samp = row >= MP;
            const int b = samp ? (row - MP) / DEC_T : row / SEQ;
            { const u32x2 w = *(const u32x2*)(CQ + (size_t)row * D + h * CHD + lane * 4);
              qs[lane * 4 + 0] = bf2f((bf16_t)(w[0] & 0xffff)); qs[lane * 4 + 1] = bf2f((bf16_t)(w[0] >> 16)); qs[lane * 4 + 2] = bf2f((bf16_t)(w[1] & 0xffff)); qs[lane * 4 + 3] = bf2f((bf16_t)(w[1] >> 16)); }
            float sc[4]; float mx = -3.0e38f;
#pragma unroll
            for (int mm = 0; mm < 4; ++mm) {
                const int m = mm * 64 + lane; float s = 0.f;
                if (!samp) { const bf16_t* kp = MK + ((size_t)b * NMEM + m) * D + h * CHD; for (int d = 0; d < CHD; ++d) s += qs[d] * bf2f(kp[d]); }
                else { const float* kp = a.cache_mem_k + (((size_t)b * NMEM + m) * NCH + h) * CHD; for (int d = 0; d < CHD; ++d) s += qs[d] * kp[d]; }
                sc[mm] = s; mx = fmaxf(mx, s);
            }
            mx = wave_max(mx); float sum = 0.f;
#pragma unroll
            for (int mm = 0; mm < 4; ++mm) { const float p = exp2f(sc[mm] - mx); sum += p; ps[mm * 64 + lane] = p; }
            sum = wave_sum(sum);
            float o[4] = {0.f, 0.f, 0.f, 0.f};
            if (!samp) { const bf16_t* vp = MV + (size_t)b * NMEM * D + h * CHD + lane * 4;
                for (int m = 0; m < NMEM; ++m) { const float p = ps[m]; const u32x2 w = *(const u32x2*)(vp + (size_t)m * D);
                    o[0] += p * bf2f((bf16_t)(w[0] & 0xffff)); o[1] += p * bf2f((bf16_t)(w[0] >> 16)); o[2] += p * bf2f((bf16_t)(w[1] & 0xffff)); o[3] += p * bf2f((bf16_t)(w[1] >> 16)); } }
            else { const float* vp = a.cache_mem_v + ((size_t)b * NMEM * NCH + h) * CHD + lane * 4;
                for (int m = 0; m < NMEM; ++m) { const float p = ps[m]; const f32x4 w = *(const f32x4*)(vp + (size_t)m * NCH * CHD);
                    o[0] += p * w[0]; o[1] += p * w[1]; o[2] += p * w[2]; o[3] += p * w[3]; } }
            const float il = 1.f / sum;
            *(u32x2*)(OC + (size_t)row * D + h * CHD + lane * 4) = (u32x2){pk2(o[0] * il, o[1] * il), pk2(o[2] * il, o[3] * il)};
        }
    }
    SEAM(5);
    if (IN(6)) gemm_naive(OC, D, Wco_t, D, M, D, D, EpiResid{X, X, XB, rss2});
    SEAM(6);
    if (IN(7)) gemm_naive(XB, D, Wup_t, D, M, DFF, D, EpiRowScale<1>{Hb, DFF, rss2, 1.0f});
    SEAM(7);
    if (IN(8)) gemm_naive(Hb, DFF, Wdn_t, DFF, M, D, DFF, EpiResid{X, X, nullptr, rss3});
    SEAM(8);
    if (IN(9)) {
        for (int r = gw; r < M; r += NGW) {
            const float rs = rsqrtf(rss3[r] * (1.f / D) + EPS);
            f32x4* xr = (f32x4*)(X + (size_t)r * D) + lane; const f32x4* gp = (const f32x4*)a.g_final + lane;
#pragma unroll
            for (int j = 0; j < 4; ++j) xr[64 * j] = xr[64 * j] * rs * gp[64 * j];
        }
    }
#undef IN
#undef SEAM
}

constexpr int N_PHASES = 10;
extern "C" void kernel_launch(void* const* d_in, const int* in_sizes, int n_in, void* d_out, int out_size, void* d_ws, size_t ws_size, hipStream_t stream) {
    static int grid = 0;
    if (grid == 0) {
        if (n_in != 24 || in_sizes[0] != MP * D || out_size != (int)O_END || ws_size < WS_END) {
            fprintf(stderr, "kernel_launch: unexpected shapes: n_in %d in0 %d out %d ws %zu (need %zu)\n", n_in, n_in > 0 ? in_sizes[0] : -1, out_size, ws_size, (size_t)WS_END); grid = -1; return; }
        int dev = 0, cus = 0, per_cu = 0;
        if (hipGetDevice(&dev) != hipSuccess || hipDeviceGetAttribute(&cus, hipDeviceAttributeMultiprocessorCount, dev) != hipSuccess) { grid = -1; return; }
        if (hipFuncSetAttribute((const void*)fwd, hipFuncAttributeMaxDynamicSharedMemorySize, LDS_BYTES) != hipSuccess) { fprintf(stderr, "kernel_launch: hipFuncSetAttribute failed\n"); grid = -1; return; }
        if (hipOccupancyMaxActiveBlocksPerMultiprocessor(&per_cu, (const void*)fwd, NTHREADS, LDS_BYTES) != hipSuccess || per_cu < 1) { fprintf(stderr, "kernel_launch: occupancy query says %d\n", per_cu); grid = -1; (void)hipGetLastError(); return; }
        grid = cus;
    }
    if (grid < 0) return;
    (void)hipMemsetAsync((char*)d_ws + WS_CTL, 0, CTL_ZERO_BYTES, stream);
    Args a{};
    const float** p = (const float**)&a;
    for (int i = 0; i < 24; ++i) p[i] = (const float*)d_in[i];
    a.out = (float*)d_out; a.ws = (unsigned char*)d_ws;
    if (MK_N_LAUNCHES == 1) { a.ph_lo = 0; a.ph_hi = N_PHASES; hipLaunchKernelGGL(fwd, dim3(grid), dim3(NTHREADS), LDS_BYTES, stream, a); }
    else for (int ph = 0; ph < N_PHASES; ++ph) { a.ph_lo = ph; a.ph_hi = ph + 1; hipLaunchKernelGGL(fwd, dim3(grid), dim3(NTHREADS), LDS_BYTES, stream, a); }
}
```

```cpp
#include <hip/hip_runtime.h>
#include <cstdio>
#include <cstdint>

#ifndef MK_N_LAUNCHES
#define MK_N_LAUNCHES 1
#endif

constexpr int D = 1024, BATCH = 4, SEQ = 4096, DEC_B = 128, DEC_T = 8, PAST = 16384;
constexpr int HD = 64, AW = 512, NH = 8, NKV = 2, KVW = 128, WIN = 128, PW = 512, PHIST = 15, INW = 1280;
constexpr int NMEM = 256, NCH = 4, CHD = 256, DFF = 4096;
constexpr int MP = BATCH * SEQ, MS = DEC_B * DEC_T, M = MP + MS;
constexpr float EPS = 1e-5f;
constexpr float LOG2E = 1.4426950408889634f;

constexpr size_t O_YP = 0, O_YS = O_YP + (size_t)MP * D, O_WKP = O_YS + (size_t)MS * D, O_WVP = O_WKP + (size_t)BATCH * WIN * KVW,
                 O_PP = O_WVP + (size_t)BATCH * WIN * KVW, O_MKP = O_PP + (size_t)BATCH * PHIST * PW, O_MVP = O_MKP + (size_t)BATCH * NMEM * D,
                 O_WKS = O_MVP + (size_t)BATCH * NMEM * D, O_WVS = O_WKS + (size_t)DEC_B * WIN * KVW, O_PS = O_WVS + (size_t)DEC_B * WIN * KVW,
                 O_END = O_PS + (size_t)DEC_B * PHIST * PW;
static_assert(O_END == 25262080, "output size");

constexpr size_t MiB = 1u << 20;
constexpr size_t WS_CTL = 0, CTL_ZERO_BYTES = 1 * MiB;
constexpr size_t WS_WIN = 2 * MiB;
constexpr size_t WS_WCKV = 5 * MiB;
constexpr size_t WS_WO2 = 9 * MiB;
constexpr size_t WS_WCQ = 11 * MiB, WS_WCO = 13 * MiB;
constexpr size_t WS_WUP = 15 * MiB;
constexpr size_t WS_WDN = 23 * MiB;
constexpr size_t WS_HM = 31 * MiB;
constexpr size_t WS_MK = 33 * MiB, WS_MV = 35 * MiB;
constexpr size_t WS_XN0 = 38 * MiB;
constexpr size_t WS_Q = 72 * MiB;
constexpr size_t WS_K = 89 * MiB, WS_V = 94 * MiB;
constexpr size_t WS_U = 99 * MiB;
constexpr size_t WS_A2 = 116 * MiB;
constexpr size_t WS_XB = 150 * MiB;
constexpr size_t WS_CQ = 184 * MiB;
constexpr size_t WS_OC = 218 * MiB;
constexpr size_t WS_H = 252 * MiB;
constexpr size_t WS_END = 388 * MiB;
constexpr int CW_BAR = 4096;
constexpr int CW_RSS1 = 32768, CW_RSS2 = CW_RSS1 + M, CW_RSS3 = CW_RSS2 + M;
static_assert((CW_RSS3 + M) * 4 <= (int)CTL_ZERO_BYTES, "ctl");

constexpr int LDS_BYTES = 147456;
constexpr int NTHREADS = 512, NWAVES = 8;

typedef unsigned short bf16_t;
typedef short bf16x8 __attribute__((ext_vector_type(8)));
typedef float f32x4 __attribute__((ext_vector_type(4)));
typedef unsigned u32x2 __attribute__((ext_vector_type(2)));
typedef unsigned u32x4 __attribute__((ext_vector_type(4)));
#define LAS __attribute__((address_space(3)))

__device__ __forceinline__ unsigned f2bf(float f) { unsigned u = __builtin_bit_cast(unsigned, f); return (u + 0x7fffu + ((u >> 16) & 1u)) >> 16; }
__device__ __forceinline__ unsigned pk2(float lo, float hi) { return f2bf(lo) | (f2bf(hi) << 16); }
__device__ __forceinline__ float bf2f(bf16_t h) { return __builtin_bit_cast(float, (unsigned)h << 16); }
__device__ __forceinline__ float wave_sum(float v) {
#pragma unroll
    for (int o = 1; o < 64; o <<= 1) v += __shfl_xor(v, o);
    return v;
}
__device__ __forceinline__ float wave_max(float v) {
#pragma unroll
    for (int o = 1; o < 64; o <<= 1) v = fmaxf(v, __shfl_xor(v, o));
    return v;
}

#define XB_TMO      128
#define XB_XCNT(j)  (256  + 64 * (j))
#define XB_XSUB(j)  (1280 + 64 * (j))
#define XB_XGEN(j)  (2304 + 64 * (j))
#define XB_TOP      3328
#define XB_TOPGEN   3392
#define XCD_BAR_WORDS 3456
#define XB_SPIN_CAP (1u << 18)
__device__ __forceinline__ unsigned xb_ld(unsigned* p)              { return __hip_atomic_load(p, __ATOMIC_RELAXED, __HIP_MEMORY_SCOPE_AGENT); }
__device__ __forceinline__ unsigned xb_add(unsigned* p, unsigned v) { return __hip_atomic_fetch_add(p, v, __ATOMIC_RELAXED, __HIP_MEMORY_SCOPE_AGENT); }
__device__ __forceinline__ unsigned xb_xcc_id() { return (unsigned)__builtin_amdgcn_s_getreg((3 << 11) | 20) & 0xFu; }
#define XB_SPIN(cond, bar) do { unsigned _sp = 0; while (cond) { __builtin_amdgcn_s_sleep(1); \
    if ((++_sp & 255u) == 0u) { if (xb_ld(&(bar)[XB_TMO])) break; if (_sp > XB_SPIN_CAP) { atomicAdd(&(bar)[XB_TMO], 1u); break; } } } } while (0)
struct XcdBarrier { unsigned* bar; unsigned x; volatile LAS unsigned* st; };
__device__ __forceinline__ XcdBarrier xcd_barrier_post(unsigned* bar, volatile LAS unsigned* st) {
    XcdBarrier b; b.bar = bar; b.x = xb_xcc_id(); b.st = st;
    if (threadIdx.x == 0) (void)xb_add(&bar[XB_XCNT(b.x)], 1u);
    return b;
}
__device__ __forceinline__ void xcd_barrier_complete(unsigned* bar, unsigned x, unsigned& nloc, unsigned& nx) {
    const unsigned G = gridDim.x * gridDim.y * gridDim.z;
    unsigned sum, cnt, mine, sp = 0u;
    for (;;) {
        sum = 0u; cnt = 0u; mine = 0u;
#pragma unroll
        for (unsigned j = 0; j < 16; ++j) { const unsigned c = xb_ld(&bar[XB_XCNT(j)]); sum += c; cnt += (c > 0u) ? 1u : 0u; mine = (j == x) ? c : mine; }
        if (sum == G) break;
        __builtin_amdgcn_s_sleep(1);
        if ((++sp & 255u) == 0u) { if (xb_ld(&bar[XB_TMO])) break; if (sp > XB_SPIN_CAP) { atomicAdd(&bar[XB_TMO], 1u); break; } }
    }
    nloc = mine > 0u ? mine : 1u; nx = cnt > 0u ? cnt : 1u;
}
__device__ __forceinline__ void xcd_barrier(const XcdBarrier& b) {
    asm volatile("s_waitcnt vmcnt(0)" ::: "memory");
    __syncthreads();
    if (threadIdx.x == 0) {
        unsigned* bar = b.bar;
        __builtin_amdgcn_s_waitcnt(0);
        unsigned nloc = b.st[0], nx = b.st[1];
        if (nloc == 0u) { xcd_barrier_complete(bar, b.x, nloc, nx); b.st[0] = nloc; b.st[1] = nx; }
        const unsigned old = xb_add(&bar[XB_XSUB(b.x)], 1u);
        const unsigned gen = old / nloc;
        if (old + 1u == (gen + 1u) * nloc) {
            __builtin_amdgcn_fence(__ATOMIC_RELEASE, "agent");
            asm volatile("s_waitcnt vmcnt(0)" ::: "memory");
            const unsigned og = xb_add(&bar[XB_TOP], 1u);
            const unsigned tg = og / nx;
            if (og + 1u == (tg + 1u) * nx) xb_add(&bar[XB_TOPGEN], 1u);
            else XB_SPIN(xb_ld(&bar[XB_TOPGEN]) == tg, bar);
            __builtin_amdgcn_fence(__ATOMIC_ACQUIRE, "agent");
            xb_add(&bar[XB_XGEN(b.x)], 1u);
            asm volatile("s_waitcnt vmcnt(0)" ::: "memory");
        } else {
            XB_SPIN(xb_ld(&bar[XB_XGEN(b.x)]) == gen, bar);
            __builtin_amdgcn_fence(__ATOMIC_ACQUIRE, "agent");
            asm volatile("s_waitcnt vmcnt(0)" ::: "memory");
        }
    }
    __syncthreads();
}

struct Args {
    const float *x_prompt, *x_sample, *cache_win_k, *cache_win_v, *state_pool, *cache_mem_k, *cache_mem_v, *mem_prompt;
    const float *g_mix, *w_in, *attn_sinks, *w_pool, *pool_scale, *w_out, *g_cross, *g_mem, *w_cq, *w_ck, *w_cv, *w_co, *g_ffn, *w_up, *w_down, *g_final;
    float* out; unsigned char* ws; int ph_lo, ph_hi;
};

template <class Epi>
__device__ __forceinline__ void gemm_naive(const bf16_t* A, int lda, const bf16_t* Bt, int ldb, int Mr, int N, int K, const Epi& epi) {
    const int wid = threadIdx.x >> 6, lane = threadIdx.x & 63, wr = wid >> 2, wc = wid & 3, fr = lane & 15, fq = lane >> 4;
    const int tn_n = N / 256, ntiles = (Mr / 128) * tn_n;
    for (int t = blockIdx.x; t < ntiles; t += gridDim.x) {
        const int tm = t / tn_n, tn = t % tn_n;
        const int r0 = tm * 128 + wr * 64, c0 = tn * 256 + wc * 64;
        f32x4 acc[4][4];
#pragma unroll
        for (int i = 0; i < 4; ++i)
#pragma unroll
            for (int j = 0; j < 4; ++j) acc[i][j] = (f32x4){0.f, 0.f, 0.f, 0.f};
        const bf16_t* ap = A + (size_t)(r0 + fr) * lda + fq * 8;
        const bf16_t* bp = Bt + (size_t)(c0 + fr) * ldb + fq * 8;
        for (int k0 = 0; k0 < K; k0 += 32) {
            bf16x8 a[4], b[4];
#pragma unroll
            for (int i = 0; i < 4; ++i) a[i] = *(const bf16x8*)(ap + (size_t)(i * 16) * lda + k0);
#pragma unroll
            for (int j = 0; j < 4; ++j) b[j] = *(const bf16x8*)(bp + (size_t)(j * 16) * ldb + k0);
#pragma unroll
            for (int i = 0; i < 4; ++i)
#pragma unroll
                for (int j = 0; j < 4; ++j) acc[i][j] = __builtin_amdgcn_mfma_f32_16x16x32_bf16(b[j], a[i], acc[i][j], 0, 0, 0);
        }
        epi(acc, r0 + fr, c0 + 4 * fq, fq);
    }
}

struct EpiProj {
    bf16_t *Q, *Kb, *Vb, *U; float* out;
    __device__ __forceinline__ void operator()(const f32x4 (&acc)[4][4], int row0, int col0, int) const {
#pragma unroll
        for (int i = 0; i < 4; ++i) {
            const int row = row0 + 16 * i;
            const bool samp = row >= MP;
            int b, t; if (!samp) { b = row / SEQ; t = row % SEQ; } else { b = (row - MP) / DEC_T; t = (row - MP) % DEC_T; }
#pragma unroll
            for (int j = 0; j < 4; ++j) {
                const int col = col0 + 16 * j; const f32x4 v = acc[i][j];
                if (col < AW) {
                    const float s = 0.125f * LOG2E;
                    *(u32x2*)(Q + (size_t)row * AW + col) = (u32x2){pk2(v[0] * s, v[1] * s), pk2(v[2] * s, v[3] * s)};
                } else if (col < AW + 2 * KVW) {
                    const bool isv = col >= AW + KVW; const int c = col - AW - (isv ? KVW : 0);
                    *(u32x2*)((isv ? Vb : Kb) + (size_t)row * KVW + c) = (u32x2){pk2(v[0], v[1]), pk2(v[2], v[3])};
                    if (!samp) { if (t >= SEQ - WIN) *(f32x4*)(out + (isv ? O_WVP : O_WKP) + ((size_t)b * WIN + (t - (SEQ - WIN))) * KVW + c) = v; }
                    else *(f32x4*)(out + (isv ? O_WVS : O_WKS) + ((size_t)b * WIN + (WIN - DEC_T + t)) * KVW + c) = v;
                } else {
                    const int c = col - AW - 2 * KVW;
                    *(u32x2*)(U + (size_t)row * PW + c) = (u32x2){pk2(v[0], v[1]), pk2(v[2], v[3])};
                    if (!samp) { if (t >= SEQ - PHIST) *(f32x4*)(out + O_PP + ((size_t)b * PHIST + (t - (SEQ - PHIST))) * PW + c) = v; }
                    else *(f32x4*)(out + O_PS + ((size_t)b * PHIST + (PHIST - DEC_T + t)) * PW + c) = v;
                }
            }
        }
    }
};
struct EpiMemKV {
    bf16_t *MK, *MV; float* out;
    __device__ __forceinline__ void operator()(const f32x4 (&acc)[4][4], int row0, int col0, int) const {
#pragma unroll
        for (int i = 0; i < 4; ++i)
#pragma unroll
            for (int j = 0; j < 4; ++j) {
                const int row = row0 + 16 * i, col = col0 + 16 * j; const f32x4 v = acc[i][j];
                const bool isv = col >= D; const int c = col - (isv ? D : 0);
                *(f32x4*)(out + (isv ? O_MVP : O_MKP) + (size_t)row * D + c) = v;
                *(u32x2*)((isv ? MV : MK) + (size_t)row * D + c) = (u32x2){pk2(v[0], v[1]), pk2(v[2], v[3])};
            }
    }
};
struct EpiResid {
    const float* base; float* X; bf16_t* XB; float* rss;
    __device__ __forceinline__ void operator()(const f32x4 (&acc)[4][4], int row0, int col0, int fq) const {
#pragma unroll
        for (int i = 0; i < 4; ++i) {
            const int row = row0 + 16 * i; float s = 0.f;
#pragma unroll
            for (int j = 0; j < 4; ++j) {
                const int col = col0 + 16 * j;
                const f32x4 v = *(const f32x4*)(base + (size_t)row * D + col) + acc[i][j];
                *(f32x4*)(X + (size_t)row * D + col) = v;
                if (XB) *(u32x2*)(XB + (size_t)row * D + col) = (u32x2){pk2(v[0], v[1]), pk2(v[2], v[3])};
                s += (v[0] * v[0] + v[1] * v[1]) + (v[2] * v[2] + v[3] * v[3]);
            }
            s += __shfl_xor(s, 16); s += __shfl_xor(s, 32);
            if (fq == 0) atomicAdd(rss + row, s);
        }
    }
};
template <int ACT>
struct EpiRowScale {
    bf16_t* O; int ldo; const float* rss; float scale;
    __device__ __forceinline__ void operator()(const f32x4 (&acc)[4][4], int row0, int col0, int) const {
#pragma unroll
        for (int i = 0; i < 4; ++i) {
            const int row = row0 + 16 * i; const float rs = rsqrtf(rss[row] * (1.0f / D) + EPS);
#pragma unroll
            for (int j = 0; j < 4; ++j) {
                const int col = col0 + 16 * j; f32x4 v = acc[i][j] * rs;
                if (ACT == 1) {
#pragma unroll
                    for (int e = 0; e < 4; ++e) { const float r = fmaxf(v[e], 0.f); v[e] = r * r; }
                }
                v = v * scale;
                *(u32x2*)(O + (size_t)row * ldo + col) = (u32x2){pk2(v[0], v[1]), pk2(v[2], v[3])};
            }
        }
    }
};

__device__ __forceinline__ void conv_weight(const float* W, const float* g, int K, int N, bf16_t* Wt, size_t gt, size_t GT) {
    for (size_t i = gt; i < (size_t)K * N; i += GT) { const int k = (int)(i / N), n = (int)(i % N); Wt[(size_t)n * K + k] = (bf16_t)f2bf(W[i] * (g ? g[k] : 1.f)); }
}
__device__ __forceinline__ void norm_rows(const float* X, bf16_t* O, int rows, int gw, int NGW, int lane) {
    for (int r = gw; r < rows; r += NGW) {
        const f32x4* xr = (const f32x4*)(X + (size_t)r * D) + lane; f32x4 v[4]; float s = 0.f;
#pragma unroll
        for (int j = 0; j < 4; ++j) { v[j] = xr[64 * j]; s += (v[j][0] * v[j][0] + v[j][1] * v[j][1]) + (v[j][2] * v[j][2] + v[j][3] * v[j][3]); }
        const float rs = rsqrtf(wave_sum(s) * (1.f / D) + EPS);
        u32x2* o = (u32x2*)(O + (size_t)r * D) + lane;
#pragma unroll
        for (int j = 0; j < 4; ++j) o[64 * j] = (u32x2){pk2(v[j][0] * rs, v[j][1] * rs), pk2(v[j][2] * rs, v[j][3] * rs)};
    }
}

__global__ void __launch_bounds__(NTHREADS, 2) fwd(Args a) {
    extern __shared__ __attribute__((aligned(16))) unsigned char lds[];
    const int tid = threadIdx.x, lane = tid & 63, wave = tid >> 6;
    const int G = gridDim.x, bx = blockIdx.x;
    const size_t gt = (size_t)bx * NTHREADS + tid, GT = (size_t)G * NTHREADS;
    const int gw = bx * NWAVES + wave, NGW = G * NWAVES;
    unsigned char* ws = a.ws;
    unsigned* ctl = (unsigned*)(ws + WS_CTL);
    float* rss1 = (float*)(ctl + CW_RSS1); float* rss2 = (float*)(ctl + CW_RSS2); float* rss3 = (float*)(ctl + CW_RSS3);
    bf16_t* Win_t = (bf16_t*)(ws + WS_WIN); bf16_t* Wckv_t = (bf16_t*)(ws + WS_WCKV); bf16_t* Wo2_t = (bf16_t*)(ws + WS_WO2);
    bf16_t* Wcq_t = (bf16_t*)(ws + WS_WCQ); bf16_t* Wco_t = (bf16_t*)(ws + WS_WCO); bf16_t* Wup_t = (bf16_t*)(ws + WS_WUP); bf16_t* Wdn_t = (bf16_t*)(ws + WS_WDN);
    bf16_t* HM = (bf16_t*)(ws + WS_HM); bf16_t* MK = (bf16_t*)(ws + WS_MK); bf16_t* MV = (bf16_t*)(ws + WS_MV);
    bf16_t* XN0 = (bf16_t*)(ws + WS_XN0); bf16_t* Qb = (bf16_t*)(ws + WS_Q); bf16_t* Kb = (bf16_t*)(ws + WS_K); bf16_t* Vb = (bf16_t*)(ws + WS_V); bf16_t* Ub = (bf16_t*)(ws + WS_U);
    bf16_t* A2 = (bf16_t*)(ws + WS_A2); bf16_t* XB = (bf16_t*)(ws + WS_XB); bf16_t* CQ = (bf16_t*)(ws + WS_CQ); bf16_t* OC = (bf16_t*)(ws + WS_OC); bf16_t* Hb = (bf16_t*)(ws + WS_H);
    float* X = a.out;

    volatile LAS unsigned* MISC = (volatile LAS unsigned*)((LAS unsigned char*)lds + 131072);
    if (tid < 32) MISC[tid] = 0u;
    __syncthreads();
    XcdBarrier bar; bar.bar = ctl + CW_BAR; bar.x = 0; bar.st = nullptr;
    if (MK_N_LAUNCHES == 1) bar = xcd_barrier_post(ctl + CW_BAR, MISC + 8);
    const int lo = a.ph_lo, hi = a.ph_hi;
#define IN(k) (lo <= (k) && (k) < hi)
#define SEAM(k) do { if (IN(k) && IN((k) + 1)) xcd_barrier(bar); } while (0)

    if (IN(0)) {
        conv_weight(a.w_in, a.g_mix, D, INW, Win_t, gt, GT);
        conv_weight(a.w_ck, a.g_mem, D, D, Wckv_t, gt, GT);
        conv_weight(a.w_cv, a.g_mem, D, D, Wckv_t + (size_t)D * D, gt, GT);
        conv_weight(a.w_cq, a.g_cross, D, D, Wcq_t, gt, GT);
        conv_weight(a.w_co, nullptr, D, D, Wco_t, gt, GT);
        conv_weight(a.w_up, a.g_ffn, D, DFF, Wup_t, gt, GT);
        conv_weight(a.w_down, nullptr, DFF, D, Wdn_t, gt, GT);
        for (size_t i = gt; i < (size_t)AW * D; i += GT) { const int k = (int)(i / D), n = (int)(i % D); Wo2_t[(size_t)n * D + k] = (bf16_t)f2bf(a.w_out[i]); }
        for (size_t i = gt; i < (size_t)PW * D; i += GT) {
            const int cc = (int)(i / D), n = (int)(i % D), g = cc / 128, c = cc % 128; float s = 0.f;
            for (int e = 0; e < 128; ++e) s += a.w_pool[((size_t)g * 128 + c) * 128 + e] * a.pool_scale[g * 128 + e] * a.w_out[(size_t)(AW + g * 128 + e) * D + n];
            Wo2_t[(size_t)n * D + AW + cc] = (bf16_t)f2bf(s);
        }
        norm_rows(a.x_prompt, XN0, MP, gw, NGW, lane);
        norm_rows(a.x_sample, XN0 + (size_t)MP * D, MS, gw, NGW, lane);
        norm_rows(a.mem_prompt, HM, BATCH * NMEM, gw, NGW, lane);
        for (size_t i = gt; i < (size_t)DEC_B * (WIN - DEC_T) * KVW; i += GT) {
            const int b = (int)(i / ((WIN - DEC_T) * KVW)), r = (int)(i % ((WIN - DEC_T) * KVW));
            a.out[O_WKS + (size_t)b * WIN * KVW + r] = a.cache_win_k[(size_t)b * WIN * KVW + DEC_T * KVW + r];
            a.out[O_WVS + (size_t)b * WIN * KVW + r] = a.cache_win_v[(size_t)b * WIN * KVW + DEC_T * KVW + r];
        }
        for (size_t i = gt; i < (size_t)DEC_B * (PHIST - DEC_T) * PW; i += GT) {
            const int b = (int)(i / ((PHIST - DEC_T) * PW)), r = (int)(i % ((PHIST - DEC_T) * PW));
            a.out[O_PS + (size_t)b * PHIST * PW + r] = a.state_pool[(size_t)b * PHIST * PW + DEC_T * PW + r];
        }
    }
    SEAM(0);
    if (IN(1)) {
        gemm_naive(XN0, D, Win_t, D, M, INW, D, EpiProj{Qb, Kb, Vb, Ub, a.out});
        gemm_naive(HM, D, Wckv_t, D, BATCH * NMEM, 2 * D, D, EpiMemKV{MK, MV, a.out});
    }
    SEAM(1);
    if (IN(2)) {
        for (size_t task = gt; task < (size_t)NH * M; task += GT) {
            const int h = (int)(task / M), row = (int)(task % M), kvh = h / 4;
            const float slope = exp2f(-(float)(h + 1)) * LOG2E, sink = a.attn_sinks[h] * LOG2E;
            float q[HD], o[HD];
#pragma unroll
            for (int d = 0; d < HD; ++d) { q[d] = bf2f(Qb[(size_t)row * AW + h * HD + d]); o[d] = 0.f; }
            float m = sink, l = 1.f;
            const bool samp = row >= MP;
            int b, t; if (!samp) { b = row / SEQ; t = row % SEQ; } else { b = (row - MP) / DEC_T; t = (row - MP) % DEC_T; }
            for (int i = 0; i <= WIN; ++i) {
                if (!samp && t - i < 0) break;
                const bool cached = samp && i > t;
                const int j = WIN + t - i;
                const bf16_t* kp = Kb + (size_t)(cached ? row : row - i) * KVW + kvh * HD; const bf16_t* vp = Vb + (size_t)(cached ? row : row - i) * KVW + kvh * HD;
                const float* kc = a.cache_win_k + ((size_t)b * WIN + (cached ? j : 0)) * KVW + kvh * HD; const float* vc = a.cache_win_v + ((size_t)b * WIN + (cached ? j : 0)) * KVW + kvh * HD;
                float s = 0.f;
                if (cached) {
#pragma unroll
                    for (int d = 0; d < HD; ++d) s += q[d] * kc[d];
                } else {
#pragma unroll
                    for (int d = 0; d < HD; ++d) s += q[d] * bf2f(kp[d]);
                }
                s -= slope * (float)i;
                if (s > m) { const float f = exp2f(m - s); l *= f;
#pragma unroll
                    for (int d = 0; d < HD; ++d) o[d] *= f;
                    m = s; }
                const float p = exp2f(s - m); l += p;
                if (cached) {
#pragma unroll
                    for (int d = 0; d < HD; ++d) o[d] += p * vc[d];
                } else {
#pragma unroll
                    for (int d = 0; d < HD; ++d) o[d] += p * bf2f(vp[d]);
                }
            }
            const float il = 1.f / l;
#pragma unroll
            for (int d = 0; d < HD; d += 2) *(unsigned*)(A2 + (size_t)row * D + h * HD + d) = pk2(o[d] * il, o[d + 1] * il);
        }
        for (size_t task = gt; task < (size_t)M * PW; task += GT) {
            const int row = (int)(task / PW), c = (int)(task % PW), w = 2 << (c / 128);
            const bool samp = row >= MP; float s = 0.f, cnt;
            if (!samp) { const int t = row % SEQ; for (int i = 0; i < w; ++i) if (t - i >= 0) s += bf2f(Ub[(size_t)(row - i) * PW + c]); cnt = (float)(t + 1 < w ? t + 1 : w); }
            else { const int b = (row - MP) / DEC_T, t = (row - MP) % DEC_T;
                for (int i = 0; i < w; ++i) { const int ti = t - i; s += ti >= 0 ? bf2f(Ub[(size_t)(row - i) * PW + c]) : a.state_pool[((size_t)b * PHIST + (PHIST + ti)) * PW + c]; } cnt = (float)w; }
            A2[(size_t)row * D + AW + c] = (bf16_t)f2bf(s / cnt - bf2f(Ub[(size_t)row * PW + c]));
        }
    }
    SEAM(2);
    if (IN(3)) {
        gemm_naive(A2, D, Wo2_t, D, MP, D, D, EpiResid{a.x_prompt, X, XB, rss1});
        gemm_naive(A2 + (size_t)MP * D, D, Wo2_t, D, MS, D, D, EpiResid{a.x_sample, X + (size_t)MP * D, XB + (size_t)MP * D, rss1 + MP});
    }
    SEAM(3);
    if (IN(4)) gemm_naive(XB, D, Wcq_t, D, M, D, D, EpiRowScale<0>{CQ, D, rss1, (1.0f / 16.0f) * LOG2E});
    SEAM(4);
    if (IN(5)) {
        LAS float* qs = (LAS float*)lds + wave * 512; LAS float* ps = qs + 256;
        for (int task = gw; task < M * NCH; task += NGW) {
            const int row = task / NCH, h = task % NCH; const bool samp = row >= MP;
            const int b = samp ? (row - MP) / DEC_T : row / SEQ;
            { const u32x2 w = *(const u32x2*)(CQ + (size_t)row * D + h * CHD + lane * 4);
              qs[lane * 4 + 0] = bf2f((bf16_t)(w[0] & 0xffff)); qs[lane * 4 + 1] = bf2f((bf16_t)(w[0] >> 16)); qs[lane * 4 + 2] = bf2f((bf16_t)(w[1] & 0xffff)); qs[lane * 4 + 3] = bf2f((bf16_t)(w[1] >> 16)); }
            float sc[4]; float mx = -3.0e38f;
#pragma unroll
            for (int mm = 0; mm < 4; ++mm) {
                const int m = mm * 64 + lane; float s = 0.f;
                if (!samp) { const bf16_t* kp = MK + ((size_t)b * NMEM + m) * D + h * CHD; for (int d = 0; d < CHD; ++d) s += qs[d] * bf2f(kp[d]); }
                else { const float* kp = a.cache_mem_k + (((size_t)b * NMEM + m) * NCH + h) * CHD; for (int d = 0; d < CHD; ++d) s += qs[d] * kp[d]; }
                sc[mm] = s; mx = fmaxf(mx, s);
            }
            mx = wave_max(mx); float sum = 0.f;
#pragma unroll
            for (int mm = 0; mm < 4; ++mm) { const float p = exp2f(sc[mm] - mx); sum += p; ps[mm * 64 + lane] = p; }
            sum = wave_sum(sum);
            float o[4] = {0.f, 0.f, 0.f, 0.f};
            if (!samp) { const bf16_t* vp = MV + (size_t)b * NMEM * D + h * CHD + lane * 4;
                for (int m = 0; m < NMEM; ++m) { const float p = ps[m]; const u32x2 w = *(const u32x2*)(vp + (size_t)m * D);
                    o[0] += p * bf2f((bf16_t)(w[0] & 0xffff)); o[1] += p * bf2f((bf16_t)(w[0] >> 16)); o[2] += p * bf2f((bf16_t)(w[1] & 0xffff)); o[3] += p * bf2f((bf16_t)(w[1] >> 16)); } }
            else { const float* vp = a.cache_mem_v + ((size_t)b * NMEM * NCH + h) * CHD + lane * 4;
                for (int m = 0; m < NMEM; ++m) { const float p = ps[m]; const f32x4 w = *(const f32x4*)(vp + (size_t)m * NCH * CHD);
                    o[0] += p * w[0]; o[1] += p * w[1]; o[2] += p * w[2]; o[3] += p * w[3]; } }
            const float il = 1.f / sum;
            *(u32x2*)(OC + (size_t)row * D + h * CHD + lane * 4) = (u32x2){pk2(o[0] * il, o[1] * il), pk2(o[2] * il, o[3] * il)};
        }
    }
    SEAM(5);
    if (IN(6)) gemm_naive(OC, D, Wco_t, D, M, D, D, EpiResid{X, X, XB, rss2});
    SEAM(6);
    if (IN(7)) gemm_naive(XB, D, Wup_t, D, M, DFF, D, EpiRowScale<1>{Hb, DFF, rss2, 1.0f});
    SEAM(7);
    if (IN(8)) gemm_naive(Hb, DFF, Wdn_t, DFF, M, D, DFF, EpiResid{X, X, nullptr, rss3});
    SEAM(8);
    if (IN(9)) {
        for (int r = gw; r < M; r += NGW) {
            const float rs = rsqrtf(rss3[r] * (1.f / D) + EPS);
            f32x4* xr = (f32x4*)(X + (size_t)r * D) + lane; const f32x4* gp = (const f32x4*)a.g_final + lane;
#pragma unroll
            for (int j = 0; j < 4; ++j) xr[64 * j] = xr[64 * j] * rs * gp[64 * j];
        }
    }
#undef IN
#undef SEAM
}

constexpr int N_PHASES = 10;
extern "C" void kernel_launch(void* const* d_in, const int* in_sizes, int n_in, void* d_out, int out_size, void* d_ws, size_t ws_size, hipStream_t stream) {
    static int grid = 0;
    if (grid == 0) {
        if (n_in != 24 || in_sizes[0] != MP * D || out_size != (int)O_END || ws_size < WS_END) {
            fprintf(stderr, "kernel_launch: unexpected shapes: n_in %d in0 %d out %d ws %zu (need %zu)\n", n_in, n_in > 0 ? in_sizes[0] : -1, out_size, ws_size, (size_t)WS_END); grid = -1; return; }
        int dev = 0, cus = 0, per_cu = 0;
        if (hipGetDevice(&dev) != hipSuccess || hipDeviceGetAttribute(&cus, hipDeviceAttributeMultiprocessorCount, dev) != hipSuccess) { grid = -1; return; }
        if (hipFuncSetAttribute((const void*)fwd, hipFuncAttributeMaxDynamicSharedMemorySize, LDS_BYTES) != hipSuccess) { fprintf(stderr, "kernel_launch: hipFuncSetAttribute failed\n"); grid = -1; return; }
        if (hipOccupancyMaxActiveBlocksPerMultiprocessor(&per_cu, (const void*)fwd, NTHREADS, LDS_BYTES) != hipSuccess || per_cu < 1) { fprintf(stderr, "kernel_launch: occupancy query says %d\n", per_cu); grid = -1; (void)hipGetLastError(); return; }
        grid = cus;
    }
    if (grid < 0) return;
    (void)hipMemsetAsync((char*)d_ws + WS_CTL, 0, CTL_ZERO_BYTES, stream);
    Args a{};
    const float** p = (const float**)&a;
    for (int i = 0; i < 24; ++i) p[i] = (const float*)d_in[i];
    a.out = (float*)d_out; a.ws = (unsigned char*)d_ws;
    if (MK_N_LAUNCHES == 1) { a.ph_lo = 0; a.ph_hi = N_PHASES; hipLaunchKernelGGL(fwd, dim3(grid), dim3(NTHREADS), LDS_BYTES, stream, a); }
    else for (int ph = 0; ph < N_PHASES; ++ph) { a.ph_lo = ph; a.ph_hi = ph + 1; hipLaunchKernelGGL(fwd, dim3(grid), dim3(NTHREADS), LDS_BYTES, stream, a); }
}
```

```cpp
#include <hip/hip_runtime.h>
#include <cstdio>
#include <cstdint>

#ifndef MK_N_LAUNCHES
#define MK_N_LAUNCHES 1
#endif

constexpr int D = 1024, BATCH = 4, SEQ = 4096, DEC_B = 128, DEC_T = 8, PAST = 16384;
constexpr int HD = 64, AW = 512, NH = 8, NKV = 2, KVW = 128, WIN = 128, PW = 512, PHIST = 15, INW = 1280;
constexpr int NMEM = 256, NCH = 4, CHD = 256, DFF = 4096;
constexpr int MP = BATCH * SEQ, MS = DEC_B * DEC_T, M = MP + MS;
constexpr float EPS = 1e-5f;
constexpr float LOG2E = 1.4426950408889634f;

constexpr size_t O_YP = 0, O_YS = O_YP + (size_t)MP * D, O_WKP = O_YS + (size_t)MS * D, O_WVP = O_WKP + (size_t)BATCH * WIN * KVW,
                 O_PP = O_WVP + (size_t)BATCH * WIN * KVW, O_MKP = O_PP + (size_t)BATCH * PHIST * PW, O_MVP = O_MKP + (size_t)BATCH * NMEM * D,
                 O_WKS = O_MVP + (size_t)BATCH * NMEM * D, O_WVS = O_WKS + (size_t)DEC_B * WIN * KVW, O_PS = O_WVS + (size_t)DEC_B * WIN * KVW,
                 O_END = O_PS + (size_t)DEC_B * PHIST * PW;
static_assert(O_END == 25262080, "output size");

constexpr size_t MiB = 1u << 20;
constexpr size_t WS_CTL = 0, CTL_ZERO_BYTES = 1 * MiB;
constexpr size_t WS_WIN = 2 * MiB;
constexpr size_t WS_WCKV = 5 * MiB;
constexpr size_t WS_WO2 = 9 * MiB;
constexpr size_t WS_WCQ = 11 * MiB, WS_WCO = 13 * MiB;
constexpr size_t WS_WUP = 15 * MiB;
constexpr size_t WS_WDN = 23 * MiB;
constexpr size_t WS_HM = 31 * MiB;
constexpr size_t WS_MK = 33 * MiB, WS_MV = 35 * MiB;
constexpr size_t WS_MVT = 36 * MiB + MiB;
constexpr size_t WS_XN0 = 40 * MiB;
constexpr size_t WS_Q = 74 * MiB;
constexpr size_t WS_K = 91 * MiB, WS_V = 96 * MiB;
constexpr size_t WS_U = 101 * MiB;
constexpr size_t WS_A2 = 118 * MiB;
constexpr size_t WS_XB = 152 * MiB;
constexpr size_t WS_CQ = 186 * MiB;
constexpr size_t WS_OC = 220 * MiB;
constexpr size_t WS_P = 254 * MiB;
constexpr size_t WS_H = 286 * MiB;
constexpr size_t WS_END = 422 * MiB;
constexpr int CW_BAR = 4096;
constexpr int CW_RSS1 = 32768, CW_RSS2 = CW_RSS1 + M, CW_RSS3 = CW_RSS2 + M;
static_assert((CW_RSS3 + M) * 4 <= (int)CTL_ZERO_BYTES, "ctl");

constexpr int LDS_BYTES = 147456;
constexpr int NTHREADS = 512, NWAVES = 8;

typedef unsigned short bf16_t;
typedef short bf16x8 __attribute__((ext_vector_type(8)));
typedef float f32x4 __attribute__((ext_vector_type(4)));
typedef unsigned u32x2 __attribute__((ext_vector_type(2)));
typedef unsigned u32x4 __attribute__((ext_vector_type(4)));
#define LAS __attribute__((address_space(3)))

__device__ __forceinline__ unsigned f2bf(float f) { unsigned u = __builtin_bit_cast(unsigned, f); return (u + 0x7fffu + ((u >> 16) & 1u)) >> 16; }
__device__ __forceinline__ unsigned pk2(float lo, float hi) { return f2bf(lo) | (f2bf(hi) << 16); }
__device__ __forceinline__ float bf2f(bf16_t h) { return __builtin_bit_cast(float, (unsigned)h << 16); }
__device__ __forceinline__ float wave_sum(float v) {
#pragma unroll
    for (int o = 1; o < 64; o <<= 1) v += __shfl_xor(v, o);
    return v;
}
__device__ __forceinline__ float wave_max(float v) {
#pragma unroll
    for (int o = 1; o < 64; o <<= 1) v = fmaxf(v, __shfl_xor(v, o));
    return v;
}

#define XB_TMO      128
#define XB_XCNT(j)  (256  + 64 * (j))
#define XB_XSUB(j)  (1280 + 64 * (j))
#define XB_XGEN(j)  (2304 + 64 * (j))
#define XB_TOP      3328
#define XB_TOPGEN   3392
#define XCD_BAR_WORDS 3456
#define XB_SPIN_CAP (1u << 18)
__device__ __forceinline__ unsigned xb_ld(unsigned* p)              { return __hip_atomic_load(p, __ATOMIC_RELAXED, __HIP_MEMORY_SCOPE_AGENT); }
__device__ __forceinline__ unsigned xb_add(unsigned* p, unsigned v) { return __hip_atomic_fetch_add(p, v, __ATOMIC_RELAXED, __HIP_MEMORY_SCOPE_AGENT); }
__device__ __forceinline__ unsigned xb_xcc_id() { return (unsigned)__builtin_amdgcn_s_getreg((3 << 11) | 20) & 0xFu; }
#define XB_SPIN(cond, bar) do { unsigned _sp = 0; while (cond) { __builtin_amdgcn_s_sleep(1); \
    if ((++_sp & 255u) == 0u) { if (xb_ld(&(bar)[XB_TMO])) break; if (_sp > XB_SPIN_CAP) { atomicAdd(&(bar)[XB_TMO], 1u); break; } } } } while (0)
struct XcdBarrier { unsigned* bar; unsigned x; volatile LAS unsigned* st; };
__device__ __forceinline__ XcdBarrier xcd_barrier_post(unsigned* bar, volatile LAS unsigned* st) {
    XcdBarrier b; b.bar = bar; b.x = xb_xcc_id(); b.st = st;
    if (threadIdx.x == 0) (void)xb_add(&bar[XB_XCNT(b.x)], 1u);
    return b;
}
__device__ __forceinline__ void xcd_barrier_complete(unsigned* bar, unsigned x, unsigned& nloc, unsigned& nx) {
    const unsigned G = gridDim.x * gridDim.y * gridDim.z;
    unsigned sum, cnt, mine, sp = 0u;
    for (;;) {
        sum = 0u; cnt = 0u; mine = 0u;
#pragma unroll
        for (unsigned j = 0; j < 16; ++j) { const unsigned c = xb_ld(&bar[XB_XCNT(j)]); sum += c; cnt += (c > 0u) ? 1u : 0u; mine = (j == x) ? c : mine; }
        if (sum == G) break;
        __builtin_amdgcn_s_sleep(1);
        if ((++sp & 255u) == 0u) { if (xb_ld(&bar[XB_TMO])) break; if (sp > XB_SPIN_CAP) { atomicAdd(&bar[XB_TMO], 1u); break; } }
    }
    nloc = mine > 0u ? mine : 1u; nx = cnt > 0u ? cnt : 1u;
}
__device__ __forceinline__ void xcd_barrier(const XcdBarrier& b) {
    asm volatile("s_waitcnt vmcnt(0)" ::: "memory");
    __syncthreads();
    if (threadIdx.x == 0) {
        unsigned* bar = b.bar;
        __builtin_amdgcn_s_waitcnt(0);
        unsigned nloc = b.st[0], nx = b.st[1];
        if (nloc == 0u) { xcd_barrier_complete(bar, b.x, nloc, nx); b.st[0] = nloc; b.st[1] = nx; }
        const unsigned old = xb_add(&bar[XB_XSUB(b.x)], 1u);
        const unsigned gen = old / nloc;
        if (old + 1u == (gen + 1u) * nloc) {
            __builtin_amdgcn_fence(__ATOMIC_RELEASE, "agent");
            asm volatile("s_waitcnt vmcnt(0)" ::: "memory");
            const unsigned og = xb_add(&bar[XB_TOP], 1u);
            const unsigned tg = og / nx;
            if (og + 1u == (tg + 1u) * nx) xb_add(&bar[XB_TOPGEN], 1u);
            else XB_SPIN(xb_ld(&bar[XB_TOPGEN]) == tg, bar);
            __builtin_amdgcn_fence(__ATOMIC_ACQUIRE, "agent");
            xb_add(&bar[XB_XGEN(b.x)], 1u);
            asm volatile("s_waitcnt vmcnt(0)" ::: "memory");
        } else {
            XB_SPIN(xb_ld(&bar[XB_XGEN(b.x)]) == gen, bar);
            __builtin_amdgcn_fence(__ATOMIC_ACQUIRE, "agent");
            asm volatile("s_waitcnt vmcnt(0)" ::: "memory");
        }
    }
    __syncthreads();
}

struct Args {
    const float *x_prompt, *x_sample, *cache_win_k, *cache_win_v, *state_pool, *cache_mem_k, *cache_mem_v, *mem_prompt;
    const float *g_mix, *w_in, *attn_sinks, *w_pool, *pool_scale, *w_out, *g_cross, *g_mem, *w_cq, *w_ck, *w_cv, *w_co, *g_ffn, *w_up, *w_down, *g_final;
    float* out; unsigned char* ws; int ph_lo, ph_hi;
};

template <class Epi>
__device__ __forceinline__ void gemm_naive(const bf16_t* A, int lda, const bf16_t* Bt, int ldb, int Mr, int N, int K, const Epi& epi) {
    const int wid = threadIdx.x >> 6, lane = threadIdx.x & 63, wr = wid >> 2, wc = wid & 3, fr = lane & 15, fq = lane >> 4;
    const int tn_n = N / 256, ntiles = (Mr / 128) * tn_n;
    for (int t = blockIdx.x; t < ntiles; t += gridDim.x) {
        const int tm = t / tn_n, tn = t % tn_n;
        const int r0 = tm * 128 + wr * 64, c0 = tn * 256 + wc * 64;
        f32x4 acc[4][4];
#pragma unroll
        for (int i = 0; i < 4; ++i)
#pragma unroll
            for (int j = 0; j < 4; ++j) acc[i][j] = (f32x4){0.f, 0.f, 0.f, 0.f};
        const bf16_t* ap = A + (size_t)(r0 + fr) * lda + fq * 8;
        const bf16_t* bp = Bt + (size_t)(c0 + fr) * ldb + fq * 8;
        for (int k0 = 0; k0 < K; k0 += 32) {
            bf16x8 a[4], b[4];
#pragma unroll
            for (int i = 0; i < 4; ++i) a[i] = *(const bf16x8*)(ap + (size_t)(i * 16) * lda + k0);
#pragma unroll
            for (int j = 0; j < 4; ++j) b[j] = *(const bf16x8*)(bp + (size_t)(j * 16) * ldb + k0);
#pragma unroll
            for (int i = 0; i < 4; ++i)
#pragma unroll
                for (int j = 0; j < 4; ++j) acc[i][j] = __builtin_amdgcn_mfma_f32_16x16x32_bf16(b[j], a[i], acc[i][j], 0, 0, 0);
        }
        epi(acc, r0 + fr, c0 + 4 * fq, fq);
    }
}

struct EpiProj {
    bf16_t *Q, *Kb, *Vb, *U; float* out;
    __device__ __forceinline__ void operator()(const f32x4 (&acc)[4][4], int row0, int col0, int) const {
#pragma unroll
        for (int i = 0; i < 4; ++i) {
            const int row = row0 + 16 * i;
            const bool samp = row >= MP;
            int b, t; if (!samp) { b = row / SEQ; t = row % SEQ; } else { b = (row - MP) / DEC_T; t = (row - MP) % DEC_T; }
#pragma unroll
            for (int j = 0; j < 4; ++j) {
                const int col = col0 + 16 * j; const f32x4 v = acc[i][j];
                if (col < AW) {
                    const float s = 0.125f * LOG2E;
                    *(u32x2*)(Q + (size_t)row * AW + col) = (u32x2){pk2(v[0] * s, v[1] * s), pk2(v[2] * s, v[3] * s)};
                } else if (col < AW + 2 * KVW) {
                    const bool isv = col >= AW + KVW; const int c = col - AW - (isv ? KVW : 0);
                    *(u32x2*)((isv ? Vb : Kb) + (size_t)row * KVW + c) = (u32x2){pk2(v[0], v[1]), pk2(v[2], v[3])};
                    if (!samp) { if (t >= SEQ - WIN) *(f32x4*)(out + (isv ? O_WVP : O_WKP) + ((size_t)b * WIN + (t - (SEQ - WIN))) * KVW + c) = v; }
                    else *(f32x4*)(out + (isv ? O_WVS : O_WKS) + ((size_t)b * WIN + (WIN - DEC_T + t)) * KVW + c) = v;
                } else {
                    const int c = col - AW - 2 * KVW;
                    *(u32x2*)(U + (size_t)row * PW + c) = (u32x2){pk2(v[0], v[1]), pk2(v[2], v[3])};
                    if (!samp) { if (t >= SEQ - PHIST) *(f32x4*)(out + O_PP + ((size_t)b * PHIST + (t - (SEQ - PHIST))) * PW + c) = v; }
                    else *(f32x4*)(out + O_PS + ((size_t)b * PHIST + (PHIST - DEC_T + t)) * PW + c) = v;
                }
            }
        }
    }
};
struct EpiMemKV {
    bf16_t *MK, *MV; float* out;
    __device__ __forceinline__ void operator()(const f32x4 (&acc)[4][4], int row0, int col0, int) const {
#pragma unroll
        for (int i = 0; i < 4; ++i)
#pragma unroll
            for (int j = 0; j < 4; ++j) {
                const int row = row0 + 16 * i, col = col0 + 16 * j; const f32x4 v = acc[i][j];
                const bool isv = col >= D; const int c = col - (isv ? D : 0);
                *(f32x4*)(out + (isv ? O_MVP : O_MKP) + (size_t)row * D + c) = v;
                *(u32x2*)((isv ? MV : MK) + (size_t)row * D + c) = (u32x2){pk2(v[0], v[1]), pk2(v[2], v[3])};
            }
    }
};
struct EpiResid {
    const float* base; float* X; bf16_t* XB; float* rss;
    __device__ __forceinline__ void operator()(const f32x4 (&acc)[4][4], int row0, int col0, int fq) const {
#pragma unroll
        for (int i = 0; i < 4; ++i) {
            const int row = row0 + 16 * i; float s = 0.f;
#pragma unroll
            for (int j = 0; j < 4; ++j) {
                const int col = col0 + 16 * j;
                const f32x4 v = *(const f32x4*)(base + (size_t)row * D + col) + acc[i][j];
                *(f32x4*)(X + (size_t)row * D + col) = v;
                if (XB) *(u32x2*)(XB + (size_t)row * D + col) = (u32x2){pk2(v[0], v[1]), pk2(v[2], v[3])};
                s += (v[0] * v[0] + v[1] * v[1]) + (v[2] * v[2] + v[3] * v[3]);
            }
            s += __shfl_xor(s, 16); s += __shfl_xor(s, 32);
            if (fq == 0) atomicAdd(rss + row, s);
        }
    }
};
template <int ACT>
struct EpiRowScale {
    bf16_t* O; int ldo; const float* rss; float scale;
    __device__ __forceinline__ void operator()(const f32x4 (&acc)[4][4], int row0, int col0, int) const {
#pragma unroll
        for (int i = 0; i < 4; ++i) {
            const int row = row0 + 16 * i; const float rs = rsqrtf(rss[row] * (1.0f / D) + EPS);
#pragma unroll
            for (int j = 0; j < 4; ++j) {
                const int col = col0 + 16 * j; f32x4 v = acc[i][j] * rs;
                if (ACT == 1) {
#pragma unroll
                    for (int e = 0; e < 4; ++e) { const float r = fmaxf(v[e], 0.f); v[e] = r * r; }
                }
                v = v * scale;
                *(u32x2*)(O + (size_t)row * ldo + col) = (u32x2){pk2(v[0], v[1]), pk2(v[2], v[3])};
            }
        }
    }
};


namespace pg8 {
constexpr int BM = 256, BK = 64, HALF = 128, HTB = HALF * BK * 2, STAGE_BYTES = 8 * HTB, NXCD = 8, WGM = 8;
__host__ __device__ __forceinline__ int lds_byte(int r, int c) { const int st = (r >> 4) * 2 + (c >> 5), rr = r & 15, cc = c & 31, ob = rr * 64 + cc * 2; return st * 1024 + (ob ^ (((ob >> 9) & 1) << 5)); }
__host__ __device__ __forceinline__ void stage_rc(int b, int& R, int& C) { const int st = b / 1024, sb = b % 1024, swz = sb ^ (((sb >> 9) & 1) << 5); R = (st >> 1) * 16 + swz / 64; C = (st & 1) * 32 + (swz % 64) / 2; }
__host__ __device__ __forceinline__ int perm32(int rho) { const int n = rho >> 4, i = rho & 15; return 8 * (i >> 2) + 4 * n + (i & 3); }

struct Unit { const char* a; const char* b; int pm, pn, kind; };
struct Seg { const bf16_t* A; const bf16_t* B; int nM, nN, kind; };
template <int NSEG> struct SegOrder {
    Seg s[NSEG]; int G, c; size_t pa, pb;
    __device__ __forceinline__ bool next(int i, Unit& u) const {
        long L = (long)i * G + c;
#pragma unroll
        for (int k = 0; k < NSEG; ++k) {
            const int nM = s[k].nM, nN = s[k].nN, nwg = nM * nN;
            if (L < nwg) {
                int wgid = (int)L; { const int q = nwg / NXCD, r = nwg % NXCD, xcd = wgid % NXCD, off = wgid / NXCD; wgid = (xcd < r ? xcd * (q + 1) : r * (q + 1) + (xcd - r) * q) + off; }
                const int nig = WGM * nN, gid = wgid / nig, fm = gid * WGM, gsz = (nM - fm) < WGM ? (nM - fm) : WGM;
                u.pm = fm + ((wgid % nig) % gsz); u.pn = (wgid % nig) / gsz; u.kind = s[k].kind;
                u.a = (const char*)s[k].A + (size_t)u.pm * pa; u.b = (const char*)s[k].B + (size_t)u.pn * pb; return true;
            }
            L -= nwg;
        }
        return false;
    }
};
__device__ __forceinline__ unsigned cvt_pk_bf16(float lo, float hi) { unsigned r; asm volatile("v_cvt_pk_bf16_f32 %0, %1, %2" : "=v"(r) : "v"(lo), "v"(hi)); return r; }
__device__ __forceinline__ u32x4 pack8(const f32x4 v0, const f32x4 v1) { u32x4 w; w.x = cvt_pk_bf16(v0[0], v0[1]); w.y = cvt_pk_bf16(v0[2], v0[3]); w.z = cvt_pk_bf16(v1[0], v1[1]); w.w = cvt_pk_bf16(v1[2], v1[3]); return w; }

template <class Epi, class Sched, bool ALIGN_EPI, bool SP2>
__device__ __forceinline__ void gemm_phase(LAS unsigned char* lds, const int lda, const int ldb, const int K, const Sched& S, const Epi& E) {
    const int tid = threadIdx.x, wid = __builtin_amdgcn_readfirstlane(tid >> 6), lane = tid & 63, wr = wid >> 2, wc = wid & 3, fr = lane & 15, fq = lane >> 4;
    const int nt = K / BK;
    unsigned voffA[2], voffB[2];
#pragma unroll
    for (int i = 0; i < 2; ++i) { int R, C; stage_rc(tid * 16 + i * 8192, R, C); const int Rb = Epi::PERM ? ((R & ~31) + perm32(R & 31)) : R;
        voffA[i] = (unsigned)(R * lda + C) * 2u; voffB[i] = (unsigned)(Rb * ldb + C) * 2u; }
    const size_t kstep = (size_t)(BK * 2);
    const size_t hstepA = (size_t)HALF * lda * 2, hstepB = (size_t)HALF * ldb * 2;
    const unsigned ldsw = (unsigned)wid * 1024u;
    const int aoff = lds_byte(wr * 64 + fr, fq * 8), boff = lds_byte(wc * 32 + fr, fq * 8);
#define PG8_SA(b, h) (((b) * 2 + (h)) * HTB)
#define PG8_SB(b, h) ((4 + (b) * 2 + (h)) * HTB)
#define PG8_STAGE(bufoff, gbase, voff) do { _Pragma("unroll") for (int _i = 0; _i < 2; ++_i) \
        __builtin_amdgcn_global_load_lds((const unsigned*)((const char*)(gbase) + (voff)[_i]), (LAS unsigned*)(lds + (bufoff) + ldsw + _i * 8192), 16, 0, 0); } while (0)
#define PG8_LDA(dst, b, h) do { _Pragma("unroll") for (int m = 0; m < 4; ++m) _Pragma("unroll") for (int k = 0; k < 2; ++k) dst[m][k] = *(const LAS bf16x8*)(lds + PG8_SA(b, h) + aoff + m * 2048 + k * 1024); } while (0)
#define PG8_LDB(dst, b, h) do { _Pragma("unroll") for (int n = 0; n < 2; ++n) _Pragma("unroll") for (int k = 0; k < 2; ++k) dst[n][k] = *(const LAS bf16x8*)(lds + PG8_SB(b, h) + boff + n * 2048 + k * 1024); } while (0)
#define PG8_MMA(ai, bj, At, Bt) do { __builtin_amdgcn_s_setprio(1); _Pragma("unroll") for (int m = 0; m < 4; ++m) _Pragma("unroll") for (int n = 0; n < 2; ++n) _Pragma("unroll") for (int k = 0; k < 2; ++k) \
        acc[ai][bj][m][n] = __builtin_amdgcn_mfma_f32_16x16x32_bf16(Bt[n][k], At[m][k], acc[ai][bj][m][n], 0, 0, 0); __builtin_amdgcn_s_setprio(0); } while (0)
#define PG8_WAIT_V(n) asm volatile("s_waitcnt vmcnt(" #n ")" ::: "memory")
#define PG8_WAIT_L(n) asm volatile("s_waitcnt lgkmcnt(" #n ")" ::: "memory")
#define PG8_BAR __builtin_amdgcn_s_barrier()
#define PG8_SCHED __builtin_amdgcn_sched_barrier(0)
    Unit cur, nxt; int ui = 0;
    if (!S.next(0, cur)) return;
    f32x4 acc[2][2][4][2];
#pragma unroll
    for (int a = 0; a < 2; ++a)
#pragma unroll
        for (int b = 0; b < 2; ++b)
#pragma unroll
            for (int m = 0; m < 4; ++m)
#pragma unroll
                for (int n = 0; n < 2; ++n) acc[a][b][m][n] = (f32x4){0.f, 0.f, 0.f, 0.f};
    bf16x8 At[4][2], B0[2][2], B1[2][2];
    const char* cA = cur.a; const char* cB = cur.b;
    if constexpr (SP2) {
        PG8_STAGE(PG8_SB(0, 0), cB, voffB); PG8_STAGE(PG8_SB(0, 1), cB + hstepB, voffB); PG8_STAGE(PG8_SA(0, 0), cA, voffA); PG8_STAGE(PG8_SA(0, 1), cA + hstepA, voffA);
        if (wr == 1) PG8_BAR;
        PG8_WAIT_V(2); PG8_BAR;
        PG8_STAGE(PG8_SB(1, 0), cB + kstep, voffB); PG8_STAGE(PG8_SA(1, 0), cA + kstep, voffA); PG8_STAGE(PG8_SB(1, 1), cB + hstepB + kstep, voffB);
        PG8_WAIT_V(6); PG8_BAR;
    } else {
        PG8_STAGE(PG8_SB(0, 0), cB, voffB); PG8_STAGE(PG8_SA(0, 0), cA, voffA); PG8_STAGE(PG8_SB(0, 1), cB + hstepB, voffB); PG8_STAGE(PG8_SA(0, 1), cA + hstepA, voffA);
        if (wr == 1) PG8_BAR;
        PG8_WAIT_V(4); PG8_BAR;
        PG8_STAGE(PG8_SB(1, 0), cB + kstep, voffB); PG8_STAGE(PG8_SA(1, 0), cA + kstep, voffA); PG8_STAGE(PG8_SB(1, 1), cB + hstepB + kstep, voffB);
        PG8_WAIT_V(6); PG8_BAR;
    }
    for (;;) {
        const bool has_next = S.next(ui + 1, nxt);
        const char* nA = has_next ? nxt.a : cA; const char* nB = has_next ? nxt.b : cB;
        for (int t = 0; t < nt; t += 2) {
            const bool last = (t == nt - 2);
            const char* a1 = cA + (size_t)(t + 1) * kstep;
            const char* a2 = last ? nA : cA + (size_t)(t + 2) * kstep; const char* b2 = last ? nB : cB + (size_t)(t + 2) * kstep;
            const char* a3 = a2 + kstep; const char* b3 = b2 + kstep;
            if constexpr (SP2) {
            PG8_LDB(B0, 0, 0); PG8_LDB(B1, 0, 1); PG8_SCHED; PG8_LDA(At, 0, 0); PG8_STAGE(PG8_SA(1, 1), a1 + hstepA, voffA);
            PG8_WAIT_V(8); PG8_WAIT_L(0); PG8_BAR; PG8_MMA(0, 0, At, B0); PG8_MMA(0, 1, At, B1); PG8_BAR; PG8_SCHED;
            PG8_LDA(At, 0, 1); PG8_STAGE(PG8_SB(0, 0), b2, voffB); PG8_STAGE(PG8_SB(0, 1), b2 + hstepB, voffB); PG8_STAGE(PG8_SA(0, 0), a2, voffA);
            PG8_WAIT_V(8); PG8_WAIT_L(0); PG8_BAR; PG8_MMA(1, 0, At, B0); PG8_MMA(1, 1, At, B1); PG8_BAR; PG8_SCHED;
            PG8_LDB(B0, 1, 0); PG8_LDB(B1, 1, 1); PG8_SCHED; PG8_LDA(At, 1, 0); PG8_STAGE(PG8_SA(0, 1), a2 + hstepA, voffA);
            PG8_WAIT_V(8); PG8_WAIT_L(0); PG8_BAR; PG8_MMA(0, 0, At, B0); PG8_MMA(0, 1, At, B1); PG8_BAR; PG8_SCHED;
            PG8_LDA(At, 1, 1); PG8_STAGE(PG8_SB(1, 0), b3, voffB); PG8_STAGE(PG8_SB(1, 1), b3 + hstepB, voffB); PG8_STAGE(PG8_SA(1, 0), a3, voffA);
            PG8_WAIT_V(8); PG8_WAIT_L(0); PG8_BAR; PG8_MMA(1, 0, At, B0); PG8_MMA(1, 1, At, B1); PG8_BAR; PG8_SCHED;
            } else {
            PG8_LDB(B0, 0, 0); PG8_SCHED; PG8_LDA(At, 0, 0); PG8_STAGE(PG8_SA(1, 1), a1 + hstepA, voffA);
            PG8_WAIT_L(8); PG8_BAR; PG8_WAIT_L(0); PG8_MMA(0, 0, At, B0); PG8_BAR; PG8_SCHED;
            PG8_LDB(B1, 0, 1); PG8_STAGE(PG8_SB(0, 0), b2, voffB);
            PG8_BAR; PG8_WAIT_L(0); PG8_MMA(0, 1, At, B1); PG8_BAR;
            PG8_LDA(At, 0, 1); PG8_STAGE(PG8_SA(0, 0), a2, voffA);
            PG8_BAR; PG8_WAIT_L(0); PG8_MMA(1, 0, At, B0); PG8_BAR; PG8_SCHED;
            PG8_STAGE(PG8_SB(0, 1), b2 + hstepB, voffB);
            PG8_WAIT_V(6); PG8_BAR; PG8_MMA(1, 1, At, B1); PG8_BAR;
            PG8_LDB(B0, 1, 0); PG8_SCHED; PG8_LDA(At, 1, 0); PG8_STAGE(PG8_SA(0, 1), a2 + hstepA, voffA);
            PG8_WAIT_L(8); PG8_BAR; PG8_WAIT_L(0); PG8_MMA(0, 0, At, B0); PG8_BAR; PG8_SCHED;
            PG8_LDB(B1, 1, 1); PG8_STAGE(PG8_SB(1, 0), b3, voffB);
            PG8_BAR; PG8_WAIT_L(0); PG8_MMA(0, 1, At, B1); PG8_BAR;
            PG8_LDA(At, 1, 1); PG8_STAGE(PG8_SA(1, 0), a3, voffA);
            PG8_BAR; PG8_WAIT_L(0); PG8_MMA(1, 0, At, B0); PG8_BAR; PG8_SCHED;
            PG8_STAGE(PG8_SB(1, 1), b3 + hstepB, voffB);
            PG8_WAIT_V(6); PG8_BAR; PG8_MMA(1, 1, At, B1); PG8_BAR;
            }
        }
        if constexpr (ALIGN_EPI) { if (wr == 0) PG8_BAR; }
        if constexpr (!Epi::AFTER_DRAIN) { E(acc, cur, wr, wc, fr, fq); }
        if (!has_next) break;
#pragma unroll
        for (int a = 0; a < 2; ++a)
#pragma unroll
            for (int b = 0; b < 2; ++b)
#pragma unroll
                for (int m = 0; m < 4; ++m)
#pragma unroll
                    for (int n = 0; n < 2; ++n) acc[a][b][m][n] = (f32x4){0.f, 0.f, 0.f, 0.f};
        cur = nxt; cA = nA; cB = nB; ++ui;
        if constexpr (ALIGN_EPI) { if (wr == 1) PG8_BAR; }
    }
    PG8_WAIT_V(0);
    if constexpr (!ALIGN_EPI) { if (wr == 0) PG8_BAR; }
    PG8_BAR;
    if constexpr (Epi::AFTER_DRAIN) { E.fused(acc, cur, wr, wc, fr, fq, lds, wid, lane); }
#undef PG8_SA
#undef PG8_SB
#undef PG8_STAGE
#undef PG8_LDA
#undef PG8_LDB
#undef PG8_MMA
#undef PG8_WAIT_V
#undef PG8_WAIT_L
#undef PG8_BAR
#undef PG8_SCHED
}

struct EpiP1 {
    static constexpr bool PERM = true, AFTER_DRAIN = false;
    bf16_t *Q, *Kb, *Vb, *U, *MK, *MV, *MVt; float* out;
    __device__ __forceinline__ void operator()(const f32x4 (&acc)[2][2][4][2], const Unit& u, int wr, int wc, int fr, int fq) const {
        const int cl = wc * 32 + 8 * fq;
        if (u.kind == 0) {
            const bool samp = u.pm >= MP / 256;
#pragma unroll
            for (int ai = 0; ai < 2; ++ai)
#pragma unroll
                for (int m = 0; m < 4; ++m) {
                    const int row = u.pm * 256 + ai * 128 + wr * 64 + m * 16 + fr;
                    int b, t; if (!samp) { b = row / SEQ; t = row % SEQ; } else { b = (row - MP) / DEC_T; t = (row - MP) % DEC_T; }
#pragma unroll
                    for (int bj = 0; bj < 2; ++bj) {
                        const f32x4 v0 = acc[ai][bj][m][0], v1 = acc[ai][bj][m][1];
                        if (u.pn < 2) { const float s = 0.125f * LOG2E; *(u32x4*)(Q + (size_t)row * AW + u.pn * 256 + bj * 128 + cl) = pack8(v0 * s, v1 * s); }
                        else if (u.pn == 2) {
                            *(u32x4*)((bj ? Vb : Kb) + (size_t)row * KVW + cl) = pack8(v0, v1);
                            float* o = nullptr;
                            if (!samp) { if (t >= SEQ - WIN) o = out + (bj ? O_WVP : O_WKP) + ((size_t)b * WIN + (t - (SEQ - WIN))) * KVW + cl; }
                            else o = out + (bj ? O_WVS : O_WKS) + ((size_t)b * WIN + (WIN - DEC_T + t)) * KVW + cl;
                            if (o) { *(f32x4*)o = v0; *(f32x4*)(o + 4) = v1; }
                        } else {
                            const int c = (u.pn - 3) * 256 + bj * 128 + cl;
                            *(u32x4*)(U + (size_t)row * PW + c) = pack8(v0, v1);
                            float* o = nullptr;
                            if (!samp) { if (t >= SEQ - PHIST) o = out + O_PP + ((size_t)b * PHIST + (t - (SEQ - PHIST))) * PW + c; }
                            else o = out + O_PS + ((size_t)b * PHIST + (PHIST - DEC_T + t)) * PW + c;
                            if (o) { *(f32x4*)o = v0; *(f32x4*)(o + 4) = v1; }
                        }
                    }
                }
        } else if (u.kind == 1) {
            const bool isv = u.pn >= 4;
#pragma unroll
            for (int ai = 0; ai < 2; ++ai)
#pragma unroll
                for (int m = 0; m < 4; ++m) {
                    const int row = u.pm * 256 + ai * 128 + wr * 64 + m * 16 + fr;
#pragma unroll
                    for (int bj = 0; bj < 2; ++bj) {
                        const f32x4 v0 = acc[ai][bj][m][0], v1 = acc[ai][bj][m][1];
                        const int c = (u.pn & 3) * 256 + bj * 128 + cl;
                        float* o = out + (isv ? O_MVP : O_MKP) + (size_t)row * D + c; *(f32x4*)o = v0; *(f32x4*)(o + 4) = v1;
                        *(u32x4*)((isv ? MV : MK) + (size_t)row * D + c) = pack8(v0, v1);
                    }
                }
        } else {
#pragma unroll
            for (int ai = 0; ai < 2; ++ai)
#pragma unroll
                for (int m = 0; m < 4; ++m) {
                    const int dd = u.pm * 256 + ai * 128 + wr * 64 + m * 16 + fr;
#pragma unroll
                    for (int bj = 0; bj < 2; ++bj) *(u32x4*)(MVt + ((size_t)u.pn * D + dd) * NMEM + bj * 128 + cl) = pack8(acc[ai][bj][m][0], acc[ai][bj][m][1]);
                }
        }
    }
};
struct EpiResidG {
    static constexpr bool PERM = true, AFTER_DRAIN = false;
    const float* baseP; const float* baseS; float* X; bf16_t* XB; float* rss;
    __device__ __forceinline__ void operator()(const f32x4 (&acc)[2][2][4][2], const Unit& u, int wr, int wc, int fr, int fq) const {
        const float* base = u.pm >= MP / 256 ? baseS : baseP;
        const int col0 = u.pn * 256 + wc * 32 + 8 * fq;
#pragma unroll
        for (int ai = 0; ai < 2; ++ai)
#pragma unroll
            for (int m = 0; m < 4; ++m) {
                const int row = u.pm * 256 + ai * 128 + wr * 64 + m * 16 + fr; float s = 0.f;
#pragma unroll
                for (int bj = 0; bj < 2; ++bj) {
                    const size_t off = (size_t)row * D + col0 + bj * 128;
                    const f32x4 v0 = *(const f32x4*)(base + off) + acc[ai][bj][m][0], v1 = *(const f32x4*)(base + off + 4) + acc[ai][bj][m][1];
                    *(f32x4*)(X + off) = v0; *(f32x4*)(X + off + 4) = v1;
                    if (XB) *(u32x4*)(XB + off) = pack8(v0, v1);
                    s += ((v0[0] * v0[0] + v0[1] * v0[1]) + (v0[2] * v0[2] + v0[3] * v0[3])) + ((v1[0] * v1[0] + v1[1] * v1[1]) + (v1[2] * v1[2] + v1[3] * v1[3]));
                }
                s += __shfl_xor(s, 16); s += __shfl_xor(s, 32);
                if (fq == 0) atomicAdd(rss + row, s);
            }
    }
};
template <int ACT>
struct EpiRowScaleG {
    static constexpr bool PERM = true, AFTER_DRAIN = false;
    bf16_t* O; int ldo; const float* rss; float scale;
    __device__ __forceinline__ void operator()(const f32x4 (&acc)[2][2][4][2], const Unit& u, int wr, int wc, int fr, int fq) const {
        const int col0 = u.pn * 256 + wc * 32 + 8 * fq;
#pragma unroll
        for (int ai = 0; ai < 2; ++ai)
#pragma unroll
            for (int m = 0; m < 4; ++m) {
                const int row = u.pm * 256 + ai * 128 + wr * 64 + m * 16 + fr;
                const float rs = rsqrtf(rss[row] * (1.0f / D) + EPS);
#pragma unroll
                for (int bj = 0; bj < 2; ++bj) {
                    f32x4 v0 = acc[ai][bj][m][0] * rs, v1 = acc[ai][bj][m][1] * rs;
                    if (ACT == 1) {
#pragma unroll
                        for (int e = 0; e < 4; ++e) { const float r0 = fmaxf(v0[e], 0.f), r1 = fmaxf(v1[e], 0.f); v0[e] = r0 * r0; v1[e] = r1 * r1; }
                    }
                    *(u32x4*)(O + (size_t)row * ldo + col0 + bj * 128) = pack8(v0 * scale, v1 * scale);
                }
            }
    }
};
}

__device__ __forceinline__ void conv_weight(const float* W, const float* g, int K, int N, bf16_t* Wt, size_t gt, size_t GT) {
    for (size_t i = gt; i < (size_t)K * N; i += GT) { const int k = (int)(i / N), n = (int)(i % N); Wt[(size_t)n * K + k] = (bf16_t)f2bf(W[i] * (g ? g[k] : 1.f)); }
}
__device__ __forceinline__ void norm_rows(const float* X, bf16_t* O, int rows, int gw, int NGW, int lane) {
    for (int r = gw; r < rows; r += NGW) {
        const f32x4* xr = (const f32x4*)(X + (size_t)r * D) + lane; f32x4 v[4]; float s = 0.f;
#pragma unroll
        for (int j = 0; j < 4; ++j) { v[j] = xr[64 * j]; s += (v[j][0] * v[j][0] + v[j][1] * v[j][1]) + (v[j][2] * v[j][2] + v[j][3] * v[j][3]); }
        const float rs = rsqrtf(wave_sum(s) * (1.f / D) + EPS);
        u32x2* o = (u32x2*)(O + (size_t)r * D) + lane;
#pragma unroll
        for (int j = 0; j < 4; ++j) o[64 * j] = (u32x2){pk2(v[j][0] * rs, v[j][1] * rs), pk2(v[j][2] * rs, v[j][3] * rs)};
    }
}

__global__ void __launch_bounds__(NTHREADS, 2) fwd(Args a) {
    extern __shared__ __attribute__((aligned(16))) unsigned char lds[];
    const int tid = threadIdx.x, lane = tid & 63, wave = tid >> 6;
    const int G = gridDim.x, bx = blockIdx.x;
    const size_t gt = (size_t)bx * NTHREADS + tid, GT = (size_t)G * NTHREADS;
    const int gw = bx * NWAVES + wave, NGW = G * NWAVES;
    unsigned char* ws = a.ws;
    unsigned* ctl = (unsigned*)(ws + WS_CTL);
    float* rss1 = (float*)(ctl + CW_RSS1); float* rss2 = (float*)(ctl + CW_RSS2); float* rss3 = (float*)(ctl + CW_RSS3);
    bf16_t* Win_t = (bf16_t*)(ws + WS_WIN); bf16_t* Wckv_t = (bf16_t*)(ws + WS_WCKV); bf16_t* Wo2_t = (bf16_t*)(ws + WS_WO2);
    bf16_t* Wcq_t = (bf16_t*)(ws + WS_WCQ); bf16_t* Wco_t = (bf16_t*)(ws + WS_WCO); bf16_t* Wup_t = (bf16_t*)(ws + WS_WUP); bf16_t* Wdn_t = (bf16_t*)(ws + WS_WDN);
    bf16_t* HM = (bf16_t*)(ws + WS_HM); bf16_t* MK = (bf16_t*)(ws + WS_MK); bf16_t* MV = (bf16_t*)(ws + WS_MV); bf16_t* MVt = (bf16_t*)(ws + WS_MVT);
    LAS unsigned char* L = (LAS unsigned char*)lds;
    bf16_t* XN0 = (bf16_t*)(ws + WS_XN0); bf16_t* Qb = (bf16_t*)(ws + WS_Q); bf16_t* Kb = (bf16_t*)(ws + WS_K); bf16_t* Vb = (bf16_t*)(ws + WS_V); bf16_t* Ub = (bf16_t*)(ws + WS_U);
    bf16_t* A2 = (bf16_t*)(ws + WS_A2); bf16_t* XB = (bf16_t*)(ws + WS_XB); bf16_t* CQ = (bf16_t*)(ws + WS_CQ); bf16_t* OC = (bf16_t*)(ws + WS_OC); bf16_t* Hb = (bf16_t*)(ws + WS_H);
    float* X = a.out;

    volatile LAS unsigned* MISC = (volatile LAS unsigned*)((LAS unsigned char*)lds + 131072);
    if (tid < 32) MISC[tid] = 0u;
    __syncthreads();
    XcdBarrier bar; bar.bar = ctl + CW_BAR; bar.x = 0; bar.st = nullptr;
    if (MK_N_LAUNCHES == 1) bar = xcd_barrier_post(ctl + CW_BAR, MISC + 8);
    const int lo = a.ph_lo, hi = a.ph_hi;
#ifndef PHASE_MASK
#define PHASE_MASK 0x3ff
#endif
#define IN(k) (((PHASE_MASK >> (k)) & 1) && lo <= (k) && (k) < hi)
#define SEAM(k) do { if (IN(k) && IN((k) + 1)) xcd_barrier(bar); } while (0)

    if (IN(0)) {
        conv_weight(a.w_in, a.g_mix, D, INW, Win_t, gt, GT);
        conv_weight(a.w_ck, a.g_mem, D, D, Wckv_t, gt, GT);
        conv_weight(a.w_cv, a.g_mem, D, D, Wckv_t + (size_t)D * D, gt, GT);
        conv_weight(a.w_cq, a.g_cross, D, D, Wcq_t, gt, GT);
        conv_weight(a.w_co, nullptr, D, D, Wco_t, gt, GT);
        conv_weight(a.w_up, a.g_ffn, D, DFF, Wup_t, gt, GT);
        conv_weight(a.w_down, nullptr, DFF, D, Wdn_t, gt, GT);
        for (size_t i = gt; i < (size_t)AW * D; i += GT) { const int k = (int)(i / D), n = (int)(i % D); Wo2_t[(size_t)n * D + k] = (bf16_t)f2bf(a.w_out[i]); }
        for (size_t i = gt; i < (size_t)PW * D; i += GT) {
            const int cc = (int)(i / D), n = (int)(i % D), g = cc / 128, c = cc % 128; float s = 0.f;
            for (int e = 0; e < 128; ++e) s += a.w_pool[((size_t)g * 128 + c) * 128 + e] * a.pool_scale[g * 128 + e] * a.w_out[(size_t)(AW + g * 128 + e) * D + n];
            Wo2_t[(size_t)n * D + AW + cc] = (bf16_t)f2bf(s);
        }
        norm_rows(a.x_prompt, XN0, MP, gw, NGW, lane);
        norm_rows(a.x_sample, XN0 + (size_t)MP * D, MS, gw, NGW, lane);
        norm_rows(a.mem_prompt, HM, BATCH * NMEM, gw, NGW, lane);
        for (size_t i = gt; i < (size_t)DEC_B * (WIN - DEC_T) * KVW; i += GT) {
            const int b = (int)(i / ((WIN - DEC_T) * KVW)), r = (int)(i % ((WIN - DEC_T) * KVW));
            a.out[O_WKS + (size_t)b * WIN * KVW + r] = a.cache_win_k[(size_t)b * WIN * KVW + DEC_T * KVW + r];
            a.out[O_WVS + (size_t)b * WIN * KVW + r] = a.cache_win_v[(size_t)b * WIN * KVW + DEC_T * KVW + r];
        }
        for (size_t i = gt; i < (size_t)DEC_B * (PHIST - DEC_T) * PW; i += GT) {
            const int b = (int)(i / ((PHIST - DEC_T) * PW)), r = (int)(i % ((PHIST - DEC_T) * PW));
            a.out[O_PS + (size_t)b * PHIST * PW + r] = a.state_pool[(size_t)b * PHIST * PW + DEC_T * PW + r];
        }
    }
    SEAM(0);
    if (IN(1)) {
        pg8::SegOrder<3> S{}; S.G = G; S.c = bx; S.pa = (size_t)256 * D * 2; S.pb = (size_t)256 * D * 2;
        S.s[0] = pg8::Seg{XN0, Win_t, M / 256, INW / 256, 0};
        S.s[1] = pg8::Seg{HM, Wckv_t, BATCH * NMEM / 256, 2 * D / 256, 1};
        S.s[2] = pg8::Seg{Wckv_t + (size_t)D * D, HM, D / 256, BATCH, 2};
        pg8::gemm_phase<pg8::EpiP1, pg8::SegOrder<3>, true, true>(L, D, D, D, S, pg8::EpiP1{Qb, Kb, Vb, Ub, MK, MV, MVt, a.out});
    }
    SEAM(1);
    if (IN(2)) {
        for (size_t task = gt; task < (size_t)NH * M; task += GT) {
            const int h = (int)(task / M), row = (int)(task % M), kvh = h / 4;
            const float slope = exp2f(-(float)(h + 1)) * LOG2E, sink = a.attn_sinks[h] * LOG2E;
            float q[HD], o[HD];
#pragma unroll
            for (int d = 0; d < HD; ++d) { q[d] = bf2f(Qb[(size_t)row * AW + h * HD + d]); o[d] = 0.f; }
            float m = sink, l = 1.f;
            const bool samp = row >= MP;
            int b, t; if (!samp) { b = row / SEQ; t = row % SEQ; } else { b = (row - MP) / DEC_T; t = (row - MP) % DEC_T; }
            for (int i = 0; i <= WIN; ++i) {
                if (!samp && t - i < 0) break;
                const bool cached = samp && i > t;
                const int j = WIN + t - i;
                const bf16_t* kp = Kb + (size_t)(cached ? row : row - i) * KVW + kvh * HD; const bf16_t* vp = Vb + (size_t)(cached ? row : row - i) * KVW + kvh * HD;
                const float* kc = a.cache_win_k + ((size_t)b * WIN + (cached ? j : 0)) * KVW + kvh * HD; const float* vc = a.cache_win_v + ((size_t)b * WIN + (cached ? j : 0)) * KVW + kvh * HD;
                float s = 0.f;
                if (cached) {
#pragma unroll
                    for (int d = 0; d < HD; ++d) s += q[d] * kc[d];
                } else {
#pragma unroll
                    for (int d = 0; d < HD; ++d) s += q[d] * bf2f(kp[d]);
                }
                s -= slope * (float)i;
                if (s > m) { const float f = exp2f(m - s); l *= f;
#pragma unroll
                    for (int d = 0; d < HD; ++d) o[d] *= f;
                    m = s; }
                const float p = exp2f(s - m); l += p;
                if (cached) {
#pragma unroll
                    for (int d = 0; d < HD; ++d) o[d] += p * vc[d];
                } else {
#pragma unroll
                    for (int d = 0; d < HD; ++d) o[d] += p * bf2f(vp[d]);
                }
            }
            const float il = 1.f / l;
#pragma unroll
            for (int d = 0; d < HD; d += 2) *(unsigned*)(A2 + (size_t)row * D + h * HD + d) = pk2(o[d] * il, o[d + 1] * il);
        }
        for (size_t task = gt; task < (size_t)M * PW; task += GT) {
            const int row = (int)(task / PW), c = (int)(task % PW), w = 2 << (c / 128);
            const bool samp = row >= MP; float s = 0.f, cnt;
            if (!samp) { const int t = row % SEQ; for (int i = 0; i < w; ++i) if (t - i >= 0) s += bf2f(Ub[(size_t)(row - i) * PW + c]); cnt = (float)(t + 1 < w ? t + 1 : w); }
            else { const int b = (row - MP) / DEC_T, t = (row - MP) % DEC_T;
                for (int i = 0; i < w; ++i) { const int ti = t - i; s += ti >= 0 ? bf2f(Ub[(size_t)(row - i) * PW + c]) : a.state_pool[((size_t)b * PHIST + (PHIST + ti)) * PW + c]; } cnt = (float)w; }
            A2[(size_t)row * D + AW + c] = (bf16_t)f2bf(s / cnt - bf2f(Ub[(size_t)row * PW + c]));
        }
    }
    SEAM(2);
    if (IN(3)) {
        pg8::SegOrder<1> S{}; S.G = G; S.c = bx; S.pa = (size_t)256 * D * 2; S.pb = (size_t)256 * D * 2;
        S.s[0] = pg8::Seg{A2, Wo2_t, M / 256, D / 256, 0};
        pg8::gemm_phase<pg8::EpiResidG, pg8::SegOrder<1>, true, true>(L, D, D, D, S, pg8::EpiResidG{a.x_prompt, a.x_sample - (size_t)MP * D, X, XB, rss1});
    }
    SEAM(3);
    if (IN(4)) {
        pg8::SegOrder<1> S{}; S.G = G; S.c = bx; S.pa = (size_t)256 * D * 2; S.pb = (size_t)256 * D * 2;
        S.s[0] = pg8::Seg{XB, Wcq_t, M / 256, D / 256, 0};
        pg8::gemm_phase<pg8::EpiRowScaleG<0>, pg8::SegOrder<1>, true, true>(L, D, D, D, S, pg8::EpiRowScaleG<0>{CQ, D, rss1, (1.0f / 16.0f) * LOG2E});
    }
    SEAM(4);
    if (IN(5)) {
        LAS float* qs = (LAS float*)lds + wave * 512; LAS float* ps = qs + 256;
        for (int task = gw; task < M * NCH; task += NGW) {
            const int row = task / NCH, h = task % NCH; const bool samp = row >= MP;
            const int b = samp ? (row - MP) / DEC_T : row / SEQ;
            { const u32x2 w = *(const u32x2*)(CQ + (size_t)row * D + h * CHD + lane * 4);
              qs[lane * 4 + 0] = bf2f((bf16_t)(w[0] & 0xffff)); qs[lane * 4 + 1] = bf2f((bf16_t)(w[0] >> 16)); qs[lane * 4 + 2] = bf2f((bf16_t)(w[1] & 0xffff)); qs[lane * 4 + 3] = bf2f((bf16_t)(w[1] >> 16)); }
            float sc[4]; float mx = -3.0e38f;
#pragma unroll
            for (int mm = 0; mm < 4; ++mm) {
                const int m = mm * 64 + lane; float s = 0.f;
                if (!samp) { const bf16_t* kp = MK + ((size_t)b * NMEM + m) * D + h * CHD; for (int d = 0; d < CHD; ++d) s += qs[d] * bf2f(kp[d]); }
                else { const float* kp = a.cache_mem_k + (((size_t)b * NMEM + m) * NCH + h) * CHD; for (int d = 0; d < CHD; ++d) s += qs[d] * kp[d]; }
                sc[mm] = s; mx = fmaxf(mx, s);
            }
            mx = wave_max(mx); float sum = 0.f;
#pragma unroll
            for (int mm = 0; mm < 4; ++mm) { const float p = exp2f(sc[mm] - mx); sum += p; ps[mm * 64 + lane] = p; }
            sum = wave_sum(sum);
            float o[4] = {0.f, 0.f, 0.f, 0.f};
            if (!samp) { const bf16_t* vp = MV + (size_t)b * NMEM * D + h * CHD + lane * 4;
                for (int m = 0; m < NMEM; ++m) { const float p = ps[m]; const u32x2 w = *(const u32x2*)(vp + (size_t)m * D);
                    o[0] += p * bf2f((bf16_t)(w[0] & 0xffff)); o[1] += p * bf2f((bf16_t)(w[0] >> 16)); o[2] += p * bf2f((bf16_t)(w[1] & 0xffff)); o[3] += p * bf2f((bf16_t)(w[1] >> 16)); } }
            else { const float* vp = a.cache_mem_v + ((size_t)b * NMEM * NCH + h) * CHD + lane * 4;
                for (int m = 0; m < NMEM; ++m) { const float p = ps[m]; const f32x4 w = *(const f32x4*)(vp + (size_t)m * NCH * CHD);
                    o[0] += p * w[0]; o[1] += p * w[1]; o[2] += p * w[2]; o[3] += p * w[3]; } }
            const float il = 1.f / sum;
            *(u32x2*)(OC + (size_t)row * D + h * CHD + lane * 4) = (u32x2){pk2(o[0] * il, o[1] * il), pk2(o[2] * il, o[3] * il)};
        }
    }
    SEAM(5);
    if (IN(6)) {
        pg8::SegOrder<1> S{}; S.G = G; S.c = bx; S.pa = (size_t)256 * D * 2; S.pb = (size_t)256 * D * 2;
        S.s[0] = pg8::Seg{OC, Wco_t, M / 256, D / 256, 0};
        pg8::gemm_phase<pg8::EpiResidG, pg8::SegOrder<1>, true, true>(L, D, D, D, S, pg8::EpiResidG{X, X, X, XB, rss2});
    }
    SEAM(6);
    if (IN(7)) {
        pg8::SegOrder<1> S{}; S.G = G; S.c = bx; S.pa = (size_t)256 * D * 2; S.pb = (size_t)256 * D * 2;
        S.s[0] = pg8::Seg{XB, Wup_t, M / 256, DFF / 256, 0};
        pg8::gemm_phase<pg8::EpiRowScaleG<1>, pg8::SegOrder<1>, true, true>(L, D, D, D, S, pg8::EpiRowScaleG<1>{Hb, DFF, rss2, 1.0f});
    }
    SEAM(7);
    if (IN(8)) {
        pg8::SegOrder<1> S{}; S.G = G; S.c = bx; S.pa = (size_t)256 * DFF * 2; S.pb = (size_t)256 * DFF * 2;
        S.s[0] = pg8::Seg{Hb, Wdn_t, M / 256, D / 256, 0};
        pg8::gemm_phase<pg8::EpiResidG, pg8::SegOrder<1>, true, true>(L, DFF, DFF, DFF, S, pg8::EpiResidG{X, X, X, nullptr, rss3});
    }
    SEAM(8);
    if (IN(9)) {
        for (int r = gw; r < M; r += NGW) {
            const float rs = rsqrtf(rss3[r] * (1.f / D) + EPS);
            f32x4* xr = (f32x4*)(X + (size_t)r * D) + lane; const f32x4* gp = (const f32x4*)a.g_final + lane;
#pragma unroll
            for (int j = 0; j < 4; ++j) xr[64 * j] = xr[64 * j] * rs * gp[64 * j];
        }
    }
#undef IN
#undef SEAM
}

constexpr int N_PHASES = 10;
extern "C" void kernel_launch(void* const* d_in, const int* in_sizes, int n_in, void* d_out, int out_size, void* d_ws, size_t ws_size, hipStream_t stream) {
    static int grid = 0;
    if (grid == 0) {
        if (n_in != 24 || in_sizes[0] != MP * D || out_size != (int)O_END || ws_size < WS_END) {
            fprintf(stderr, "kernel_launch: unexpected shapes: n_in %d in0 %d out %d ws %zu (need %zu)\n", n_in, n_in > 0 ? in_sizes[0] : -1, out_size, ws_size, (size_t)WS_END); grid = -1; return; }
        int dev = 0, cus = 0, per_cu = 0;
        if (hipGetDevice(&dev) != hipSuccess || hipDeviceGetAttribute(&cus, hipDeviceAttributeMultiprocessorCount, dev) != hipSuccess) { grid = -1; return; }
        if (hipFuncSetAttribute((const void*)fwd, hipFuncAttributeMaxDynamicSharedMemorySize, LDS_BYTES) != hipSuccess) { fprintf(stderr, "kernel_launch: hipFuncSetAttribute failed\n"); grid = -1; return; }
        if (hipOccupancyMaxActiveBlocksPerMultiprocessor(&per_cu, (const void*)fwd, NTHREADS, LDS_BYTES) != hipSuccess || per_cu < 1) { fprintf(stderr, "kernel_launch: occupancy query says %d\n", per_cu); grid = -1; (void)hipGetLastError(); return; }
        grid = cus;
    }
    if (grid < 0) return;
    (void)hipMemsetAsync((char*)d_ws + WS_CTL, 0, CTL_ZERO_BYTES, stream);
    Args a{};
    const float** p = (const float**)&a;
    for (int i = 0; i < 24; ++i) p[i] = (const float*)d_in[i];
    a.out = (float*)d_out; a.ws = (unsigned char*)d_ws;
    if (MK_N_LAUNCHES == 1) { a.ph_lo = 0; a.ph_hi = N_PHASES; hipLaunchKernelGGL(fwd, dim3(grid), dim3(NTHREADS), LDS_BYTES, stream, a); }
    else for (int ph = 0; ph < N_PHASES; ++ph) { a.ph_lo = ph; a.ph_hi = ph + 1; hipLaunchKernelGGL(fwd, dim3(grid), dim3(NTHREADS), LDS_BYTES, stream, a); }
}
```

```cpp
#include <hip/hip_runtime.h>
#include <cstdio>
#include <cstdint>

#ifndef MK_N_LAUNCHES
#define MK_N_LAUNCHES 1
#endif

constexpr int D = 1024, BATCH = 4, SEQ = 4096, DEC_B = 128, DEC_T = 8, PAST = 16384;
constexpr int HD = 64, AW = 512, NH = 8, NKV = 2, KVW = 128, WIN = 128, PW = 512, PHIST = 15, INW = 1280;
constexpr int NMEM = 256, NCH = 4, CHD = 256, DFF = 4096;
constexpr int MP = BATCH * SEQ, MS = DEC_B * DEC_T, M = MP + MS;
constexpr float EPS = 1e-5f;
constexpr float LOG2E = 1.4426950408889634f;

constexpr size_t O_YP = 0, O_YS = O_YP + (size_t)MP * D, O_WKP = O_YS + (size_t)MS * D, O_WVP = O_WKP + (size_t)BATCH * WIN * KVW,
                 O_PP = O_WVP + (size_t)BATCH * WIN * KVW, O_MKP = O_PP + (size_t)BATCH * PHIST * PW, O_MVP = O_MKP + (size_t)BATCH * NMEM * D,
                 O_WKS = O_MVP + (size_t)BATCH * NMEM * D, O_WVS = O_WKS + (size_t)DEC_B * WIN * KVW, O_PS = O_WVS + (size_t)DEC_B * WIN * KVW,
                 O_END = O_PS + (size_t)DEC_B * PHIST * PW;
static_assert(O_END == 25262080, "output size");

constexpr size_t MiB = 1u << 20;
constexpr size_t WS_CTL = 0, CTL_ZERO_BYTES = 1 * MiB;
constexpr size_t WS_WIN = 2 * MiB;
constexpr size_t WS_WCKV = 5 * MiB;
constexpr size_t WS_WO2 = 9 * MiB;
constexpr size_t WS_WCQ = 11 * MiB, WS_WCO = 13 * MiB;
constexpr size_t WS_WUP = 15 * MiB;
constexpr size_t WS_WDN = 23 * MiB;
constexpr size_t WS_HM = 31 * MiB;
constexpr size_t WS_MK = 33 * MiB, WS_MV = 35 * MiB;
constexpr size_t WS_MVT = 36 * MiB + MiB;
constexpr size_t WS_XN0 = 40 * MiB;
constexpr size_t WS_Q = 74 * MiB;
constexpr size_t WS_K = 91 * MiB, WS_V = 96 * MiB;
constexpr size_t WS_U = 101 * MiB;
constexpr size_t WS_A2 = 118 * MiB;
constexpr size_t WS_XB = 152 * MiB;
constexpr size_t WS_CQ = 186 * MiB;
constexpr size_t WS_OC = 220 * MiB;
constexpr size_t WS_P = 254 * MiB;
constexpr size_t WS_H = 286 * MiB;
constexpr size_t WS_END = 422 * MiB;
constexpr int CW_BAR = 4096;
constexpr int CW_RSS1 = 32768, CW_RSS2 = CW_RSS1 + M, CW_RSS3 = CW_RSS2 + M;
static_assert((CW_RSS3 + M) * 4 <= (int)CTL_ZERO_BYTES, "ctl");

constexpr int LDS_BYTES = 147456;
constexpr int NTHREADS = 512, NWAVES = 8;

typedef unsigned short bf16_t;
typedef short bf16x8 __attribute__((ext_vector_type(8)));
typedef float f32x4 __attribute__((ext_vector_type(4)));
typedef unsigned u32x2 __attribute__((ext_vector_type(2)));
typedef unsigned u32x4 __attribute__((ext_vector_type(4)));
#define LAS __attribute__((address_space(3)))

__device__ __forceinline__ unsigned f2bf(float f) { unsigned u = __builtin_bit_cast(unsigned, f); return (u + 0x7fffu + ((u >> 16) & 1u)) >> 16; }
__device__ __forceinline__ unsigned pk2(float lo, float hi) { return f2bf(lo) | (f2bf(hi) << 16); }
__device__ __forceinline__ float bf2f(bf16_t h) { return __builtin_bit_cast(float, (unsigned)h << 16); }
__device__ __forceinline__ float wave_sum(float v) {
#pragma unroll
    for (int o = 1; o < 64; o <<= 1) v += __shfl_xor(v, o);
    return v;
}
__device__ __forceinline__ float wave_max(float v) {
#pragma unroll
    for (int o = 1; o < 64; o <<= 1) v = fmaxf(v, __shfl_xor(v, o));
    return v;
}

#define XB_TMO      128
#define XB_XCNT(j)  (256  + 64 * (j))
#define XB_XSUB(j)  (1280 + 64 * (j))
#define XB_XGEN(j)  (2304 + 64 * (j))
#define XB_TOP      3328
#define XB_TOPGEN   3392
#define XCD_BAR_WORDS 3456
#define XB_SPIN_CAP (1u << 18)
__device__ __forceinline__ unsigned xb_ld(unsigned* p)              { return __hip_atomic_load(p, __ATOMIC_RELAXED, __HIP_MEMORY_SCOPE_AGENT); }
__device__ __forceinline__ unsigned xb_add(unsigned* p, unsigned v) { return __hip_atomic_fetch_add(p, v, __ATOMIC_RELAXED, __HIP_MEMORY_SCOPE_AGENT); }
__device__ __forceinline__ unsigned xb_xcc_id() { return (unsigned)__builtin_amdgcn_s_getreg((3 << 11) | 20) & 0xFu; }
#define XB_SPIN(cond, bar) do { unsigned _sp = 0; while (cond) { __builtin_amdgcn_s_sleep(1); \
    if ((++_sp & 255u) == 0u) { if (xb_ld(&(bar)[XB_TMO])) break; if (_sp > XB_SPIN_CAP) { atomicAdd(&(bar)[XB_TMO], 1u); break; } } } } while (0)
struct XcdBarrier { unsigned* bar; unsigned x; volatile LAS unsigned* st; };
__device__ __forceinline__ XcdBarrier xcd_barrier_post(unsigned* bar, volatile LAS unsigned* st) {
    XcdBarrier b; b.bar = bar; b.x = xb_xcc_id(); b.st = st;
    if (threadIdx.x == 0) (void)xb_add(&bar[XB_XCNT(b.x)], 1u);
    return b;
}
__device__ __forceinline__ void xcd_barrier_complete(unsigned* bar, unsigned x, unsigned& nloc, unsigned& nx) {
    const unsigned G = gridDim.x * gridDim.y * gridDim.z;
    unsigned sum, cnt, mine, sp = 0u;
    for (;;) {
        sum = 0u; cnt = 0u; mine = 0u;
#pragma unroll
        for (unsigned j = 0; j < 16; ++j) { const unsigned c = xb_ld(&bar[XB_XCNT(j)]); sum += c; cnt += (c > 0u) ? 1u : 0u; mine = (j == x) ? c : mine; }
        if (sum == G) break;
        __builtin_amdgcn_s_sleep(1);
        if ((++sp & 255u) == 0u) { if (xb_ld(&bar[XB_TMO])) break; if (sp > XB_SPIN_CAP) { atomicAdd(&bar[XB_TMO], 1u); break; } }
    }
    nloc = mine > 0u ? mine : 1u; nx = cnt > 0u ? cnt : 1u;
}
__device__ __forceinline__ void xcd_barrier(const XcdBarrier& b) {
    asm volatile("s_waitcnt vmcnt(0)" ::: "memory");
    __syncthreads();
    if (threadIdx.x == 0) {
        unsigned* bar = b.bar;
        __builtin_amdgcn_s_waitcnt(0);
        unsigned nloc = b.st[0], nx = b.st[1];
        if (nloc == 0u) { xcd_barrier_complete(bar, b.x, nloc, nx); b.st[0] = nloc; b.st[1] = nx; }
        const unsigned old = xb_add(&bar[XB_XSUB(b.x)], 1u);
        const unsigned gen = old / nloc;
        if (old + 1u == (gen + 1u) * nloc) {
            __builtin_amdgcn_fence(__ATOMIC_RELEASE, "agent");
            asm volatile("s_waitcnt vmcnt(0)" ::: "memory");
            const unsigned og = xb_add(&bar[XB_TOP], 1u);
            const unsigned tg = og / nx;
            if (og + 1u == (tg + 1u) * nx) xb_add(&bar[XB_TOPGEN], 1u);
            else XB_SPIN(xb_ld(&bar[XB_TOPGEN]) == tg, bar);
            __builtin_amdgcn_fence(__ATOMIC_ACQUIRE, "agent");
            xb_add(&bar[XB_XGEN(b.x)], 1u);
            asm volatile("s_waitcnt vmcnt(0)" ::: "memory");
        } else {
            XB_SPIN(xb_ld(&bar[XB_XGEN(b.x)]) == gen, bar);
            __builtin_amdgcn_fence(__ATOMIC_ACQUIRE, "agent");
            asm volatile("s_waitcnt vmcnt(0)" ::: "memory");
        }
    }
    __syncthreads();
}

struct Args {
    const float *x_prompt, *x_sample, *cache_win_k, *cache_win_v, *state_pool, *cache_mem_k, *cache_mem_v, *mem_prompt;
    const float *g_mix, *w_in, *attn_sinks, *w_pool, *pool_scale, *w_out, *g_cross, *g_mem, *w_cq, *w_ck, *w_cv, *w_co, *g_ffn, *w_up, *w_down, *g_final;
    float* out; unsigned char* ws; int ph_lo, ph_hi;
};

template <class Epi>
__device__ __forceinline__ void gemm_naive(const bf16_t* A, int lda, const bf16_t* Bt, int ldb, int Mr, int N, int K, const Epi& epi) {
    const int wid = threadIdx.x >> 6, lane = threadIdx.x & 63, wr = wid >> 2, wc = wid & 3, fr = lane & 15, fq = lane >> 4;
    const int tn_n = N / 256, ntiles = (Mr / 128) * tn_n;
    for (int t = blockIdx.x; t < ntiles; t += gridDim.x) {
        const int tm = t / tn_n, tn = t % tn_n;
        const int r0 = tm * 128 + wr * 64, c0 = tn * 256 + wc * 64;
        f32x4 acc[4][4];
#pragma unroll
        for (int i = 0; i < 4; ++i)
#pragma unroll
            for (int j = 0; j < 4; ++j) acc[i][j] = (f32x4){0.f, 0.f, 0.f, 0.f};
        const bf16_t* ap = A + (size_t)(r0 + fr) * lda + fq * 8;
        const bf16_t* bp = Bt + (size_t)(c0 + fr) * ldb + fq * 8;
        for (int k0 = 0; k0 < K; k0 += 32) {
            bf16x8 a[4], b[4];
#pragma unroll
            for (int i = 0; i < 4; ++i) a[i] = *(const bf16x8*)(ap + (size_t)(i * 16) * lda + k0);
#pragma unroll
            for (int j = 0; j < 4; ++j) b[j] = *(const bf16x8*)(bp + (size_t)(j * 16) * ldb + k0);
#pragma unroll
            for (int i = 0; i < 4; ++i)
#pragma unroll
                for (int j = 0; j < 4; ++j) acc[i][j] = __builtin_amdgcn_mfma_f32_16x16x32_bf16(b[j], a[i], acc[i][j], 0, 0, 0);
        }
        epi(acc, r0 + fr, c0 + 4 * fq, fq);
    }
}

struct EpiProj {
    bf16_t *Q, *Kb, *Vb, *U; float* out;
    __device__ __forceinline__ void operator()(const f32x4 (&acc)[4][4], int row0, int col0, int) const {
#pragma unroll
        for (int i = 0; i < 4; ++i) {
            const int row = row0 + 16 * i;
            const bool samp = row >= MP;
            int b, t; if (!samp) { b = row / SEQ; t = row % SEQ; } else { b = (row - MP) / DEC_T; t = (row - MP) % DEC_T; }
#pragma unroll
            for (int j = 0; j < 4; ++j) {
                const int col = col0 + 16 * j; const f32x4 v = acc[i][j];
                if (col < AW) {
                    const float s = 0.125f * LOG2E;
                    *(u32x2*)(Q + (size_t)row * AW + col) = (u32x2){pk2(v[0] * s, v[1] * s), pk2(v[2] * s, v[3] * s)};
                } else if (col < AW + 2 * KVW) {
                    const bool isv = col >= AW + KVW; const int c = col - AW - (isv ? KVW : 0);
                    *(u32x2*)((isv ? Vb : Kb) + (size_t)row * KVW + c) = (u32x2){pk2(v[0], v[1]), pk2(v[2], v[3])};
                    if (!samp) { if (t >= SEQ - WIN) *(f32x4*)(out + (isv ? O_WVP : O_WKP) + ((size_t)b * WIN + (t - (SEQ - WIN))) * KVW + c) = v; }
                    else *(f32x4*)(out + (isv ? O_WVS : O_WKS) + ((size_t)b * WIN + (WIN - DEC_T + t)) * KVW + c) = v;
                } else {
                    const int c = col - AW - 2 * KVW;
                    *(u32x2*)(U + (size_t)row * PW + c) = (u32x2){pk2(v[0], v[1]), pk2(v[2], v[3])};
                    if (!samp) { if (t >= SEQ - PHIST) *(f32x4*)(out + O_PP + ((size_t)b * PHIST + (t - (SEQ - PHIST))) * PW + c) = v; }
                    else *(f32x4*)(out + O_PS + ((size_t)b * PHIST + (PHIST - DEC_T + t)) * PW + c) = v;
                }
            }
        }
    }
};
struct EpiMemKV {
    bf16_t *MK, *MV; float* out;
    __device__ __forceinline__ void operator()(const f32x4 (&acc)[4][4], int row0, int col0, int) const {
#pragma unroll
        for (int i = 0; i < 4; ++i)
#pragma unroll
            for (int j = 0; j < 4; ++j) {
                const int row = row0 + 16 * i, col = col0 + 16 * j; const f32x4 v = acc[i][j];
                const bool isv = col >= D; const int c = col - (isv ? D : 0);
                *(f32x4*)(out + (isv ? O_MVP : O_MKP) + (size_t)row * D + c) = v;
                *(u32x2*)((isv ? MV : MK) + (size_t)row * D + c) = (u32x2){pk2(v[0], v[1]), pk2(v[2], v[3])};
            }
    }
};
struct EpiResid {
    const float* base; float* X; bf16_t* XB; float* rss;
    __device__ __forceinline__ void operator()(const f32x4 (&acc)[4][4], int row0, int col0, int fq) const {
#pragma unroll
        for (int i = 0; i < 4; ++i) {
            const int row = row0 + 16 * i; float s = 0.f;
#pragma unroll
            for (int j = 0; j < 4; ++j) {
                const int col = col0 + 16 * j;
                const f32x4 v = *(const f32x4*)(base + (size_t)row * D + col) + acc[i][j];
                *(f32x4*)(X + (size_t)row * D + col) = v;
                if (XB) *(u32x2*)(XB + (size_t)row * D + col) = (u32x2){pk2(v[0], v[1]), pk2(v[2], v[3])};
                s += (v[0] * v[0] + v[1] * v[1]) + (v[2] * v[2] + v[3] * v[3]);
            }
            s += __shfl_xor(s, 16); s += __shfl_xor(s, 32);
            if (fq == 0) atomicAdd(rss + row, s);
        }
    }
};
template <int ACT>
struct EpiRowScale {
    bf16_t* O; int ldo; const float* rss; float scale;
    __device__ __forceinline__ void operator()(const f32x4 (&acc)[4][4], int row0, int col0, int) const {
#pragma unroll
        for (int i = 0; i < 4; ++i) {
            const int row = row0 + 16 * i; const float rs = rsqrtf(rss[row] * (1.0f / D) + EPS);
#pragma unroll
            for (int j = 0; j < 4; ++j) {
                const int col = col0 + 16 * j; f32x4 v = acc[i][j] * rs;
                if (ACT == 1) {
#pragma unroll
                    for (int e = 0; e < 4; ++e) { const float r = fmaxf(v[e], 0.f); v[e] = r * r; }
                }
                v = v * scale;
                *(u32x2*)(O + (size_t)row * ldo + col) = (u32x2){pk2(v[0], v[1]), pk2(v[2], v[3])};
            }
        }
    }
};


namespace pg8 {
constexpr int BM = 256, BK = 64, HALF = 128, HTB = HALF * BK * 2, STAGE_BYTES = 8 * HTB, NXCD = 8, WGM = 8;
__host__ __device__ __forceinline__ int lds_byte(int r, int c) { const int st = (r >> 4) * 2 + (c >> 5), rr = r & 15, cc = c & 31, ob = rr * 64 + cc * 2; return st * 1024 + (ob ^ (((ob >> 9) & 1) << 5)); }
__host__ __device__ __forceinline__ void stage_rc(int b, int& R, int& C) { const int st = b / 1024, sb = b % 1024, swz = sb ^ (((sb >> 9) & 1) << 5); R = (st >> 1) * 16 + swz / 64; C = (st & 1) * 32 + (swz % 64) / 2; }
__host__ __device__ __forceinline__ int perm32(int rho) { const int n = rho >> 4, i = rho & 15; return 8 * (i >> 2) + 4 * n + (i & 3); }

struct Unit { const char* a; const char* b; int pm, pn, kind; };
struct Seg { const bf16_t* A; const bf16_t* B; int nM, nN, kind; };
template <int NSEG> struct SegOrder {
    Seg s[NSEG]; int G, c; size_t pa, pb;
    __device__ __forceinline__ bool next(int i, Unit& u) const {
        long L = (long)i * G + c;
#pragma unroll
        for (int k = 0; k < NSEG; ++k) {
            const int nM = s[k].nM, nN = s[k].nN, nwg = nM * nN;
            if (L < nwg) {
                int wgid = (int)L; { const int q = nwg / NXCD, r = nwg % NXCD, xcd = wgid % NXCD, off = wgid / NXCD; wgid = (xcd < r ? xcd * (q + 1) : r * (q + 1) + (xcd - r) * q) + off; }
                const int nig = WGM * nN, gid = wgid / nig, fm = gid * WGM, gsz = (nM - fm) < WGM ? (nM - fm) : WGM;
                u.pm = fm + ((wgid % nig) % gsz); u.pn = (wgid % nig) / gsz; u.kind = s[k].kind;
                u.a = (const char*)s[k].A + (size_t)u.pm * pa; u.b = (const char*)s[k].B + (size_t)u.pn * pb; return true;
            }
            L -= nwg;
        }
        return false;
    }
};
__device__ __forceinline__ unsigned cvt_pk_bf16(float lo, float hi) { unsigned r; asm volatile("v_cvt_pk_bf16_f32 %0, %1, %2" : "=v"(r) : "v"(lo), "v"(hi)); return r; }
__device__ __forceinline__ u32x4 pack8(const f32x4 v0, const f32x4 v1) { u32x4 w; w.x = cvt_pk_bf16(v0[0], v0[1]); w.y = cvt_pk_bf16(v0[2], v0[3]); w.z = cvt_pk_bf16(v1[0], v1[1]); w.w = cvt_pk_bf16(v1[2], v1[3]); return w; }

template <class Epi, class Sched, bool ALIGN_EPI, bool SP2>
__device__ __forceinline__ void gemm_phase(LAS unsigned char* lds, const int lda, const int ldb, const int K, const Sched& S, const Epi& E) {
    int tid_ = threadIdx.x; asm volatile("" : "+v"(tid_));
    const int tid = tid_, wid = __builtin_amdgcn_readfirstlane(tid >> 6), lane = tid & 63, wr = wid >> 2, wc = wid & 3, fr = lane & 15, fq = lane >> 4;
    const int nt = K / BK;
    unsigned voffA[2], voffB[2];
#pragma unroll
    for (int i = 0; i < 2; ++i) { int R, C; stage_rc(tid * 16 + i * 8192, R, C); const int Rb = Epi::PERM ? ((R & ~31) + perm32(R & 31)) : R;
        voffA[i] = (unsigned)(R * lda + C) * 2u; voffB[i] = (unsigned)(Rb * ldb + C) * 2u; }
    const size_t kstep = (size_t)(BK * 2);
    const size_t hstepA = (size_t)HALF * lda * 2, hstepB = (size_t)HALF * ldb * 2;
    const unsigned ldsw = (unsigned)wid * 1024u;
    const int aoff = lds_byte(wr * 64 + fr, fq * 8), boff = lds_byte(wc * 32 + fr, fq * 8);
#define PG8_SA(b, h) (((b) * 2 + (h)) * HTB)
#define PG8_SB(b, h) ((4 + (b) * 2 + (h)) * HTB)
#define PG8_STAGE(bufoff, gbase, voff) do { _Pragma("unroll") for (int _i = 0; _i < 2; ++_i) \
        __builtin_amdgcn_global_load_lds((const unsigned*)((const char*)(gbase) + (voff)[_i]), (LAS unsigned*)(lds + (bufoff) + ldsw + _i * 8192), 16, 0, 0); } while (0)
#define PG8_LDA(dst, b, h) do { _Pragma("unroll") for (int m = 0; m < 4; ++m) _Pragma("unroll") for (int k = 0; k < 2; ++k) dst[m][k] = *(const LAS bf16x8*)(lds + PG8_SA(b, h) + aoff + m * 2048 + k * 1024); } while (0)
#define PG8_LDB(dst, b, h) do { _Pragma("unroll") for (int n = 0; n < 2; ++n) _Pragma("unroll") for (int k = 0; k < 2; ++k) dst[n][k] = *(const LAS bf16x8*)(lds + PG8_SB(b, h) + boff + n * 2048 + k * 1024); } while (0)
#define PG8_MMA(ai, bj, At, Bt) do { __builtin_amdgcn_s_setprio(1); _Pragma("unroll") for (int m = 0; m < 4; ++m) _Pragma("unroll") for (int n = 0; n < 2; ++n) _Pragma("unroll") for (int k = 0; k < 2; ++k) \
        acc[ai][bj][m][n] = __builtin_amdgcn_mfma_f32_16x16x32_bf16(Bt[n][k], At[m][k], acc[ai][bj][m][n], 0, 0, 0); __builtin_amdgcn_s_setprio(0); } while (0)
#define PG8_WAIT_V(n) asm volatile("s_waitcnt vmcnt(" #n ")" ::: "memory")
#define PG8_WAIT_L(n) asm volatile("s_waitcnt lgkmcnt(" #n ")" ::: "memory")
#define PG8_BAR __builtin_amdgcn_s_barrier()
#define PG8_SCHED __builtin_amdgcn_sched_barrier(0)
    Unit cur, nxt; int ui = 0;
    if (!S.next(0, cur)) return;
    f32x4 acc[2][2][4][2];
#pragma unroll
    for (int a = 0; a < 2; ++a)
#pragma unroll
        for (int b = 0; b < 2; ++b)
#pragma unroll
            for (int m = 0; m < 4; ++m)
#pragma unroll
                for (int n = 0; n < 2; ++n) acc[a][b][m][n] = (f32x4){0.f, 0.f, 0.f, 0.f};
    bf16x8 At[4][2], B0[2][2], B1[2][2];
    const char* cA = cur.a; const char* cB = cur.b;
    if constexpr (SP2) {
        PG8_STAGE(PG8_SB(0, 0), cB, voffB); PG8_STAGE(PG8_SB(0, 1), cB + hstepB, voffB); PG8_STAGE(PG8_SA(0, 0), cA, voffA); PG8_STAGE(PG8_SA(0, 1), cA + hstepA, voffA);
        if (wr == 1) PG8_BAR;
        PG8_WAIT_V(2); PG8_BAR;
        PG8_STAGE(PG8_SB(1, 0), cB + kstep, voffB); PG8_STAGE(PG8_SA(1, 0), cA + kstep, voffA); PG8_STAGE(PG8_SB(1, 1), cB + hstepB + kstep, voffB);
        PG8_WAIT_V(6); PG8_BAR;
    } else {
        PG8_STAGE(PG8_SB(0, 0), cB, voffB); PG8_STAGE(PG8_SA(0, 0), cA, voffA); PG8_STAGE(PG8_SB(0, 1), cB + hstepB, voffB); PG8_STAGE(PG8_SA(0, 1), cA + hstepA, voffA);
        if (wr == 1) PG8_BAR;
        PG8_WAIT_V(4); PG8_BAR;
        PG8_STAGE(PG8_SB(1, 0), cB + kstep, voffB); PG8_STAGE(PG8_SA(1, 0), cA + kstep, voffA); PG8_STAGE(PG8_SB(1, 1), cB + hstepB + kstep, voffB);
        PG8_WAIT_V(6); PG8_BAR;
    }
    for (;;) {
        const bool has_next = S.next(ui + 1, nxt);
        const char* nA = has_next ? nxt.a : cA; const char* nB = has_next ? nxt.b : cB;
        for (int t = 0; t < nt; t += 2) {
            const bool last = (t == nt - 2);
            const char* a1 = cA + (size_t)(t + 1) * kstep;
            const char* a2 = last ? nA : cA + (size_t)(t + 2) * kstep; const char* b2 = last ? nB : cB + (size_t)(t + 2) * kstep;
            const char* a3 = a2 + kstep; const char* b3 = b2 + kstep;
            if constexpr (SP2) {
            PG8_LDB(B0, 0, 0); PG8_LDB(B1, 0, 1); PG8_SCHED; PG8_LDA(At, 0, 0); PG8_STAGE(PG8_SA(1, 1), a1 + hstepA, voffA);
            PG8_WAIT_V(8); PG8_WAIT_L(0); PG8_BAR; PG8_MMA(0, 0, At, B0); PG8_MMA(0, 1, At, B1); PG8_BAR; PG8_SCHED;
            PG8_LDA(At, 0, 1); PG8_STAGE(PG8_SB(0, 0), b2, voffB); PG8_STAGE(PG8_SB(0, 1), b2 + hstepB, voffB); PG8_STAGE(PG8_SA(0, 0), a2, voffA);
            PG8_WAIT_V(8); PG8_WAIT_L(0); PG8_BAR; PG8_MMA(1, 0, At, B0); PG8_MMA(1, 1, At, B1); PG8_BAR; PG8_SCHED;
            PG8_LDB(B0, 1, 0); PG8_LDB(B1, 1, 1); PG8_SCHED; PG8_LDA(At, 1, 0); PG8_STAGE(PG8_SA(0, 1), a2 + hstepA, voffA);
            PG8_WAIT_V(8); PG8_WAIT_L(0); PG8_BAR; PG8_MMA(0, 0, At, B0); PG8_MMA(0, 1, At, B1); PG8_BAR; PG8_SCHED;
            PG8_LDA(At, 1, 1); PG8_STAGE(PG8_SB(1, 0), b3, voffB); PG8_STAGE(PG8_SB(1, 1), b3 + hstepB, voffB); PG8_STAGE(PG8_SA(1, 0), a3, voffA);
            PG8_WAIT_V(8); PG8_WAIT_L(0); PG8_BAR; PG8_MMA(1, 0, At, B0); PG8_MMA(1, 1, At, B1); PG8_BAR; PG8_SCHED;
            } else {
            PG8_LDB(B0, 0, 0); PG8_SCHED; PG8_LDA(At, 0, 0); PG8_STAGE(PG8_SA(1, 1), a1 + hstepA, voffA);
            PG8_WAIT_L(8); PG8_BAR; PG8_WAIT_L(0); PG8_MMA(0, 0, At, B0); PG8_BAR; PG8_SCHED;
            PG8_LDB(B1, 0, 1); PG8_STAGE(PG8_SB(0, 0), b2, voffB);
            PG8_BAR; PG8_WAIT_L(0); PG8_MMA(0, 1, At, B1); PG8_BAR;
            PG8_LDA(At, 0, 1); PG8_STAGE(PG8_SA(0, 0), a2, voffA);
            PG8_BAR; PG8_WAIT_L(0); PG8_MMA(1, 0, At, B0); PG8_BAR; PG8_SCHED;
            PG8_STAGE(PG8_SB(0, 1), b2 + hstepB, voffB);
            PG8_WAIT_V(6); PG8_BAR; PG8_MMA(1, 1, At, B1); PG8_BAR;
            PG8_LDB(B0, 1, 0); PG8_SCHED; PG8_LDA(At, 1, 0); PG8_STAGE(PG8_SA(0, 1), a2 + hstepA, voffA);
            PG8_WAIT_L(8); PG8_BAR; PG8_WAIT_L(0); PG8_MMA(0, 0, At, B0); PG8_BAR; PG8_SCHED;
            PG8_LDB(B1, 1, 1); PG8_STAGE(PG8_SB(1, 0), b3, voffB);
            PG8_BAR; PG8_WAIT_L(0); PG8_MMA(0, 1, At, B1); PG8_BAR;
            PG8_LDA(At, 1, 1); PG8_STAGE(PG8_SA(1, 0), a3, voffA);
            PG8_BAR; PG8_WAIT_L(0); PG8_MMA(1, 0, At, B0); PG8_BAR; PG8_SCHED;
            PG8_STAGE(PG8_SB(1, 1), b3 + hstepB, voffB);
            PG8_WAIT_V(6); PG8_BAR; PG8_MMA(1, 1, At, B1); PG8_BAR;
            }
        }
        if constexpr (ALIGN_EPI) { if (wr == 0) PG8_BAR; }
        if constexpr (!Epi::AFTER_DRAIN) { E(acc, cur, wr, wc, fr, fq); }
        if (!has_next) break;
#pragma unroll
        for (int a = 0; a < 2; ++a)
#pragma unroll
            for (int b = 0; b < 2; ++b)
#pragma unroll
                for (int m = 0; m < 4; ++m)
#pragma unroll
                    for (int n = 0; n < 2; ++n) acc[a][b][m][n] = (f32x4){0.f, 0.f, 0.f, 0.f};
        cur = nxt; cA = nA; cB = nB; ++ui;
        if constexpr (ALIGN_EPI) { if (wr == 1) PG8_BAR; }
    }
    PG8_WAIT_V(0);
    if constexpr (!ALIGN_EPI) { if (wr == 0) PG8_BAR; }
    PG8_BAR;
    if constexpr (Epi::AFTER_DRAIN) { E.fused(acc, cur, wr, wc, fr, fq, lds, wid, lane); }
#undef PG8_SA
#undef PG8_SB
#undef PG8_STAGE
#undef PG8_LDA
#undef PG8_LDB
#undef PG8_MMA
#undef PG8_WAIT_V
#undef PG8_WAIT_L
#undef PG8_BAR
#undef PG8_SCHED
}

struct EpiP1 {
    static constexpr bool PERM = true, AFTER_DRAIN = false;
    bf16_t *Q, *Kb, *Vb, *U, *MK, *MV, *MVt; float* out;
    __device__ __forceinline__ void operator()(const f32x4 (&acc)[2][2][4][2], const Unit& u, int wr, int wc, int fr, int fq) const {
        const int cl = wc * 32 + 8 * fq;
        if (u.kind == 0) {
            const bool samp = u.pm >= MP / 256;
#pragma unroll
            for (int ai = 0; ai < 2; ++ai)
#pragma unroll
                for (int m = 0; m < 4; ++m) {
                    const int row = u.pm * 256 + ai * 128 + wr * 64 + m * 16 + fr;
                    int b, t; if (!samp) { b = row / SEQ; t = row % SEQ; } else { b = (row - MP) / DEC_T; t = (row - MP) % DEC_T; }
#pragma unroll
                    for (int bj = 0; bj < 2; ++bj) {
                        const f32x4 v0 = acc[ai][bj][m][0], v1 = acc[ai][bj][m][1];
                        if (u.pn < 2) { const float s = 0.125f * LOG2E; *(u32x4*)(Q + (size_t)row * AW + u.pn * 256 + bj * 128 + cl) = pack8(v0 * s, v1 * s); }
                        else if (u.pn == 2) {
                            *(u32x4*)((bj ? Vb : Kb) + (size_t)row * KVW + cl) = pack8(v0, v1);
                            float* o = nullptr;
                            if (!samp) { if (t >= SEQ - WIN) o = out + (bj ? O_WVP : O_WKP) + ((size_t)b * WIN + (t - (SEQ - WIN))) * KVW + cl; }
                            else o = out + (bj ? O_WVS : O_WKS) + ((size_t)b * WIN + (WIN - DEC_T + t)) * KVW + cl;
                            if (o) { *(f32x4*)o = v0; *(f32x4*)(o + 4) = v1; }
                        } else {
                            const int c = (u.pn - 3) * 256 + bj * 128 + cl;
                            *(u32x4*)(U + (size_t)row * PW + c) = pack8(v0, v1);
                            float* o = nullptr;
                            if (!samp) { if (t >= SEQ - PHIST) o = out + O_PP + ((size_t)b * PHIST + (t - (SEQ - PHIST))) * PW + c; }
                            else o = out + O_PS + ((size_t)b * PHIST + (PHIST - DEC_T + t)) * PW + c;
                            if (o) { *(f32x4*)o = v0; *(f32x4*)(o + 4) = v1; }
                        }
                    }
                }
        } else if (u.kind == 1) {
            const bool isv = u.pn >= 4;
#pragma unroll
            for (int ai = 0; ai < 2; ++ai)
#pragma unroll
                for (int m = 0; m < 4; ++m) {
                    const int row = u.pm * 256 + ai * 128 + wr * 64 + m * 16 + fr;
#pragma unroll
                    for (int bj = 0; bj < 2; ++bj) {
                        const f32x4 v0 = acc[ai][bj][m][0], v1 = acc[ai][bj][m][1];
                        const int c = (u.pn & 3) * 256 + bj * 128 + cl;
                        float* o = out + (isv ? O_MVP : O_MKP) + (size_t)row * D + c; *(f32x4*)o = v0; *(f32x4*)(o + 4) = v1;
                        *(u32x4*)((isv ? MV : MK) + (size_t)row * D + c) = pack8(v0, v1);
                    }
                }
        } else {
#pragma unroll
            for (int ai = 0; ai < 2; ++ai)
#pragma unroll
                for (int m = 0; m < 4; ++m) {
                    const int dd = u.pm * 256 + ai * 128 + wr * 64 + m * 16 + fr;
#pragma unroll
                    for (int bj = 0; bj < 2; ++bj) *(u32x4*)(MVt + ((size_t)u.pn * D + dd) * NMEM + bj * 128 + cl) = pack8(acc[ai][bj][m][0], acc[ai][bj][m][1]);
                }
        }
    }
};
struct EpiResidG {
    static constexpr bool PERM = true, AFTER_DRAIN = false;
    const float* baseP; const float* baseS; float* X; bf16_t* XB; float* rss;
    __device__ __forceinline__ void operator()(const f32x4 (&acc)[2][2][4][2], const Unit& u, int wr, int wc, int fr, int fq) const {
        const float* base = u.pm >= MP / 256 ? baseS : baseP;
        const int col0 = u.pn * 256 + wc * 32 + 8 * fq;
#pragma unroll
        for (int ai = 0; ai < 2; ++ai)
#pragma unroll
            for (int m = 0; m < 4; ++m) {
                const int row = u.pm * 256 + ai * 128 + wr * 64 + m * 16 + fr; float s = 0.f;
#pragma unroll
                for (int bj = 0; bj < 2; ++bj) {
                    const size_t off = (size_t)row * D + col0 + bj * 128;
                    const f32x4 v0 = *(const f32x4*)(base + off) + acc[ai][bj][m][0], v1 = *(const f32x4*)(base + off + 4) + acc[ai][bj][m][1];
                    *(f32x4*)(X + off) = v0; *(f32x4*)(X + off + 4) = v1;
                    if (XB) *(u32x4*)(XB + off) = pack8(v0, v1);
                    s += ((v0[0] * v0[0] + v0[1] * v0[1]) + (v0[2] * v0[2] + v0[3] * v0[3])) + ((v1[0] * v1[0] + v1[1] * v1[1]) + (v1[2] * v1[2] + v1[3] * v1[3]));
                }
                s += __shfl_xor(s, 16); s += __shfl_xor(s, 32);
                if (fq == 0) atomicAdd(rss + row, s);
            }
    }
};
template <int ACT>
struct EpiRowScaleG {
    static constexpr bool PERM = true, AFTER_DRAIN = false;
    bf16_t* O; int ldo; const float* rss; float scale;
    __device__ __forceinline__ void operator()(const f32x4 (&acc)[2][2][4][2], const Unit& u, int wr, int wc, int fr, int fq) const {
        const int col0 = u.pn * 256 + wc * 32 + 8 * fq;
#pragma unroll
        for (int ai = 0; ai < 2; ++ai)
#pragma unroll
            for (int m = 0; m < 4; ++m) {
                const int row = u.pm * 256 + ai * 128 + wr * 64 + m * 16 + fr;
                const float rs = rsqrtf(rss[row] * (1.0f / D) + EPS);
#pragma unroll
                for (int bj = 0; bj < 2; ++bj) {
                    f32x4 v0 = acc[ai][bj][m][0] * rs, v1 = acc[ai][bj][m][1] * rs;
                    if (ACT == 1) {
#pragma unroll
                        for (int e = 0; e < 4; ++e) { const float r0 = fmaxf(v0[e], 0.f), r1 = fmaxf(v1[e], 0.f); v0[e] = r0 * r0; v1[e] = r1 * r1; }
                    }
                    *(u32x4*)(O + (size_t)row * ldo + col0 + bj * 128) = pack8(v0 * scale, v1 * scale);
                }
            }
    }
};

struct OneUnit { Unit u; __device__ __forceinline__ bool next(int i, Unit& o) const { if (i != 0) return false; o = u; return true; } };
struct EpiSoftmaxP {
    static constexpr bool PERM = true, AFTER_DRAIN = true;
    bf16_t* P;
    __device__ __forceinline__ void fused(f32x4 (&acc)[2][2][4][2], const Unit& u, int wr, int wc, int fr, int fq, LAS unsigned char* lds, int wid, int lane) const {
        LAS float* Pm = (LAS float*)lds; LAS float* Ps = Pm + 1024;
#pragma unroll
        for (int ai = 0; ai < 2; ++ai)
#pragma unroll
            for (int m = 0; m < 4; ++m) {
                float mx = -3.0e38f;
#pragma unroll
                for (int bj = 0; bj < 2; ++bj)
#pragma unroll
                    for (int n = 0; n < 2; ++n) { const f32x4 x = acc[ai][bj][m][n]; mx = fmaxf(mx, fmaxf(fmaxf(x[0], x[1]), fmaxf(x[2], x[3]))); }
                mx = fmaxf(mx, __shfl_xor(mx, 16)); mx = fmaxf(mx, __shfl_xor(mx, 32));
                if (fq == 0) Pm[(ai * 128 + wr * 64 + m * 16 + fr) * 4 + wc] = mx;
            }
        asm volatile("s_waitcnt lgkmcnt(0)" ::: "memory"); __builtin_amdgcn_s_barrier(); asm volatile("" ::: "memory");
#pragma unroll
        for (int ai = 0; ai < 2; ++ai)
#pragma unroll
            for (int m = 0; m < 4; ++m) {
                const int rl = ai * 128 + wr * 64 + m * 16 + fr;
                const f32x4 pm4 = *(const LAS f32x4*)(Pm + rl * 4); const float mr = fmaxf(fmaxf(pm4[0], pm4[1]), fmaxf(pm4[2], pm4[3]));
                float s = 0.f;
#pragma unroll
                for (int bj = 0; bj < 2; ++bj)
#pragma unroll
                    for (int n = 0; n < 2; ++n) { f32x4 x = acc[ai][bj][m][n];
#pragma unroll
                        for (int e = 0; e < 4; ++e) { x[e] = __builtin_amdgcn_exp2f(x[e] - mr); s += x[e]; }
                        acc[ai][bj][m][n] = x; }
                s += __shfl_xor(s, 16); s += __shfl_xor(s, 32);
                if (fq == 0) Ps[rl * 4 + wc] = s;
            }
        asm volatile("s_waitcnt lgkmcnt(0)" ::: "memory"); __builtin_amdgcn_s_barrier(); asm volatile("" ::: "memory");
#pragma unroll
        for (int ai = 0; ai < 2; ++ai)
#pragma unroll
            for (int m = 0; m < 4; ++m) {
                const int rl = ai * 128 + wr * 64 + m * 16 + fr;
                const f32x4 ps4 = *(const LAS f32x4*)(Ps + rl * 4); const float inv = 1.0f / ((ps4[0] + ps4[1]) + (ps4[2] + ps4[3]));
#pragma unroll
                for (int bj = 0; bj < 2; ++bj)
                    *(u32x4*)(P + (size_t)(u.pm * 256 + rl) * D + u.pn * 256 + bj * 128 + wc * 32 + 8 * fq) = pack8(acc[ai][bj][m][0] * inv, acc[ai][bj][m][1] * inv);
            }
    }
};
struct EpiStoreBf16 {
    static constexpr bool PERM = true, AFTER_DRAIN = false;
    bf16_t* O;
    __device__ __forceinline__ void operator()(const f32x4 (&acc)[2][2][4][2], const Unit& u, int wr, int wc, int fr, int fq) const {
#pragma unroll
        for (int ai = 0; ai < 2; ++ai)
#pragma unroll
            for (int m = 0; m < 4; ++m) {
                const int row = u.pm * 256 + ai * 128 + wr * 64 + m * 16 + fr;
#pragma unroll
                for (int bj = 0; bj < 2; ++bj) *(u32x4*)(O + (size_t)row * D + u.pn * 256 + bj * 128 + wc * 32 + 8 * fq) = pack8(acc[ai][bj][m][0], acc[ai][bj][m][1]);
            }
    }
};
}

__device__ __forceinline__ void conv_weight(const float* W, const float* g, int K, int N, bf16_t* Wt, size_t gt, size_t GT) {
    for (size_t i = gt; i < (size_t)K * N; i += GT) { const int k = (int)(i / N), n = (int)(i % N); Wt[(size_t)n * K + k] = (bf16_t)f2bf(W[i] * (g ? g[k] : 1.f)); }
}
__device__ __forceinline__ void norm_rows(const float* X, bf16_t* O, int rows, int gw, int NGW, int lane) {
    for (int r = gw; r < rows; r += NGW) {
        const f32x4* xr = (const f32x4*)(X + (size_t)r * D) + lane; f32x4 v[4]; float s = 0.f;
#pragma unroll
        for (int j = 0; j < 4; ++j) { v[j] = xr[64 * j]; s += (v[j][0] * v[j][0] + v[j][1] * v[j][1]) + (v[j][2] * v[j][2] + v[j][3] * v[j][3]); }
        const float rs = rsqrtf(wave_sum(s) * (1.f / D) + EPS);
        u32x2* o = (u32x2*)(O + (size_t)r * D) + lane;
#pragma unroll
        for (int j = 0; j < 4; ++j) o[64 * j] = (u32x2){pk2(v[j][0] * rs, v[j][1] * rs), pk2(v[j][2] * rs, v[j][3] * rs)};
    }
}


__device__ __forceinline__ void cross_sample_pair(const float* __restrict__ mk, const float* __restrict__ mv, const bf16_t* __restrict__ CQ, bf16_t* OC, int task0, int ntask, LAS unsigned char* lds) {
    int tid_ = threadIdx.x; asm volatile("" : "+v"(tid_));
    const int tid = tid_, lane = tid & 63, wave = __builtin_amdgcn_readfirstlane(tid >> 6), tk = wave >> 2, mq = wave & 3;
    const int task = task0 + tk; const bool live = task < ntask;
    const int b = (live ? task : 0) / NCH, h = (live ? task : 0) % NCH;
    const int t16 = lane & 15, dq = lane >> 4;
    LAS float* pl = (LAS float*)(lds + wave * 2048);
    LAS float* op = (LAS float*)(lds + 16384 + (tk * 4 + mq) * 8192);
    LAS float* st = (LAS float*)(lds + 81920);
    if (live) {
        bf16x8 qf[8];
#pragma unroll
        for (int ds = 0; ds < 8; ++ds) {
            u32x4 w = (u32x4){0u, 0u, 0u, 0u};
            if (t16 < DEC_T) w = *(const u32x4*)(CQ + (size_t)(MP + b * DEC_T + t16) * D + h * CHD + ds * 32 + dq * 8);
            qf[ds] = __builtin_bit_cast(bf16x8, w);
        }
        f32x4 s[4];
        const float* kb = mk + (((size_t)b * NMEM + mq * 64 + t16) * NCH + h) * CHD + dq * 8;
#pragma unroll
        for (int mt = 0; mt < 4; ++mt) {
            f32x4 kv[16];
#pragma unroll
            for (int ds = 0; ds < 8; ++ds) { const float* p = kb + (size_t)(mt * 16) * NCH * CHD + ds * 32; kv[2 * ds] = *(const f32x4*)p; kv[2 * ds + 1] = *(const f32x4*)(p + 4); }
            f32x4 acc = (f32x4){0.f, 0.f, 0.f, 0.f};
#pragma unroll
            for (int ds = 0; ds < 8; ++ds) acc = __builtin_amdgcn_mfma_f32_16x16x32_bf16(__builtin_bit_cast(bf16x8, pg8::pack8(kv[2 * ds], kv[2 * ds + 1])), qf[ds], acc, 0, 0, 0);
            s[mt] = acc;
        }
        float mx = -3.0e38f;
#pragma unroll
        for (int mt = 0; mt < 4; ++mt) mx = fmaxf(mx, fmaxf(fmaxf(s[mt][0], s[mt][1]), fmaxf(s[mt][2], s[mt][3])));
        mx = fmaxf(mx, __shfl_xor(mx, 16)); mx = fmaxf(mx, __shfl_xor(mx, 32));
        float sum = 0.f;
#pragma unroll
        for (int mt = 0; mt < 4; ++mt)
#pragma unroll
            for (int e = 0; e < 4; ++e) { const float p = __builtin_amdgcn_exp2f(s[mt][e] - mx); sum += p; if (t16 < DEC_T) pl[(mt * 16 + dq * 4 + e) * 8 + t16] = p; }
        sum += __shfl_xor(sum, 16); sum += __shfl_xor(sum, 32);
        if (lane < DEC_T) { st[((tk * 4 + mq) * 8 + lane) * 2] = mx; st[((tk * 4 + mq) * 8 + lane) * 2 + 1] = sum; }
        asm volatile("s_waitcnt lgkmcnt(0)" ::: "memory");
        f32x4 o[8];
#pragma unroll
        for (int t = 0; t < 8; ++t) o[t] = (f32x4){0.f, 0.f, 0.f, 0.f};
        const float* vb = mv + (((size_t)b * NMEM + mq * 64) * NCH + h) * CHD + lane * 4;
#pragma unroll 8
        for (int ml = 0; ml < 64; ++ml) {
            const f32x4 v = *(const f32x4*)(vb + (size_t)ml * NCH * CHD);
            const f32x4 p0 = *(const LAS f32x4*)(pl + ml * 8), p1 = *(const LAS f32x4*)(pl + ml * 8 + 4);
            o[0] += v * p0[0]; o[1] += v * p0[1]; o[2] += v * p0[2]; o[3] += v * p0[3];
            o[4] += v * p1[0]; o[5] += v * p1[1]; o[6] += v * p1[2]; o[7] += v * p1[3];
        }
#pragma unroll
        for (int t = 0; t < 8; ++t) *(LAS f32x4*)(op + t * 256 + lane * 4) = o[t];
    }
    __syncthreads();
    if (live) {
#pragma unroll
        for (int tt = 0; tt < 2; ++tt) {
            const int t = 2 * mq + tt; float m4[4], l4[4]; float M4 = -3.0e38f;
#pragma unroll
            for (int q = 0; q < 4; ++q) { m4[q] = st[((tk * 4 + q) * 8 + t) * 2]; l4[q] = st[((tk * 4 + q) * 8 + t) * 2 + 1]; M4 = fmaxf(M4, m4[q]); }
            float Ls = 0.f; f32x4 o = (f32x4){0.f, 0.f, 0.f, 0.f};
#pragma unroll
            for (int q = 0; q < 4; ++q) { const float f = __builtin_amdgcn_exp2f(m4[q] - M4); Ls += l4[q] * f; o += *(const LAS f32x4*)((LAS float*)(lds + 16384 + (tk * 4 + q) * 8192) + t * 256 + lane * 4) * f; }
            const float il = 1.0f / Ls;
            *(u32x2*)(OC + (size_t)(MP + b * DEC_T + t) * D + h * CHD + lane * 4) = (u32x2){pg8::cvt_pk_bf16(o[0] * il, o[1] * il), pg8::cvt_pk_bf16(o[2] * il, o[3] * il)};
        }
    }
    __syncthreads();
}

__global__ void __launch_bounds__(NTHREADS, 2) fwd(Args a) {
    extern __shared__ __attribute__((aligned(16))) unsigned char lds[];
    const int tid = threadIdx.x, lane = tid & 63, wave = tid >> 6;
    const int G = gridDim.x, bx = blockIdx.x;
    const size_t gt = (size_t)bx * NTHREADS + tid, GT = (size_t)G * NTHREADS;
    const int gw = bx * NWAVES + wave, NGW = G * NWAVES;
    unsigned char* ws = a.ws;
    unsigned* ctl = (unsigned*)(ws + WS_CTL);
    float* rss1 = (float*)(ctl + CW_RSS1); float* rss2 = (float*)(ctl + CW_RSS2); float* rss3 = (float*)(ctl + CW_RSS3);
    bf16_t* Win_t = (bf16_t*)(ws + WS_WIN); bf16_t* Wckv_t = (bf16_t*)(ws + WS_WCKV); bf16_t* Wo2_t = (bf16_t*)(ws + WS_WO2);
    bf16_t* Wcq_t = (bf16_t*)(ws + WS_WCQ); bf16_t* Wco_t = (bf16_t*)(ws + WS_WCO); bf16_t* Wup_t = (bf16_t*)(ws + WS_WUP); bf16_t* Wdn_t = (bf16_t*)(ws + WS_WDN);
    bf16_t* HM = (bf16_t*)(ws + WS_HM); bf16_t* MK = (bf16_t*)(ws + WS_MK); bf16_t* MV = (bf16_t*)(ws + WS_MV); bf16_t* MVt = (bf16_t*)(ws + WS_MVT);
    LAS unsigned char* L = (LAS unsigned char*)lds;
    bf16_t* XN0 = (bf16_t*)(ws + WS_XN0); bf16_t* Qb = (bf16_t*)(ws + WS_Q); bf16_t* Kb = (bf16_t*)(ws + WS_K); bf16_t* Vb = (bf16_t*)(ws + WS_V); bf16_t* Ub = (bf16_t*)(ws + WS_U);
    bf16_t* A2 = (bf16_t*)(ws + WS_A2); bf16_t* XB = (bf16_t*)(ws + WS_XB); bf16_t* CQ = (bf16_t*)(ws + WS_CQ); bf16_t* OC = (bf16_t*)(ws + WS_OC); bf16_t* Hb = (bf16_t*)(ws + WS_H);
    float* X = a.out;

    volatile LAS unsigned* MISC = (volatile LAS unsigned*)((LAS unsigned char*)lds + 131072);
    if (tid < 32) MISC[tid] = 0u;
    __syncthreads();
    XcdBarrier bar; bar.bar = ctl + CW_BAR; bar.x = 0; bar.st = nullptr;
    if (MK_N_LAUNCHES == 1) bar = xcd_barrier_post(ctl + CW_BAR, MISC + 8);
    const int lo = a.ph_lo, hi = a.ph_hi;
#ifndef PHASE_MASK
#define PHASE_MASK 0x3ff
#endif
#define IN(k) (((PHASE_MASK >> (k)) & 1) && lo <= (k) && (k) < hi)
#define SEAM(k) do { if (IN(k) && IN((k) + 1)) xcd_barrier(bar); } while (0)

    if (IN(0)) {
        conv_weight(a.w_in, a.g_mix, D, INW, Win_t, gt, GT);
        conv_weight(a.w_ck, a.g_mem, D, D, Wckv_t, gt, GT);
        conv_weight(a.w_cv, a.g_mem, D, D, Wckv_t + (size_t)D * D, gt, GT);
        conv_weight(a.w_cq, a.g_cross, D, D, Wcq_t, gt, GT);
        conv_weight(a.w_co, nullptr, D, D, Wco_t, gt, GT);
        conv_weight(a.w_up, a.g_ffn, D, DFF, Wup_t, gt, GT);
        conv_weight(a.w_down, nullptr, DFF, D, Wdn_t, gt, GT);
        for (size_t i = gt; i < (size_t)AW * D; i += GT) { const int k = (int)(i / D), n = (int)(i % D); Wo2_t[(size_t)n * D + k] = (bf16_t)f2bf(a.w_out[i]); }
        for (size_t i = gt; i < (size_t)PW * D; i += GT) {
            const int cc = (int)(i / D), n = (int)(i % D), g = cc / 128, c = cc % 128; float s = 0.f;
            for (int e = 0; e < 128; ++e) s += a.w_pool[((size_t)g * 128 + c) * 128 + e] * a.pool_scale[g * 128 + e] * a.w_out[(size_t)(AW + g * 128 + e) * D + n];
            Wo2_t[(size_t)n * D + AW + cc] = (bf16_t)f2bf(s);
        }
        norm_rows(a.x_prompt, XN0, MP, gw, NGW, lane);
        norm_rows(a.x_sample, XN0 + (size_t)MP * D, MS, gw, NGW, lane);
        norm_rows(a.mem_prompt, HM, BATCH * NMEM, gw, NGW, lane);
        for (size_t i = gt; i < (size_t)DEC_B * (WIN - DEC_T) * KVW; i += GT) {
            const int b = (int)(i / ((WIN - DEC_T) * KVW)), r = (int)(i % ((WIN - DEC_T) * KVW));
            a.out[O_WKS + (size_t)b * WIN * KVW + r] = a.cache_win_k[(size_t)b * WIN * KVW + DEC_T * KVW + r];
            a.out[O_WVS + (size_t)b * WIN * KVW + r] = a.cache_win_v[(size_t)b * WIN * KVW + DEC_T * KVW + r];
        }
        for (size_t i = gt; i < (size_t)DEC_B * (PHIST - DEC_T) * PW; i += GT) {
            const int b = (int)(i / ((PHIST - DEC_T) * PW)), r = (int)(i % ((PHIST - DEC_T) * PW));
            a.out[O_PS + (size_t)b * PHIST * PW + r] = a.state_pool[(size_t)b * PHIST * PW + DEC_T * PW + r];
        }
    }
    SEAM(0);
    if (IN(1)) {
        pg8::SegOrder<3> S{}; S.G = G; S.c = bx; S.pa = (size_t)256 * D * 2; S.pb = (size_t)256 * D * 2;
        S.s[0] = pg8::Seg{XN0, Win_t, M / 256, INW / 256, 0};
        S.s[1] = pg8::Seg{HM, Wckv_t, BATCH * NMEM / 256, 2 * D / 256, 1};
        S.s[2] = pg8::Seg{Wckv_t + (size_t)D * D, HM, D / 256, BATCH, 2};
        pg8::gemm_phase<pg8::EpiP1, pg8::SegOrder<3>, true, true>(L, D, D, D, S, pg8::EpiP1{Qb, Kb, Vb, Ub, MK, MV, MVt, a.out});
    }
    SEAM(1);
    if (IN(2)) {
        for (size_t task = gt; task < (size_t)NH * M; task += GT) {
            const int h = (int)(task / M), row = (int)(task % M), kvh = h / 4;
            const float slope = exp2f(-(float)(h + 1)) * LOG2E, sink = a.attn_sinks[h] * LOG2E;
            float q[HD], o[HD];
#pragma unroll
            for (int d = 0; d < HD; ++d) { q[d] = bf2f(Qb[(size_t)row * AW + h * HD + d]); o[d] = 0.f; }
            float m = sink, l = 1.f;
            const bool samp = row >= MP;
            int b, t; if (!samp) { b = row / SEQ; t = row % SEQ; } else { b = (row - MP) / DEC_T; t = (row - MP) % DEC_T; }
            for (int i = 0; i <= WIN; ++i) {
                if (!samp && t - i < 0) break;
                const bool cached = samp && i > t;
                const int j = WIN + t - i;
                const bf16_t* kp = Kb + (size_t)(cached ? row : row - i) * KVW + kvh * HD; const bf16_t* vp = Vb + (size_t)(cached ? row : row - i) * KVW + kvh * HD;
                const float* kc = a.cache_win_k + ((size_t)b * WIN + (cached ? j : 0)) * KVW + kvh * HD; const float* vc = a.cache_win_v + ((size_t)b * WIN + (cached ? j : 0)) * KVW + kvh * HD;
                float s = 0.f;
                if (cached) {
#pragma unroll
                    for (int d = 0; d < HD; ++d) s += q[d] * kc[d];
                } else {
#pragma unroll
                    for (int d = 0; d < HD; ++d) s += q[d] * bf2f(kp[d]);
                }
                s -= slope * (float)i;
                if (s > m) { const float f = exp2f(m - s); l *= f;
#pragma unroll
                    for (int d = 0; d < HD; ++d) o[d] *= f;
                    m = s; }
                const float p = exp2f(s - m); l += p;
                if (cached) {
#pragma unroll
                    for (int d = 0; d < HD; ++d) o[d] += p * vc[d];
                } else {
#pragma unroll
                    for (int d = 0; d < HD; ++d) o[d] += p * bf2f(vp[d]);
                }
            }
            const float il = 1.f / l;
#pragma unroll
            for (int d = 0; d < HD; d += 2) *(unsigned*)(A2 + (size_t)row * D + h * HD + d) = pk2(o[d] * il, o[d + 1] * il);
        }
        for (size_t task = gt; task < (size_t)M * PW; task += GT) {
            const int row = (int)(task / PW), c = (int)(task % PW), w = 2 << (c / 128);
            const bool samp = row >= MP; float s = 0.f, cnt;
            if (!samp) { const int t = row % SEQ; for (int i = 0; i < w; ++i) if (t - i >= 0) s += bf2f(Ub[(size_t)(row - i) * PW + c]); cnt = (float)(t + 1 < w ? t + 1 : w); }
            else { const int b = (row - MP) / DEC_T, t = (row - MP) % DEC_T;
                for (int i = 0; i < w; ++i) { const int ti = t - i; s += ti >= 0 ? bf2f(Ub[(size_t)(row - i) * PW + c]) : a.state_pool[((size_t)b * PHIST + (PHIST + ti)) * PW + c]; } cnt = (float)w; }
            A2[(size_t)row * D + AW + c] = (bf16_t)f2bf(s / cnt - bf2f(Ub[(size_t)row * PW + c]));
        }
    }
    SEAM(2);
    if (IN(3)) {
        pg8::SegOrder<1> S{}; S.G = G; S.c = bx; S.pa = (size_t)256 * D * 2; S.pb = (size_t)256 * D * 2;
        S.s[0] = pg8::Seg{A2, Wo2_t, M / 256, D / 256, 0};
        pg8::gemm_phase<pg8::EpiResidG, pg8::SegOrder<1>, true, true>(L, D, D, D, S, pg8::EpiResidG{a.x_prompt, a.x_sample - (size_t)MP * D, X, XB, rss1});
    }
    SEAM(3);
    if (IN(4)) {
        pg8::SegOrder<1> S{}; S.G = G; S.c = bx; S.pa = (size_t)256 * D * 2; S.pb = (size_t)256 * D * 2;
        S.s[0] = pg8::Seg{XB, Wcq_t, M / 256, D / 256, 0};
        pg8::gemm_phase<pg8::EpiRowScaleG<0>, pg8::SegOrder<1>, true, true>(L, D, D, D, S, pg8::EpiRowScaleG<0>{CQ, D, rss1, (1.0f / 16.0f) * LOG2E});
    }
    SEAM(4);
    if (IN(5)) {
        bf16_t* Pb = (bf16_t*)(ws + WS_P);
        const bool sample_first = ((bx >> 3) & 1) != 0;
        if (sample_first) for (int t0 = 2 * bx; t0 < DEC_B * NCH; t0 += 2 * G) cross_sample_pair(a.cache_mem_k, a.cache_mem_v, CQ, OC, t0, DEC_B * NCH, L);
        for (int Lu = bx; Lu < BATCH * NCH * (SEQ / 256); Lu += G) {
            const int xc = Lu & 7, idx = Lu >> 3, bh = xc * 2 + (idx >> 4), qp = idx & 15, b = bh >> 2, h = bh & 3;
            pg8::OneUnit S1; S1.u.pm = b * (SEQ / 256) + qp; S1.u.pn = h; S1.u.kind = 0;
            S1.u.a = (const char*)(CQ + ((size_t)(b * SEQ + qp * 256)) * D + h * CHD); S1.u.b = (const char*)(MK + (size_t)(b * NMEM) * D + h * CHD);
            pg8::gemm_phase<pg8::EpiSoftmaxP, pg8::OneUnit, false, true>(L, D, D, CHD, S1, pg8::EpiSoftmaxP{Pb});
            asm volatile("s_waitcnt vmcnt(0)" ::: "memory"); __syncthreads();
            pg8::OneUnit S2; S2.u.pm = S1.u.pm; S2.u.pn = h; S2.u.kind = 0;
            S2.u.a = (const char*)(Pb + ((size_t)(b * SEQ + qp * 256)) * D + h * CHD); S2.u.b = (const char*)(MVt + ((size_t)b * D + h * CHD) * NMEM);
            pg8::gemm_phase<pg8::EpiStoreBf16, pg8::OneUnit, true, true>(L, D, NMEM, NMEM, S2, pg8::EpiStoreBf16{OC});
            __syncthreads();
        }
        if (!sample_first) for (int t0 = 2 * bx; t0 < DEC_B * NCH; t0 += 2 * G) cross_sample_pair(a.cache_mem_k, a.cache_mem_v, CQ, OC, t0, DEC_B * NCH, L);
    }
    SEAM(5);
    if (IN(6)) {
        pg8::SegOrder<1> S{}; S.G = G; S.c = bx; S.pa = (size_t)256 * D * 2; S.pb = (size_t)256 * D * 2;
        S.s[0] = pg8::Seg{OC, Wco_t, M / 256, D / 256, 0};
        pg8::gemm_phase<pg8::EpiResidG, pg8::SegOrder<1>, true, true>(L, D, D, D, S, pg8::EpiResidG{X, X, X, XB, rss2});
    }
    SEAM(6);
    if (IN(7)) {
        pg8::SegOrder<1> S{}; S.G = G; S.c = bx; S.pa = (size_t)256 * D * 2; S.pb = (size_t)256 * D * 2;
        S.s[0] = pg8::Seg{XB, Wup_t, M / 256, DFF / 256, 0};
        pg8::gemm_phase<pg8::EpiRowScaleG<1>, pg8::SegOrder<1>, true, true>(L, D, D, D, S, pg8::EpiRowScaleG<1>{Hb, DFF, rss2, 1.0f});
    }
    SEAM(7);
    if (IN(8)) {
        pg8::SegOrder<1> S{}; S.G = G; S.c = bx; S.pa = (size_t)256 * DFF * 2; S.pb = (size_t)256 * DFF * 2;
        S.s[0] = pg8::Seg{Hb, Wdn_t, M / 256, D / 256, 0};
        pg8::gemm_phase<pg8::EpiResidG, pg8::SegOrder<1>, true, true>(L, DFF, DFF, DFF, S, pg8::EpiResidG{X, X, X, nullptr, rss3});
    }
    SEAM(8);
    if (IN(9)) {
        for (int r = gw; r < M; r += NGW) {
            const float rs = rsqrtf(rss3[r] * (1.f / D) + EPS);
            f32x4* xr = (f32x4*)(X + (size_t)r * D) + lane; const f32x4* gp = (const f32x4*)a.g_final + lane;
#pragma unroll
            for (int j = 0; j < 4; ++j) xr[64 * j] = xr[64 * j] * rs * gp[64 * j];
        }
    }
#undef IN
#undef SEAM
}

constexpr int N_PHASES = 10;
extern "C" void kernel_launch(void* const* d_in, const int* in_sizes, int n_in, void* d_out, int out_size, void* d_ws, size_t ws_size, hipStream_t stream) {
    static int grid = 0;
    if (grid == 0) {
        if (n_in != 24 || in_sizes[0] != MP * D || out_size != (int)O_END || ws_size < WS_END) {
            fprintf(stderr, "kernel_launch: unexpected shapes: n_in %d in0 %d out %d ws %zu (need %zu)\n", n_in, n_in > 0 ? in_sizes[0] : -1, out_size, ws_size, (size_t)WS_END); grid = -1; return; }
        int dev = 0, cus = 0, per_cu = 0;
        if (hipGetDevice(&dev) != hipSuccess || hipDeviceGetAttribute(&cus, hipDeviceAttributeMultiprocessorCount, dev) != hipSuccess) { grid = -1; return; }
        if (hipFuncSetAttribute((const void*)fwd, hipFuncAttributeMaxDynamicSharedMemorySize, LDS_BYTES) != hipSuccess) { fprintf(stderr, "kernel_launch: hipFuncSetAttribute failed\n"); grid = -1; return; }
        if (hipOccupancyMaxActiveBlocksPerMultiprocessor(&per_cu, (const void*)fwd, NTHREADS, LDS_BYTES) != hipSuccess || per_cu < 1) { fprintf(stderr, "kernel_launch: occupancy query says %d\n", per_cu); grid = -1; (void)hipGetLastError(); return; }
        grid = cus;
    }
    if (grid < 0) return;
    (void)hipMemsetAsync((char*)d_ws + WS_CTL, 0, CTL_ZERO_BYTES, stream);
    Args a{};
    const float** p = (const float**)&a;
    for (int i = 0; i < 24; ++i) p[i] = (const float*)d_in[i];
    a.out = (float*)d_out; a.ws = (unsigned char*)d_ws;
    if (MK_N_LAUNCHES == 1) { a.ph_lo = 0; a.ph_hi = N_PHASES; hipLaunchKernelGGL(fwd, dim3(grid), dim3(NTHREADS), LDS_BYTES, stream, a); }
    else for (int ph = 0; ph < N_PHASES; ++ph) { a.ph_lo = ph; a.ph_hi = ph + 1; hipLaunchKernelGGL(fwd, dim3(grid), dim3(NTHREADS), LDS_BYTES, stream, a); }
}
```

```cpp
#include <hip/hip_runtime.h>
#include <cstdio>
#include <cstdint>

#ifndef MK_N_LAUNCHES
#define MK_N_LAUNCHES 1
#endif

constexpr int D = 1024, BATCH = 4, SEQ = 4096, DEC_B = 128, DEC_T = 8, PAST = 16384;
constexpr int HD = 64, AW = 512, NH = 8, NKV = 2, KVW = 128, WIN = 128, PW = 512, PHIST = 15, INW = 1280;
constexpr int NMEM = 256, NCH = 4, CHD = 256, DFF = 4096;
constexpr int MP = BATCH * SEQ, MS = DEC_B * DEC_T, M = MP + MS;
constexpr float EPS = 1e-5f;
constexpr float LOG2E = 1.4426950408889634f;

constexpr size_t O_YP = 0, O_YS = O_YP + (size_t)MP * D, O_WKP = O_YS + (size_t)MS * D, O_WVP = O_WKP + (size_t)BATCH * WIN * KVW,
                 O_PP = O_WVP + (size_t)BATCH * WIN * KVW, O_MKP = O_PP + (size_t)BATCH * PHIST * PW, O_MVP = O_MKP + (size_t)BATCH * NMEM * D,
                 O_WKS = O_MVP + (size_t)BATCH * NMEM * D, O_WVS = O_WKS + (size_t)DEC_B * WIN * KVW, O_PS = O_WVS + (size_t)DEC_B * WIN * KVW,
                 O_END = O_PS + (size_t)DEC_B * PHIST * PW;
static_assert(O_END == 25262080, "output size");

constexpr size_t MiB = 1u << 20;
constexpr size_t WS_CTL = 0, CTL_ZERO_BYTES = 1 * MiB;
constexpr size_t WS_WIN = 2 * MiB;
constexpr size_t WS_WCKV = 5 * MiB;
constexpr size_t WS_WO2 = 9 * MiB;
constexpr size_t WS_WCQ = 11 * MiB, WS_WCO = 13 * MiB;
constexpr size_t WS_WUP = 15 * MiB;
constexpr size_t WS_WDN = 23 * MiB;
constexpr size_t WS_HM = 31 * MiB;
constexpr size_t WS_MK = 33 * MiB, WS_MV = 35 * MiB;
constexpr size_t WS_MVT = 36 * MiB + MiB;
constexpr size_t WS_XN0 = 40 * MiB;
constexpr size_t WS_Q = 74 * MiB;
constexpr size_t WS_K = 91 * MiB, WS_V = 96 * MiB;
constexpr size_t WS_U = 101 * MiB;
constexpr size_t WS_A2 = 118 * MiB;
constexpr size_t WS_XB = 152 * MiB;
constexpr size_t WS_CQ = 186 * MiB;
constexpr size_t WS_OC = 220 * MiB;
constexpr size_t WS_P = 254 * MiB;
constexpr size_t WS_H = 286 * MiB;
constexpr size_t WS_END = 422 * MiB;
constexpr int CW_BAR = 4096;
constexpr int CW_RSS1 = 32768, CW_RSS2 = CW_RSS1 + M, CW_RSS3 = CW_RSS2 + M;
static_assert((CW_RSS3 + M) * 4 <= (int)CTL_ZERO_BYTES, "ctl");

constexpr int LDS_BYTES = 147456;
constexpr int NTHREADS = 512, NWAVES = 8;

typedef unsigned short bf16_t;
typedef short bf16x8 __attribute__((ext_vector_type(8)));
typedef float f32x4 __attribute__((ext_vector_type(4)));
typedef unsigned u32x2 __attribute__((ext_vector_type(2)));
typedef unsigned u32x4 __attribute__((ext_vector_type(4)));
#define LAS __attribute__((address_space(3)))

__device__ __forceinline__ unsigned f2bf(float f) { unsigned u = __builtin_bit_cast(unsigned, f); return (u + 0x7fffu + ((u >> 16) & 1u)) >> 16; }
__device__ __forceinline__ unsigned pk2(float lo, float hi) { return f2bf(lo) | (f2bf(hi) << 16); }
__device__ __forceinline__ float bf2f(bf16_t h) { return __builtin_bit_cast(float, (unsigned)h << 16); }
__device__ __forceinline__ float wave_sum(float v) {
#pragma unroll
    for (int o = 1; o < 64; o <<= 1) v += __shfl_xor(v, o);
    return v;
}
__device__ __forceinline__ float wave_max(float v) {
#pragma unroll
    for (int o = 1; o < 64; o <<= 1) v = fmaxf(v, __shfl_xor(v, o));
    return v;
}

#define XB_TMO      128
#define XB_XCNT(j)  (256  + 64 * (j))
#define XB_XSUB(j)  (1280 + 64 * (j))
#define XB_XGEN(j)  (2304 + 64 * (j))
#define XB_TOP      3328
#define XB_TOPGEN   3392
#define XCD_BAR_WORDS 3456
#define XB_SPIN_CAP (1u << 18)
__device__ __forceinline__ unsigned xb_ld(unsigned* p)              { return __hip_atomic_load(p, __ATOMIC_RELAXED, __HIP_MEMORY_SCOPE_AGENT); }
__device__ __forceinline__ unsigned xb_add(unsigned* p, unsigned v) { return __hip_atomic_fetch_add(p, v, __ATOMIC_RELAXED, __HIP_MEMORY_SCOPE_AGENT); }
__device__ __forceinline__ unsigned xb_xcc_id() { return (unsigned)__builtin_amdgcn_s_getreg((3 << 11) | 20) & 0xFu; }
#define XB_SPIN(cond, bar) do { unsigned _sp = 0; while (cond) { __builtin_amdgcn_s_sleep(1); \
    if ((++_sp & 255u) == 0u) { if (xb_ld(&(bar)[XB_TMO])) break; if (_sp > XB_SPIN_CAP) { atomicAdd(&(bar)[XB_TMO], 1u); break; } } } } while (0)
struct XcdBarrier { unsigned* bar; unsigned x; volatile LAS unsigned* st; };
__device__ __forceinline__ XcdBarrier xcd_barrier_post(unsigned* bar, volatile LAS unsigned* st) {
    XcdBarrier b; b.bar = bar; b.x = xb_xcc_id(); b.st = st;
    if (threadIdx.x == 0) (void)xb_add(&bar[XB_XCNT(b.x)], 1u);
    return b;
}
__device__ __forceinline__ void xcd_barrier_complete(unsigned* bar, unsigned x, unsigned& nloc, unsigned& nx) {
    const unsigned G = gridDim.x * gridDim.y * gridDim.z;
    unsigned sum, cnt, mine, sp = 0u;
    for (;;) {
        sum = 0u; cnt = 0u; mine = 0u;
#pragma unroll
        for (unsigned j = 0; j < 16; ++j) { const unsigned c = xb_ld(&bar[XB_XCNT(j)]); sum += c; cnt += (c > 0u) ? 1u : 0u; mine = (j == x) ? c : mine; }
        if (sum == G) break;
        __builtin_amdgcn_s_sleep(1);
        if ((++sp & 255u) == 0u) { if (xb_ld(&bar[XB_TMO])) break; if (sp > XB_SPIN_CAP) { atomicAdd(&bar[XB_TMO], 1u); break; } }
    }
    nloc = mine > 0u ? mine : 1u; nx = cnt > 0u ? cnt : 1u;
}
__device__ __forceinline__ void xcd_barrier(const XcdBarrier& b) {
    asm volatile("s_waitcnt vmcnt(0)" ::: "memory");
    __syncthreads();
    if (threadIdx.x == 0) {
        unsigned* bar = b.bar;
        __builtin_amdgcn_s_waitcnt(0);
        unsigned nloc = b.st[0], nx = b.st[1];
        if (nloc == 0u) { xcd_barrier_complete(bar, b.x, nloc, nx); b.st[0] = nloc; b.st[1] = nx; }
        const unsigned old = xb_add(&bar[XB_XSUB(b.x)], 1u);
        const unsigned gen = old / nloc;
        if (old + 1u == (gen + 1u) * nloc) {
            __builtin_amdgcn_fence(__ATOMIC_RELEASE, "agent");
            asm volatile("s_waitcnt vmcnt(0)" ::: "memory");
            const unsigned og = xb_add(&bar[XB_TOP], 1u);
            const unsigned tg = og / nx;
            if (og + 1u == (tg + 1u) * nx) xb_add(&bar[XB_TOPGEN], 1u);
            else XB_SPIN(xb_ld(&bar[XB_TOPGEN]) == tg, bar);
            __builtin_amdgcn_fence(__ATOMIC_ACQUIRE, "agent");
            xb_add(&bar[XB_XGEN(b.x)], 1u);
            asm volatile("s_waitcnt vmcnt(0)" ::: "memory");
        } else {
            XB_SPIN(xb_ld(&bar[XB_XGEN(b.x)]) == gen, bar);
            __builtin_amdgcn_fence(__ATOMIC_ACQUIRE, "agent");
            asm volatile("s_waitcnt vmcnt(0)" ::: "memory");
        }
    }
    __syncthreads();
}

struct Args {
    const float *x_prompt, *x_sample, *cache_win_k, *cache_win_v, *state_pool, *cache_mem_k, *cache_mem_v, *mem_prompt;
    const float *g_mix, *w_in, *attn_sinks, *w_pool, *pool_scale, *w_out, *g_cross, *g_mem, *w_cq, *w_ck, *w_cv, *w_co, *g_ffn, *w_up, *w_down, *g_final;
    float* out; unsigned char* ws; int ph_lo, ph_hi;
};

template <class Epi>
__device__ __forceinline__ void gemm_naive(const bf16_t* A, int lda, const bf16_t* Bt, int ldb, int Mr, int N, int K, const Epi& epi) {
    const int wid = threadIdx.x >> 6, lane = threadIdx.x & 63, wr = wid >> 2, wc = wid & 3, fr = lane & 15, fq = lane >> 4;
    const int tn_n = N / 256, ntiles = (Mr / 128) * tn_n;
    for (int t = blockIdx.x; t < ntiles; t += gridDim.x) {
        const int tm = t / tn_n, tn = t % tn_n;
        const int r0 = tm * 128 + wr * 64, c0 = tn * 256 + wc * 64;
        f32x4 acc[4][4];
#pragma unroll
        for (int i = 0; i < 4; ++i)
#pragma unroll
            for (int j = 0; j < 4; ++j) acc[i][j] = (f32x4){0.f, 0.f, 0.f, 0.f};
        const bf16_t* ap = A + (size_t)(r0 + fr) * lda + fq * 8;
        const bf16_t* bp = Bt + (size_t)(c0 + fr) * ldb + fq * 8;
        for (int k0 = 0; k0 < K; k0 += 32) {
            bf16x8 a[4], b[4];
#pragma unroll
            for (int i = 0; i < 4; ++i) a[i] = *(const bf16x8*)(ap + (size_t)(i * 16) * lda + k0);
#pragma unroll
            for (int j = 0; j < 4; ++j) b[j] = *(const bf16x8*)(bp + (size_t)(j * 16) * ldb + k0);
#pragma unroll
            for (int i = 0; i < 4; ++i)
#pragma unroll
                for (int j = 0; j < 4; ++j) acc[i][j] = __builtin_amdgcn_mfma_f32_16x16x32_bf16(b[j], a[i], acc[i][j], 0, 0, 0);
        }
        epi(acc, r0 + fr, c0 + 4 * fq, fq);
    }
}

struct EpiProj {
    bf16_t *Q, *Kb, *Vb, *U; float* out;
    __device__ __forceinline__ void operator()(const f32x4 (&acc)[4][4], int row0, int col0, int) const {
#pragma unroll
        for (int i = 0; i < 4; ++i) {
            const int row = row0 + 16 * i;
            const bool samp = row >= MP;
            int b, t; if (!samp) { b = row / SEQ; t = row % SEQ; } else { b = (row - MP) / DEC_T; t = (row - MP) % DEC_T; }
#pragma unroll
            for (int j = 0; j < 4; ++j) {
                const int col = col0 + 16 * j; const f32x4 v = acc[i][j];
                if (col < AW) {
                    const float s = 0.125f * LOG2E;
                    *(u32x2*)(Q + (size_t)row * AW + col) = (u32x2){pk2(v[0] * s, v[1] * s), pk2(v[2] * s, v[3] * s)};
                } else if (col < AW + 2 * KVW) {
                    const bool isv = col >= AW + KVW; const int c = col - AW - (isv ? KVW : 0);
                    *(u32x2*)((isv ? Vb : Kb) + (size_t)row * KVW + c) = (u32x2){pk2(v[0], v[1]), pk2(v[2], v[3])};
                    if (!samp) { if (t >= SEQ - WIN) *(f32x4*)(out + (isv ? O_WVP : O_WKP) + ((size_t)b * WIN + (t - (SEQ - WIN))) * KVW + c) = v; }
                    else *(f32x4*)(out + (isv ? O_WVS : O_WKS) + ((size_t)b * WIN + (WIN - DEC_T + t)) * KVW + c) = v;
                } else {
                    const int c = col - AW - 2 * KVW;
                    *(u32x2*)(U + (size_t)row * PW + c) = (u32x2){pk2(v[0], v[1]), pk2(v[2], v[3])};
                    if (!samp) { if (t >= SEQ - PHIST) *(f32x4*)(out + O_PP + ((size_t)b * PHIST + (t - (SEQ - PHIST))) * PW + c) = v; }
                    else *(f32x4*)(out + O_PS + ((size_t)b * PHIST + (PHIST - DEC_T + t)) * PW + c) = v;
                }
            }
        }
    }
};
struct EpiMemKV {
    bf16_t *MK, *MV; float* out;
    __device__ __forceinline__ void operator()(const f32x4 (&acc)[4][4], int row0, int col0, int) const {
#pragma unroll
        for (int i = 0; i < 4; ++i)
#pragma unroll
            for (int j = 0; j < 4; ++j) {
                const int row = row0 + 16 * i, col = col0 + 16 * j; const f32x4 v = acc[i][j];
                const bool isv = col >= D; const int c = col - (isv ? D : 0);
                *(f32x4*)(out + (isv ? O_MVP : O_MKP) + (size_t)row * D + c) = v;
                *(u32x2*)((isv ? MV : MK) + (size_t)row * D + c) = (u32x2){pk2(v[0], v[1]), pk2(v[2], v[3])};
            }
    }
};
struct EpiResid {
    const float* base; float* X; bf16_t* XB; float* rss;
    __device__ __forceinline__ void operator()(const f32x4 (&acc)[4][4], int row0, int col0, int fq) const {
#pragma unroll
        for (int i = 0; i < 4; ++i) {
            const int row = row0 + 16 * i; float s = 0.f;
#pragma unroll
            for (int j = 0; j < 4; ++j) {
                const int col = col0 + 16 * j;
                const f32x4 v = *(const f32x4*)(base + (size_t)row * D + col) + acc[i][j];
                *(f32x4*)(X + (size_t)row * D + col) = v;
                if (XB) *(u32x2*)(XB + (size_t)row * D + col) = (u32x2){pk2(v[0], v[1]), pk2(v[2], v[3])};
                s += (v[0] * v[0] + v[1] * v[1]) + (v[2] * v[2] + v[3] * v[3]);
            }
            s += __shfl_xor(s, 16); s += __shfl_xor(s, 32);
            if (fq == 0) atomicAdd(rss + row, s);
        }
    }
};
template <int ACT>
struct EpiRowScale {
    bf16_t* O; int ldo; const float* rss; float scale;
    __device__ __forceinline__ void operator()(const f32x4 (&acc)[4][4], int row0, int col0, int) const {
#pragma unroll
        for (int i = 0; i < 4; ++i) {
            const int row = row0 + 16 * i; const float rs = rsqrtf(rss[row] * (1.0f / D) + EPS);
#pragma unroll
            for (int j = 0; j < 4; ++j) {
                const int col = col0 + 16 * j; f32x4 v = acc[i][j] * rs;
                if (ACT == 1) {
#pragma unroll
                    for (int e = 0; e < 4; ++e) { const float r = fmaxf(v[e], 0.f); v[e] = r * r; }
                }
                v = v * scale;
                *(u32x2*)(O + (size_t)row * ldo + col) = (u32x2){pk2(v[0], v[1]), pk2(v[2], v[3])};
            }
        }
    }
};


namespace pg8 {
constexpr int BM = 256, BK = 64, HALF = 128, HTB = HALF * BK * 2, STAGE_BYTES = 8 * HTB, NXCD = 8, WGM = 8;
__host__ __device__ __forceinline__ int lds_byte(int r, int c) { const int st = (r >> 4) * 2 + (c >> 5), rr = r & 15, cc = c & 31, ob = rr * 64 + cc * 2; return st * 1024 + (ob ^ (((ob >> 9) & 1) << 5)); }
__host__ __device__ __forceinline__ void stage_rc(int b, int& R, int& C) { const int st = b / 1024, sb = b % 1024, swz = sb ^ (((sb >> 9) & 1) << 5); R = (st >> 1) * 16 + swz / 64; C = (st & 1) * 32 + (swz % 64) / 2; }
__host__ __device__ __forceinline__ int perm32(int rho) { const int n = rho >> 4, i = rho & 15; return 8 * (i >> 2) + 4 * n + (i & 3); }

struct Unit { const char* a; const char* b; int pm, pn, kind; };
struct Seg { const bf16_t* A; const bf16_t* B; int nM, nN, kind; };
template <int NSEG> struct SegOrder {
    Seg s[NSEG]; int G, c; size_t pa, pb;
    __device__ __forceinline__ bool next(int i, Unit& u) const {
        long L = (long)i * G + c;
#pragma unroll
        for (int k = 0; k < NSEG; ++k) {
            const int nM = s[k].nM, nN = s[k].nN, nwg = nM * nN;
            if (L < nwg) {
                int wgid = (int)L; { const int q = nwg / NXCD, r = nwg % NXCD, xcd = wgid % NXCD, off = wgid / NXCD; wgid = (xcd < r ? xcd * (q + 1) : r * (q + 1) + (xcd - r) * q) + off; }
                const int nig = WGM * nN, gid = wgid / nig, fm = gid * WGM, gsz = (nM - fm) < WGM ? (nM - fm) : WGM;
                u.pm = fm + ((wgid % nig) % gsz); u.pn = (wgid % nig) / gsz; u.kind = s[k].kind;
                u.a = (const char*)s[k].A + (size_t)u.pm * pa; u.b = (const char*)s[k].B + (size_t)u.pn * pb; return true;
            }
            L -= nwg;
        }
        return false;
    }
};
__device__ __forceinline__ unsigned cvt_pk_bf16(float lo, float hi) { unsigned r; asm volatile("v_cvt_pk_bf16_f32 %0, %1, %2" : "=v"(r) : "v"(lo), "v"(hi)); return r; }
__device__ __forceinline__ u32x4 pack8(const f32x4 v0, const f32x4 v1) { u32x4 w; w.x = cvt_pk_bf16(v0[0], v0[1]); w.y = cvt_pk_bf16(v0[2], v0[3]); w.z = cvt_pk_bf16(v1[0], v1[1]); w.w = cvt_pk_bf16(v1[2], v1[3]); return w; }

template <class Epi, class Sched, bool ALIGN_EPI, bool SP2>
__device__ __forceinline__ void gemm_phase(LAS unsigned char* lds, const int lda, const int ldb, const int K, const Sched& S, const Epi& E) {
    int tid_ = threadIdx.x; asm volatile("" : "+v"(tid_));
    const int tid = tid_, wid = __builtin_amdgcn_readfirstlane(tid >> 6), lane = tid & 63, wr = wid >> 2, wc = wid & 3, fr = lane & 15, fq = lane >> 4;
    const int nt = K / BK;
    unsigned voffA[2], voffB[2];
#pragma unroll
    for (int i = 0; i < 2; ++i) { int R, C; stage_rc(tid * 16 + i * 8192, R, C); const int Rb = Epi::PERM ? ((R & ~31) + perm32(R & 31)) : R;
        voffA[i] = (unsigned)(R * lda + C) * 2u; voffB[i] = (unsigned)(Rb * ldb + C) * 2u; }
    const size_t kstep = (size_t)(BK * 2);
    const size_t hstepA = (size_t)HALF * lda * 2, hstepB = (size_t)HALF * ldb * 2;
    const unsigned ldsw = (unsigned)wid * 1024u;
    const int aoff = lds_byte(wr * 64 + fr, fq * 8), boff = lds_byte(wc * 32 + fr, fq * 8);
#define PG8_SA(b, h) (((b) * 2 + (h)) * HTB)
#define PG8_SB(b, h) ((4 + (b) * 2 + (h)) * HTB)
#define PG8_STAGE(bufoff, gbase, voff) do { _Pragma("unroll") for (int _i = 0; _i < 2; ++_i) \
        __builtin_amdgcn_global_load_lds((const unsigned*)((const char*)(gbase) + (voff)[_i]), (LAS unsigned*)(lds + (bufoff) + ldsw + _i * 8192), 16, 0, 0); } while (0)
#define PG8_LDA(dst, b, h) do { _Pragma("unroll") for (int m = 0; m < 4; ++m) _Pragma("unroll") for (int k = 0; k < 2; ++k) dst[m][k] = *(const LAS bf16x8*)(lds + PG8_SA(b, h) + aoff + m * 2048 + k * 1024); } while (0)
#define PG8_LDB(dst, b, h) do { _Pragma("unroll") for (int n = 0; n < 2; ++n) _Pragma("unroll") for (int k = 0; k < 2; ++k) dst[n][k] = *(const LAS bf16x8*)(lds + PG8_SB(b, h) + boff + n * 2048 + k * 1024); } while (0)
#define PG8_MMA(ai, bj, At, Bt) do { __builtin_amdgcn_s_setprio(1); _Pragma("unroll") for (int m = 0; m < 4; ++m) _Pragma("unroll") for (int n = 0; n < 2; ++n) _Pragma("unroll") for (int k = 0; k < 2; ++k) \
        acc[ai][bj][m][n] = __builtin_amdgcn_mfma_f32_16x16x32_bf16(Bt[n][k], At[m][k], acc[ai][bj][m][n], 0, 0, 0); __builtin_amdgcn_s_setprio(0); } while (0)
#define PG8_WAIT_V(n) asm volatile("s_waitcnt vmcnt(" #n ")" ::: "memory")
#define PG8_WAIT_L(n) asm volatile("s_waitcnt lgkmcnt(" #n ")" ::: "memory")
#define PG8_BAR __builtin_amdgcn_s_barrier()
#define PG8_SCHED __builtin_amdgcn_sched_barrier(0)
    Unit cur, nxt; int ui = 0;
    if (!S.next(0, cur)) return;
    f32x4 acc[2][2][4][2];
#pragma unroll
    for (int a = 0; a < 2; ++a)
#pragma unroll
        for (int b = 0; b < 2; ++b)
#pragma unroll
            for (int m = 0; m < 4; ++m)
#pragma unroll
                for (int n = 0; n < 2; ++n) acc[a][b][m][n] = (f32x4){0.f, 0.f, 0.f, 0.f};
    bf16x8 At[4][2], B0[2][2], B1[2][2];
    const char* cA = cur.a; const char* cB = cur.b;
    if constexpr (SP2) {
        PG8_STAGE(PG8_SB(0, 0), cB, voffB); PG8_STAGE(PG8_SB(0, 1), cB + hstepB, voffB); PG8_STAGE(PG8_SA(0, 0), cA, voffA); PG8_STAGE(PG8_SA(0, 1), cA + hstepA, voffA);
        if (wr == 1) PG8_BAR;
        PG8_WAIT_V(2); PG8_BAR;
        PG8_STAGE(PG8_SB(1, 0), cB + kstep, voffB); PG8_STAGE(PG8_SA(1, 0), cA + kstep, voffA); PG8_STAGE(PG8_SB(1, 1), cB + hstepB + kstep, voffB);
        PG8_WAIT_V(6); PG8_BAR;
    } else {
        PG8_STAGE(PG8_SB(0, 0), cB, voffB); PG8_STAGE(PG8_SA(0, 0), cA, voffA); PG8_STAGE(PG8_SB(0, 1), cB + hstepB, voffB); PG8_STAGE(PG8_SA(0, 1), cA + hstepA, voffA);
        if (wr == 1) PG8_BAR;
        PG8_WAIT_V(4); PG8_BAR;
        PG8_STAGE(PG8_SB(1, 0), cB + kstep, voffB); PG8_STAGE(PG8_SA(1, 0), cA + kstep, voffA); PG8_STAGE(PG8_SB(1, 1), cB + hstepB + kstep, voffB);
        PG8_WAIT_V(6); PG8_BAR;
    }
    for (;;) {
        const bool has_next = S.next(ui + 1, nxt);
        const char* nA = has_next ? nxt.a : cA; const char* nB = has_next ? nxt.b : cB;
        for (int t = 0; t < nt; t += 2) {
            const bool last = (t == nt - 2);
            const char* a1 = cA + (size_t)(t + 1) * kstep;
            const char* a2 = last ? nA : cA + (size_t)(t + 2) * kstep; const char* b2 = last ? nB : cB + (size_t)(t + 2) * kstep;
            const char* a3 = a2 + kstep; const char* b3 = b2 + kstep;
            if constexpr (SP2) {
            PG8_LDB(B0, 0, 0); PG8_LDB(B1, 0, 1); PG8_SCHED; PG8_LDA(At, 0, 0); PG8_STAGE(PG8_SA(1, 1), a1 + hstepA, voffA);
            PG8_WAIT_V(8); PG8_WAIT_L(0); PG8_BAR; PG8_MMA(0, 0, At, B0); PG8_MMA(0, 1, At, B1); PG8_BAR; PG8_SCHED;
            PG8_LDA(At, 0, 1); PG8_STAGE(PG8_SB(0, 0), b2, voffB); PG8_STAGE(PG8_SB(0, 1), b2 + hstepB, voffB); PG8_STAGE(PG8_SA(0, 0), a2, voffA);
            PG8_WAIT_V(8); PG8_WAIT_L(0); PG8_BAR; PG8_MMA(1, 0, At, B0); PG8_MMA(1, 1, At, B1); PG8_BAR; PG8_SCHED;
            PG8_LDB(B0, 1, 0); PG8_LDB(B1, 1, 1); PG8_SCHED; PG8_LDA(At, 1, 0); PG8_STAGE(PG8_SA(0, 1), a2 + hstepA, voffA);
            PG8_WAIT_V(8); PG8_WAIT_L(0); PG8_BAR; PG8_MMA(0, 0, At, B0); PG8_MMA(0, 1, At, B1); PG8_BAR; PG8_SCHED;
            PG8_LDA(At, 1, 1); PG8_STAGE(PG8_SB(1, 0), b3, voffB); PG8_STAGE(PG8_SB(1, 1), b3 + hstepB, voffB); PG8_STAGE(PG8_SA(1, 0), a3, voffA);
            PG8_WAIT_V(8); PG8_WAIT_L(0); PG8_BAR; PG8_MMA(1, 0, At, B0); PG8_MMA(1, 1, At, B1); PG8_BAR; PG8_SCHED;
            } else {
            PG8_LDB(B0, 0, 0); PG8_SCHED; PG8_LDA(At, 0, 0); PG8_STAGE(PG8_SA(1, 1), a1 + hstepA, voffA);
            PG8_WAIT_L(8); PG8_BAR; PG8_WAIT_L(0); PG8_MMA(0, 0, At, B0); PG8_BAR; PG8_SCHED;
            PG8_LDB(B1, 0, 1); PG8_STAGE(PG8_SB(0, 0), b2, voffB);
            PG8_BAR; PG8_WAIT_L(0); PG8_MMA(0, 1, At, B1); PG8_BAR;
            PG8_LDA(At, 0, 1); PG8_STAGE(PG8_SA(0, 0), a2, voffA);
            PG8_BAR; PG8_WAIT_L(0); PG8_MMA(1, 0, At, B0); PG8_BAR; PG8_SCHED;
            PG8_STAGE(PG8_SB(0, 1), b2 + hstepB, voffB);
            PG8_WAIT_V(6); PG8_BAR; PG8_MMA(1, 1, At, B1); PG8_BAR;
            PG8_LDB(B0, 1, 0); PG8_SCHED; PG8_LDA(At, 1, 0); PG8_STAGE(PG8_SA(0, 1), a2 + hstepA, voffA);
            PG8_WAIT_L(8); PG8_BAR; PG8_WAIT_L(0); PG8_MMA(0, 0, At, B0); PG8_BAR; PG8_SCHED;
            PG8_LDB(B1, 1, 1); PG8_STAGE(PG8_SB(1, 0), b3, voffB);
            PG8_BAR; PG8_WAIT_L(0); PG8_MMA(0, 1, At, B1); PG8_BAR;
            PG8_LDA(At, 1, 1); PG8_STAGE(PG8_SA(1, 0), a3, voffA);
            PG8_BAR; PG8_WAIT_L(0); PG8_MMA(1, 0, At, B0); PG8_BAR; PG8_SCHED;
            PG8_STAGE(PG8_SB(1, 1), b3 + hstepB, voffB);
            PG8_WAIT_V(6); PG8_BAR; PG8_MMA(1, 1, At, B1); PG8_BAR;
            }
        }
        if constexpr (ALIGN_EPI) { if (wr == 0) PG8_BAR; }
        if constexpr (!Epi::AFTER_DRAIN) { E(acc, cur, wr, wc, fr, fq); }
        if (!has_next) break;
#pragma unroll
        for (int a = 0; a < 2; ++a)
#pragma unroll
            for (int b = 0; b < 2; ++b)
#pragma unroll
                for (int m = 0; m < 4; ++m)
#pragma unroll
                    for (int n = 0; n < 2; ++n) acc[a][b][m][n] = (f32x4){0.f, 0.f, 0.f, 0.f};
        cur = nxt; cA = nA; cB = nB; ++ui;
        if constexpr (ALIGN_EPI) { if (wr == 1) PG8_BAR; }
    }
    PG8_WAIT_V(0);
    if constexpr (!ALIGN_EPI) { if (wr == 0) PG8_BAR; }
    PG8_BAR;
    if constexpr (Epi::AFTER_DRAIN) { E.fused(acc, cur, wr, wc, fr, fq, lds, wid, lane); }
#undef PG8_SA
#undef PG8_SB
#undef PG8_STAGE
#undef PG8_LDA
#undef PG8_LDB
#undef PG8_MMA
#undef PG8_WAIT_V
#undef PG8_WAIT_L
#undef PG8_BAR
#undef PG8_SCHED
}

struct EpiP1 {
    static constexpr bool PERM = true, AFTER_DRAIN = false;
    bf16_t *Q, *Kb, *Vb, *U, *MK, *MV, *MVt; float* out;
    __device__ __forceinline__ void operator()(const f32x4 (&acc)[2][2][4][2], const Unit& u, int wr, int wc, int fr, int fq) const {
        const int cl = wc * 32 + 8 * fq;
        if (u.kind == 0) {
            const bool samp = u.pm >= MP / 256;
#pragma unroll
            for (int ai = 0; ai < 2; ++ai)
#pragma unroll
                for (int m = 0; m < 4; ++m) {
                    const int row = u.pm * 256 + ai * 128 + wr * 64 + m * 16 + fr;
                    int b, t; if (!samp) { b = row / SEQ; t = row % SEQ; } else { b = (row - MP) / DEC_T; t = (row - MP) % DEC_T; }
#pragma unroll
                    for (int bj = 0; bj < 2; ++bj) {
                        const f32x4 v0 = acc[ai][bj][m][0], v1 = acc[ai][bj][m][1];
                        if (u.pn < 2) { const float s = 0.125f * LOG2E; *(u32x4*)(Q + (size_t)row * AW + u.pn * 256 + bj * 128 + cl) = pack8(v0 * s, v1 * s); }
                        else if (u.pn == 2) {
                            *(u32x4*)((bj ? Vb : Kb) + (size_t)row * KVW + cl) = pack8(v0, v1);
                            float* o = nullptr;
                            if (!samp) { if (t >= SEQ - WIN) o = out + (bj ? O_WVP : O_WKP) + ((size_t)b * WIN + (t - (SEQ - WIN))) * KVW + cl; }
                            else o = out + (bj ? O_WVS : O_WKS) + ((size_t)b * WIN + (WIN - DEC_T + t)) * KVW + cl;
                            if (o) { *(f32x4*)o = v0; *(f32x4*)(o + 4) = v1; }
                        } else {
                            const int c = (u.pn - 3) * 256 + bj * 128 + cl;
                            *(u32x4*)(U + (size_t)row * PW + c) = pack8(v0, v1);
                            float* o = nullptr;
                            if (!samp) { if (t >= SEQ - PHIST) o = out + O_PP + ((size_t)b * PHIST + (t - (SEQ - PHIST))) * PW + c; }
                            else o = out + O_PS + ((size_t)b * PHIST + (PHIST - DEC_T + t)) * PW + c;
                            if (o) { *(f32x4*)o = v0; *(f32x4*)(o + 4) = v1; }
                        }
                    }
                }
        } else if (u.kind == 1) {
            const bool isv = u.pn >= 4;
#pragma unroll
            for (int ai = 0; ai < 2; ++ai)
#pragma unroll
                for (int m = 0; m < 4; ++m) {
                    const int row = u.pm * 256 + ai * 128 + wr * 64 + m * 16 + fr;
#pragma unroll
                    for (int bj = 0; bj < 2; ++bj) {
                        const f32x4 v0 = acc[ai][bj][m][0], v1 = acc[ai][bj][m][1];
                        const int c = (u.pn & 3) * 256 + bj * 128 + cl;
                        float* o = out + (isv ? O_MVP : O_MKP) + (size_t)row * D + c; *(f32x4*)o = v0; *(f32x4*)(o + 4) = v1;
                        *(u32x4*)((isv ? MV : MK) + (size_t)row * D + c) = pack8(v0, v1);
                    }
                }
        } else {
#pragma unroll
            for (int ai = 0; ai < 2; ++ai)
#pragma unroll
                for (int m = 0; m < 4; ++m) {
                    const int dd = u.pm * 256 + ai * 128 + wr * 64 + m * 16 + fr;
#pragma unroll
                    for (int bj = 0; bj < 2; ++bj) *(u32x4*)(MVt + ((size_t)u.pn * D + dd) * NMEM + bj * 128 + cl) = pack8(acc[ai][bj][m][0], acc[ai][bj][m][1]);
                }
        }
    }
};
struct EpiResidG {
    static constexpr bool PERM = true, AFTER_DRAIN = false;
    const float* baseP; const float* baseS; float* X; bf16_t* XB; float* rss;
    __device__ __forceinline__ void operator()(const f32x4 (&acc)[2][2][4][2], const Unit& u, int wr, int wc, int fr, int fq) const {
        const float* base = u.pm >= MP / 256 ? baseS : baseP;
        const int col0 = u.pn * 256 + wc * 32 + 8 * fq;
#pragma unroll
        for (int ai = 0; ai < 2; ++ai)
#pragma unroll
            for (int m = 0; m < 4; ++m) {
                const int row = u.pm * 256 + ai * 128 + wr * 64 + m * 16 + fr; float s = 0.f;
#pragma unroll
                for (int bj = 0; bj < 2; ++bj) {
                    const size_t off = (size_t)row * D + col0 + bj * 128;
                    const f32x4 v0 = *(const f32x4*)(base + off) + acc[ai][bj][m][0], v1 = *(const f32x4*)(base + off + 4) + acc[ai][bj][m][1];
                    *(f32x4*)(X + off) = v0; *(f32x4*)(X + off + 4) = v1;
                    if (XB) *(u32x4*)(XB + off) = pack8(v0, v1);
                    s += ((v0[0] * v0[0] + v0[1] * v0[1]) + (v0[2] * v0[2] + v0[3] * v0[3])) + ((v1[0] * v1[0] + v1[1] * v1[1]) + (v1[2] * v1[2] + v1[3] * v1[3]));
                }
                s += __shfl_xor(s, 16); s += __shfl_xor(s, 32);
                if (fq == 0) atomicAdd(rss + row, s);
            }
    }
};
template <int ACT>
struct EpiRowScaleG {
    static constexpr bool PERM = true, AFTER_DRAIN = false;
    bf16_t* O; int ldo; const float* rss; float scale;
    __device__ __forceinline__ void operator()(const f32x4 (&acc)[2][2][4][2], const Unit& u, int wr, int wc, int fr, int fq) const {
        const int col0 = u.pn * 256 + wc * 32 + 8 * fq;
#pragma unroll
        for (int ai = 0; ai < 2; ++ai)
#pragma unroll
            for (int m = 0; m < 4; ++m) {
                const int row = u.pm * 256 + ai * 128 + wr * 64 + m * 16 + fr;
                const float rs = rsqrtf(rss[row] * (1.0f / D) + EPS);
#pragma unroll
                for (int bj = 0; bj < 2; ++bj) {
                    f32x4 v0 = acc[ai][bj][m][0] * rs, v1 = acc[ai][bj][m][1] * rs;
                    if (ACT == 1) {
#pragma unroll
                        for (int e = 0; e < 4; ++e) { const float r0 = fmaxf(v0[e], 0.f), r1 = fmaxf(v1[e], 0.f); v0[e] = r0 * r0; v1[e] = r1 * r1; }
                    }
                    *(u32x4*)(O + (size_t)row * ldo + col0 + bj * 128) = pack8(v0 * scale, v1 * scale);
                }
            }
    }
};

struct OneUnit { Unit u; __device__ __forceinline__ bool next(int i, Unit& o) const { if (i != 0) return false; o = u; return true; } };
struct EpiSoftmaxP {
    static constexpr bool PERM = true, AFTER_DRAIN = true;
    bf16_t* P;
    __device__ __forceinline__ void fused(f32x4 (&acc)[2][2][4][2], const Unit& u, int wr, int wc, int fr, int fq, LAS unsigned char* lds, int wid, int lane) const {
        LAS float* Pm = (LAS float*)lds; LAS float* Ps = Pm + 1024;
#pragma unroll
        for (int ai = 0; ai < 2; ++ai)
#pragma unroll
            for (int m = 0; m < 4; ++m) {
                float mx = -3.0e38f;
#pragma unroll
                for (int bj = 0; bj < 2; ++bj)
#pragma unroll
                    for (int n = 0; n < 2; ++n) { const f32x4 x = acc[ai][bj][m][n]; mx = fmaxf(mx, fmaxf(fmaxf(x[0], x[1]), fmaxf(x[2], x[3]))); }
                mx = fmaxf(mx, __shfl_xor(mx, 16)); mx = fmaxf(mx, __shfl_xor(mx, 32));
                if (fq == 0) Pm[(ai * 128 + wr * 64 + m * 16 + fr) * 4 + wc] = mx;
            }
        asm volatile("s_waitcnt lgkmcnt(0)" ::: "memory"); __builtin_amdgcn_s_barrier(); asm volatile("" ::: "memory");
#pragma unroll
        for (int ai = 0; ai < 2; ++ai)
#pragma unroll
            for (int m = 0; m < 4; ++m) {
                const int rl = ai * 128 + wr * 64 + m * 16 + fr;
                const f32x4 pm4 = *(const LAS f32x4*)(Pm + rl * 4); const float mr = fmaxf(fmaxf(pm4[0], pm4[1]), fmaxf(pm4[2], pm4[3]));
                float s = 0.f;
#pragma unroll
                for (int bj = 0; bj < 2; ++bj)
#pragma unroll
                    for (int n = 0; n < 2; ++n) { f32x4 x = acc[ai][bj][m][n];
#pragma unroll
                        for (int e = 0; e < 4; ++e) { x[e] = __builtin_amdgcn_exp2f(x[e] - mr); s += x[e]; }
                        acc[ai][bj][m][n] = x; }
                s += __shfl_xor(s, 16); s += __shfl_xor(s, 32);
                if (fq == 0) Ps[rl * 4 + wc] = s;
            }
        asm volatile("s_waitcnt lgkmcnt(0)" ::: "memory"); __builtin_amdgcn_s_barrier(); asm volatile("" ::: "memory");
#pragma unroll
        for (int ai = 0; ai < 2; ++ai)
#pragma unroll
            for (int m = 0; m < 4; ++m) {
                const int rl = ai * 128 + wr * 64 + m * 16 + fr;
                const f32x4 ps4 = *(const LAS f32x4*)(Ps + rl * 4); const float inv = 1.0f / ((ps4[0] + ps4[1]) + (ps4[2] + ps4[3]));
#pragma unroll
                for (int bj = 0; bj < 2; ++bj)
                    *(u32x4*)(P + (size_t)(u.pm * 256 + rl) * D + u.pn * 256 + bj * 128 + wc * 32 + 8 * fq) = pack8(acc[ai][bj][m][0] * inv, acc[ai][bj][m][1] * inv);
            }
    }
};
struct EpiStoreBf16 {
    static constexpr bool PERM = true, AFTER_DRAIN = false;
    bf16_t* O;
    __device__ __forceinline__ void operator()(const f32x4 (&acc)[2][2][4][2], const Unit& u, int wr, int wc, int fr, int fq) const {
#pragma unroll
        for (int ai = 0; ai < 2; ++ai)
#pragma unroll
            for (int m = 0; m < 4; ++m) {
                const int row = u.pm * 256 + ai * 128 + wr * 64 + m * 16 + fr;
#pragma unroll
                for (int bj = 0; bj < 2; ++bj) *(u32x4*)(O + (size_t)row * D + u.pn * 256 + bj * 128 + wc * 32 + 8 * fq) = pack8(acc[ai][bj][m][0], acc[ai][bj][m][1]);
            }
    }
};
}

__device__ __forceinline__ void conv_weight(const float* W, const float* g, int K, int N, bf16_t* Wt, size_t gt, size_t GT) {
    for (size_t i = gt; i < (size_t)K * N; i += GT) { const int k = (int)(i / N), n = (int)(i % N); Wt[(size_t)n * K + k] = (bf16_t)f2bf(W[i] * (g ? g[k] : 1.f)); }
}
__device__ __forceinline__ void norm_rows(const float* X, bf16_t* O, int rows, int gw, int NGW, int lane) {
    for (int r = gw; r < rows; r += NGW) {
        const f32x4* xr = (const f32x4*)(X + (size_t)r * D) + lane; f32x4 v[4]; float s = 0.f;
#pragma unroll
        for (int j = 0; j < 4; ++j) { v[j] = xr[64 * j]; s += (v[j][0] * v[j][0] + v[j][1] * v[j][1]) + (v[j][2] * v[j][2] + v[j][3] * v[j][3]); }
        const float rs = rsqrtf(wave_sum(s) * (1.f / D) + EPS);
        u32x2* o = (u32x2*)(O + (size_t)r * D) + lane;
#pragma unroll
        for (int j = 0; j < 4; ++j) o[64 * j] = (u32x2){pk2(v[j][0] * rs, v[j][1] * rs), pk2(v[j][2] * rs, v[j][3] * rs)};
    }
}


__device__ __forceinline__ void cross_sample_pair(const float* __restrict__ mk, const float* __restrict__ mv, const bf16_t* __restrict__ CQ, bf16_t* OC, int task0, int ntask, LAS unsigned char* lds) {
    int tid_ = threadIdx.x; asm volatile("" : "+v"(tid_));
    const int tid = tid_, lane = tid & 63, wave = __builtin_amdgcn_readfirstlane(tid >> 6), tk = wave >> 2, mq = wave & 3;
    const int task = task0 + tk; const bool live = task < ntask;
    const int b = (live ? task : 0) / NCH, h = (live ? task : 0) % NCH;
    const int t16 = lane & 15, dq = lane >> 4;
    LAS float* pl = (LAS float*)(lds + wave * 2048);
    LAS float* op = (LAS float*)(lds + 16384 + (tk * 4 + mq) * 8192);
    LAS float* st = (LAS float*)(lds + 81920);
    if (live) {
        bf16x8 qf[8];
#pragma unroll
        for (int ds = 0; ds < 8; ++ds) {
            u32x4 w = (u32x4){0u, 0u, 0u, 0u};
            if (t16 < DEC_T) w = *(const u32x4*)(CQ + (size_t)(MP + b * DEC_T + t16) * D + h * CHD + ds * 32 + dq * 8);
            qf[ds] = __builtin_bit_cast(bf16x8, w);
        }
        f32x4 s[4];
        const float* kb = mk + (((size_t)b * NMEM + mq * 64 + t16) * NCH + h) * CHD + dq * 8;
#pragma unroll
        for (int mt = 0; mt < 4; ++mt) {
            f32x4 kv[16];
#pragma unroll
            for (int ds = 0; ds < 8; ++ds) { const float* p = kb + (size_t)(mt * 16) * NCH * CHD + ds * 32; kv[2 * ds] = *(const f32x4*)p; kv[2 * ds + 1] = *(const f32x4*)(p + 4); }
            f32x4 acc = (f32x4){0.f, 0.f, 0.f, 0.f};
#pragma unroll
            for (int ds = 0; ds < 8; ++ds) acc = __builtin_amdgcn_mfma_f32_16x16x32_bf16(__builtin_bit_cast(bf16x8, pg8::pack8(kv[2 * ds], kv[2 * ds + 1])), qf[ds], acc, 0, 0, 0);
            s[mt] = acc;
        }
        float mx = -3.0e38f;
#pragma unroll
        for (int mt = 0; mt < 4; ++mt) mx = fmaxf(mx, fmaxf(fmaxf(s[mt][0], s[mt][1]), fmaxf(s[mt][2], s[mt][3])));
        mx = fmaxf(mx, __shfl_xor(mx, 16)); mx = fmaxf(mx, __shfl_xor(mx, 32));
        float sum = 0.f;
#pragma unroll
        for (int mt = 0; mt < 4; ++mt)
#pragma unroll
            for (int e = 0; e < 4; ++e) { const float p = __builtin_amdgcn_exp2f(s[mt][e] - mx); sum += p; if (t16 < DEC_T) pl[(mt * 16 + dq * 4 + e) * 8 + t16] = p; }
        sum += __shfl_xor(sum, 16); sum += __shfl_xor(sum, 32);
        if (lane < DEC_T) { st[((tk * 4 + mq) * 8 + lane) * 2] = mx; st[((tk * 4 + mq) * 8 + lane) * 2 + 1] = sum; }
        asm volatile("s_waitcnt lgkmcnt(0)" ::: "memory");
        f32x4 o[8];
#pragma unroll
        for (int t = 0; t < 8; ++t) o[t] = (f32x4){0.f, 0.f, 0.f, 0.f};
        const float* vb = mv + (((size_t)b * NMEM + mq * 64) * NCH + h) * CHD + lane * 4;
#pragma unroll 8
        for (int ml = 0; ml < 64; ++ml) {
            const f32x4 v = *(const f32x4*)(vb + (size_t)ml * NCH * CHD);
            const f32x4 p0 = *(const LAS f32x4*)(pl + ml * 8), p1 = *(const LAS f32x4*)(pl + ml * 8 + 4);
            o[0] += v * p0[0]; o[1] += v * p0[1]; o[2] += v * p0[2]; o[3] += v * p0[3];
            o[4] += v * p1[0]; o[5] += v * p1[1]; o[6] += v * p1[2]; o[7] += v * p1[3];
        }
#pragma unroll
        for (int t = 0; t < 8; ++t) *(LAS f32x4*)(op + t * 256 + lane * 4) = o[t];
    }
    __syncthreads();
    if (live) {
#pragma unroll
        for (int tt = 0; tt < 2; ++tt) {
            const int t = 2 * mq + tt; float m4[4], l4[4]; float M4 = -3.0e38f;
#pragma unroll
            for (int q = 0; q < 4; ++q) { m4[q] = st[((tk * 4 + q) * 8 + t) * 2]; l4[q] = st[((tk * 4 + q) * 8 + t) * 2 + 1]; M4 = fmaxf(M4, m4[q]); }
            float Ls = 0.f; f32x4 o = (f32x4){0.f, 0.f, 0.f, 0.f};
#pragma unroll
            for (int q = 0; q < 4; ++q) { const float f = __builtin_amdgcn_exp2f(m4[q] - M4); Ls += l4[q] * f; o += *(const LAS f32x4*)((LAS float*)(lds + 16384 + (tk * 4 + q) * 8192) + t * 256 + lane * 4) * f; }
            const float il = 1.0f / Ls;
            *(u32x2*)(OC + (size_t)(MP + b * DEC_T + t) * D + h * CHD + lane * 4) = (u32x2){pg8::cvt_pk_bf16(o[0] * il, o[1] * il), pg8::cvt_pk_bf16(o[2] * il, o[3] * il)};
        }
    }
    __syncthreads();
}


typedef float f32x16 __attribute__((ext_vector_type(16)));
typedef short v4i16_t __attribute__((ext_vector_type(4)));
__device__ __forceinline__ int crow(int r, int hi) { return (r & 3) + 8 * (r >> 2) + 4 * hi; }
__device__ __forceinline__ void win_attn_unit(const bf16_t* __restrict__ Qb, const bf16_t* __restrict__ Kb, const bf16_t* __restrict__ Vb, bf16_t* A2, const float* __restrict__ sinks, int unit, LAS unsigned char* lds) {
    int tid_ = threadIdx.x; asm volatile("" : "+v"(tid_));
    const int tid = tid_, lane = tid & 63, wid = __builtin_amdgcn_readfirstlane(tid >> 6), r32 = lane & 31, hi = lane >> 5;
    const int jb = unit & 63, kvh = (unit >> 6) & 1, b = unit >> 7;
    const int q0 = jb * 64, kp0 = q0 - 128;
    const size_t rowb = (size_t)b * SEQ;
#pragma unroll
    for (int tt = 0; tt < 3; ++tt) {
        const int kpos = kp0 + tt * 64 + lane, kr = kpos < 0 ? 0 : kpos;
        const u32x4 kx = *(const u32x4*)(Kb + (rowb + kr) * KVW + kvh * HD + wid * 8);
        const u32x4 vx = *(const u32x4*)(Vb + (rowb + kr) * KVW + kvh * HD + wid * 8);
        *(LAS u32x4*)(lds + tt * 8192 + wid * 1024 + lane * 16) = kx;
        *(LAS u32x4*)(lds + 24576 + tt * 8192 + (wid >> 2) * 4096 + (lane >> 4) * 1024 + (lane & 15) * 64 + (wid & 3) * 16) = vx;
    }
    const int g = wid >> 1, sb = wid & 1, h = kvh * 4 + g;
    const bf16_t* Qw = Qb + (rowb + q0 + sb * 32 + r32) * AW + h * HD;
    bf16x8 qr[4];
#pragma unroll
    for (int d0 = 0; d0 < 4; ++d0) qr[d0] = *(const bf16x8*)(Qw + d0 * 16 + hi * 8);
    __syncthreads();
    f32x16 p[3][2];
#pragma unroll
    for (int tt = 0; tt < 3; ++tt) {
        const LAS unsigned char* kb = lds + tt * 8192 + hi * 1024 + r32 * 16;
        f32x16 a0 = {}, a1 = {};
#pragma unroll
        for (int d0 = 0; d0 < 4; ++d0) {
            const bf16x8 b0 = *(const LAS bf16x8*)(kb + d0 * 2048), b1 = *(const LAS bf16x8*)(kb + d0 * 2048 + 512);
            a0 = __builtin_amdgcn_mfma_f32_32x32x16_bf16(b0, qr[d0], a0, 0, 0, 0); a1 = __builtin_amdgcn_mfma_f32_32x32x16_bf16(b1, qr[d0], a1, 0, 0, 0);
        }
        p[tt][0] = a0; p[tt][1] = a1;
    }
    const float slope = __builtin_amdgcn_exp2f(-(float)(h + 1)) * LOG2E, sink = sinks[h] * LOG2E;
    const int qrel = 128 + sb * 32 + r32;
    float mx = sink;
#pragma unroll
    for (int tt = 0; tt < 3; ++tt)
#pragma unroll
        for (int pp = 0; pp < 2; ++pp)
#pragma unroll
            for (int r = 0; r < 16; ++r) {
                const int krel = 64 * tt + 32 * pp + crow(r, hi), dist = qrel - krel;
                const bool valid = dist >= 0 && dist <= WIN && kp0 + krel >= 0;
                const float s = valid ? p[tt][pp][r] - slope * (float)dist : -3.0e38f;
                p[tt][pp][r] = s; mx = fmaxf(mx, s);
            }
    mx = fmaxf(mx, __shfl_xor(mx, 32));
    float l = 0.f;
#pragma unroll
    for (int tt = 0; tt < 3; ++tt)
#pragma unroll
        for (int pp = 0; pp < 2; ++pp)
#pragma unroll
            for (int r = 0; r < 16; ++r) { const float e = __builtin_amdgcn_exp2f(p[tt][pp][r] - mx); p[tt][pp][r] = e; l += e; }
    l += __shfl_xor(l, 32); l += __builtin_amdgcn_exp2f(sink - mx);
    LAS float* wsf = (LAS float*)(lds + 49152 + wid * 256);
    if (hi == 0) wsf[r32] = l;
    f32x16 o[2] = {{}, {}};
    const LAS unsigned char* vp0 = lds + 24576 + ((lane >> 4) & 1) * 32 + (lane & 3) * 8 + (4 * hi + ((lane & 15) >> 2)) * 64;
#pragma unroll
    for (int tt = 0; tt < 3; ++tt)
#pragma unroll
        for (int ks = 0; ks < 4; ++ks) {
            const f32x16& ps = p[tt][ks >> 1]; const int r0 = 8 * (ks & 1);
            u32x4 pw; pw.x = pg8::cvt_pk_bf16(ps[r0], ps[r0 + 1]); pw.y = pg8::cvt_pk_bf16(ps[r0 + 2], ps[r0 + 3]); pw.z = pg8::cvt_pk_bf16(ps[r0 + 4], ps[r0 + 5]); pw.w = pg8::cvt_pk_bf16(ps[r0 + 6], ps[r0 + 7]);
            const bf16x8 pa = __builtin_bit_cast(bf16x8, pw);
#pragma unroll
            for (int d0 = 0; d0 < 2; ++d0) {
                const LAS unsigned char* vp = vp0 + tt * 8192 + d0 * 4096 + ks * 1024;
                const v4i16_t lo = __builtin_amdgcn_ds_read_tr16_b64_v4i16((LAS v4i16_t*)vp), hh = __builtin_amdgcn_ds_read_tr16_b64_v4i16((LAS v4i16_t*)(vp + 512));
                const bf16x8 vf = (bf16x8){lo[0], lo[1], lo[2], lo[3], hh[0], hh[1], hh[2], hh[3]};
                o[d0] = __builtin_amdgcn_mfma_f32_32x32x16_bf16(pa, vf, o[d0], 0, 0, 0);
            }
        }
    asm volatile("s_waitcnt lgkmcnt(0)" ::: "memory");
    LAS bf16_t* stg = (LAS bf16_t*)(lds + 51200 + wid * 4096);
#pragma unroll
    for (int r = 0; r < 16; ++r) {
        const int orow = crow(r, hi); const float il = 1.0f / wsf[orow];
        stg[orow * 64 + r32] = (bf16_t)f2bf(o[0][r] * il); stg[orow * 64 + 32 + r32] = (bf16_t)f2bf(o[1][r] * il);
    }
    asm volatile("s_waitcnt lgkmcnt(0)" ::: "memory");
    bf16_t* Ow = A2 + (rowb + q0 + sb * 32) * D + h * HD;
#pragma unroll
    for (int i = 0; i < 4; ++i) { const int row = i * 8 + (lane >> 3), ch = lane & 7; *(u32x4*)(Ow + (size_t)row * D + ch * 8) = *(const LAS u32x4*)(stg + row * 64 + ch * 8); }
    __syncthreads();
}
__device__ __forceinline__ void win_attn_sample(const bf16_t* __restrict__ Qb, const bf16_t* __restrict__ Kb, const bf16_t* __restrict__ Vb, const float* __restrict__ ck, const float* __restrict__ cv,
                                                bf16_t* A2, const float* __restrict__ sinks, int task, LAS float* pl, int lane) {
    const int h = task & 7, t = (task >> 3) & 7, b = task >> 6, kvh = h >> 2, row = MP + b * DEC_T + t;
    float q[HD];
    { const u32x4* qp = (const u32x4*)(Qb + (size_t)row * AW + h * HD);
#pragma unroll
      for (int c = 0; c < 8; ++c) { const u32x4 w = qp[c];
#pragma unroll
          for (int e = 0; e < 4; ++e) { q[c * 8 + 2 * e] = __builtin_bit_cast(float, w[e] << 16); q[c * 8 + 2 * e + 1] = __builtin_bit_cast(float, w[e] & 0xffff0000u); } } }
    const float slope = __builtin_amdgcn_exp2f(-(float)(h + 1)) * LOG2E, sink = sinks[h] * LOG2E;
    float sv[3]; float mx = sink;
#pragma unroll
    for (int k = 0; k < 3; ++k) {
        const int i = lane + 64 * k; float s = -3.0e38f;
        if (i <= WIN) {
            float acc = 0.f;
            if (i > t) { const f32x4* kp = (const f32x4*)(ck + ((size_t)b * WIN + (WIN + t - i)) * KVW + kvh * HD);
#pragma unroll
                for (int c = 0; c < 16; ++c) { const f32x4 w = kp[c]; acc += q[4 * c] * w[0] + q[4 * c + 1] * w[1] + q[4 * c + 2] * w[2] + q[4 * c + 3] * w[3]; } }
            else { const u32x4* kp = (const u32x4*)(Kb + (size_t)(row - i) * KVW + kvh * HD);
#pragma unroll
                for (int c = 0; c < 8; ++c) { const u32x4 w = kp[c];
#pragma unroll
                    for (int e = 0; e < 4; ++e) acc += q[c * 8 + 2 * e] * __builtin_bit_cast(float, w[e] << 16) + q[c * 8 + 2 * e + 1] * __builtin_bit_cast(float, w[e] & 0xffff0000u); } }
            s = acc - slope * (float)i;
        }
        sv[k] = s; mx = fmaxf(mx, s);
    }
    mx = wave_max(mx);
    float l = 0.f;
#pragma unroll
    for (int k = 0; k < 3; ++k) { const int i = lane + 64 * k; const float e = (i <= WIN) ? __builtin_amdgcn_exp2f(sv[k] - mx) : 0.f; l += e; if (i <= WIN) pl[i] = e; }
    l = wave_sum(l) + __builtin_amdgcn_exp2f(sink - mx);
    asm volatile("s_waitcnt lgkmcnt(0)" ::: "memory");
    float o = 0.f;
    for (int i = 0; i <= t; ++i) o += pl[i] * bf2f(Vb[(size_t)(row - i) * KVW + kvh * HD + lane]);
    const float* vc = cv + ((size_t)b * WIN) * KVW + kvh * HD + lane;
#pragma unroll 8
    for (int j = t; j < WIN; ++j) o += pl[WIN + t - j] * vc[(size_t)j * KVW];
    A2[(size_t)row * D + h * HD + lane] = (bf16_t)f2bf(o / l);
    asm volatile("s_waitcnt lgkmcnt(0)" ::: "memory");
}
__device__ __forceinline__ void pool_diff(const bf16_t* __restrict__ Ub, const float* __restrict__ sp, bf16_t* A2, size_t gt, size_t GT) {
    for (size_t task = gt; task < (size_t)M * (PW / 8); task += GT) {
        const int row = (int)(task / (PW / 8)), c0 = (int)(task % (PW / 8)) * 8, w = 2 << (c0 / 128);
        float s[8]; float cur[8];
#pragma unroll
        for (int e = 0; e < 8; ++e) s[e] = 0.f;
        const bool samp = row >= MP; int nb, t, b = 0;
        if (!samp) { t = row % SEQ; nb = t + 1 < w ? t + 1 : w; } else { b = (row - MP) / DEC_T; t = (row - MP) % DEC_T; nb = t + 1 < w ? t + 1 : w; }
        for (int i = 0; i < nb; ++i) { const u32x4 x = *(const u32x4*)(Ub + (size_t)(row - i) * PW + c0);
#pragma unroll
            for (int e = 0; e < 4; ++e) { const float lo = __builtin_bit_cast(float, x[e] << 16), hh = __builtin_bit_cast(float, x[e] & 0xffff0000u); s[2 * e] += lo; s[2 * e + 1] += hh; if (i == 0) { cur[2 * e] = lo; cur[2 * e + 1] = hh; } } }
        float cnt = (float)nb;
        if (samp) { for (int i = nb; i < w; ++i) { const float* p = sp + ((size_t)b * PHIST + (PHIST + t - i)) * PW + c0; const f32x4 x0 = *(const f32x4*)p, x1 = *(const f32x4*)(p + 4);
#pragma unroll
                for (int e = 0; e < 4; ++e) { s[e] += x0[e]; s[4 + e] += x1[e]; } } cnt = (float)w; }
        const float ic = 1.0f / cnt;
        *(u32x4*)(A2 + (size_t)row * D + AW + c0) = (u32x4){pk2(s[0] * ic - cur[0], s[1] * ic - cur[1]), pk2(s[2] * ic - cur[2], s[3] * ic - cur[3]), pk2(s[4] * ic - cur[4], s[5] * ic - cur[5]), pk2(s[6] * ic - cur[6], s[7] * ic - cur[7])};
    }
}

__global__ void __launch_bounds__(NTHREADS, 2) fwd(Args a) {
    extern __shared__ __attribute__((aligned(16))) unsigned char lds[];
    const int tid = threadIdx.x, lane = tid & 63, wave = tid >> 6;
    const int G = gridDim.x, bx = blockIdx.x;
    const size_t gt = (size_t)bx * NTHREADS + tid, GT = (size_t)G * NTHREADS;
    const int gw = bx * NWAVES + wave, NGW = G * NWAVES;
    unsigned char* ws = a.ws;
    unsigned* ctl = (unsigned*)(ws + WS_CTL);
    float* rss1 = (float*)(ctl + CW_RSS1); float* rss2 = (float*)(ctl + CW_RSS2); float* rss3 = (float*)(ctl + CW_RSS3);
    bf16_t* Win_t = (bf16_t*)(ws + WS_WIN); bf16_t* Wckv_t = (bf16_t*)(ws + WS_WCKV); bf16_t* Wo2_t = (bf16_t*)(ws + WS_WO2);
    bf16_t* Wcq_t = (bf16_t*)(ws + WS_WCQ); bf16_t* Wco_t = (bf16_t*)(ws + WS_WCO); bf16_t* Wup_t = (bf16_t*)(ws + WS_WUP); bf16_t* Wdn_t = (bf16_t*)(ws + WS_WDN);
    bf16_t* HM = (bf16_t*)(ws + WS_HM); bf16_t* MK = (bf16_t*)(ws + WS_MK); bf16_t* MV = (bf16_t*)(ws + WS_MV); bf16_t* MVt = (bf16_t*)(ws + WS_MVT);
    LAS unsigned char* L = (LAS unsigned char*)lds;
    bf16_t* XN0 = (bf16_t*)(ws + WS_XN0); bf16_t* Qb = (bf16_t*)(ws + WS_Q); bf16_t* Kb = (bf16_t*)(ws + WS_K); bf16_t* Vb = (bf16_t*)(ws + WS_V); bf16_t* Ub = (bf16_t*)(ws + WS_U);
    bf16_t* A2 = (bf16_t*)(ws + WS_A2); bf16_t* XB = (bf16_t*)(ws + WS_XB); bf16_t* CQ = (bf16_t*)(ws + WS_CQ); bf16_t* OC = (bf16_t*)(ws + WS_OC); bf16_t* Hb = (bf16_t*)(ws + WS_H);
    float* X = a.out;

    volatile LAS unsigned* MISC = (volatile LAS unsigned*)((LAS unsigned char*)lds + 131072);
    if (tid < 32) MISC[tid] = 0u;
    __syncthreads();
    XcdBarrier bar; bar.bar = ctl + CW_BAR; bar.x = 0; bar.st = nullptr;
    if (MK_N_LAUNCHES == 1) bar = xcd_barrier_post(ctl + CW_BAR, MISC + 8);
    const int lo = a.ph_lo, hi = a.ph_hi;
#ifndef PHASE_MASK
#define PHASE_MASK 0x3ff
#endif
#define IN(k) (((PHASE_MASK >> (k)) & 1) && lo <= (k) && (k) < hi)
#define SEAM(k) do { if (IN(k) && IN((k) + 1)) xcd_barrier(bar); } while (0)

    if (IN(0)) {
        conv_weight(a.w_in, a.g_mix, D, INW, Win_t, gt, GT);
        conv_weight(a.w_ck, a.g_mem, D, D, Wckv_t, gt, GT);
        conv_weight(a.w_cv, a.g_mem, D, D, Wckv_t + (size_t)D * D, gt, GT);
        conv_weight(a.w_cq, a.g_cross, D, D, Wcq_t, gt, GT);
        conv_weight(a.w_co, nullptr, D, D, Wco_t, gt, GT);
        conv_weight(a.w_up, a.g_ffn, D, DFF, Wup_t, gt, GT);
        conv_weight(a.w_down, nullptr, DFF, D, Wdn_t, gt, GT);
        for (size_t i = gt; i < (size_t)AW * D; i += GT) { const int k = (int)(i / D), n = (int)(i % D); Wo2_t[(size_t)n * D + k] = (bf16_t)f2bf(a.w_out[i]); }
        for (size_t i = gt; i < (size_t)PW * D; i += GT) {
            const int cc = (int)(i / D), n = (int)(i % D), g = cc / 128, c = cc % 128; float s = 0.f;
            for (int e = 0; e < 128; ++e) s += a.w_pool[((size_t)g * 128 + c) * 128 + e] * a.pool_scale[g * 128 + e] * a.w_out[(size_t)(AW + g * 128 + e) * D + n];
            Wo2_t[(size_t)n * D + AW + cc] = (bf16_t)f2bf(s);
        }
        norm_rows(a.x_prompt, XN0, MP, gw, NGW, lane);
        norm_rows(a.x_sample, XN0 + (size_t)MP * D, MS, gw, NGW, lane);
        norm_rows(a.mem_prompt, HM, BATCH * NMEM, gw, NGW, lane);
        for (size_t i = gt; i < (size_t)DEC_B * (WIN - DEC_T) * KVW; i += GT) {
            const int b = (int)(i / ((WIN - DEC_T) * KVW)), r = (int)(i % ((WIN - DEC_T) * KVW));
            a.out[O_WKS + (size_t)b * WIN * KVW + r] = a.cache_win_k[(size_t)b * WIN * KVW + DEC_T * KVW + r];
            a.out[O_WVS + (size_t)b * WIN * KVW + r] = a.cache_win_v[(size_t)b * WIN * KVW + DEC_T * KVW + r];
        }
        for (size_t i = gt; i < (size_t)DEC_B * (PHIST - DEC_T) * PW; i += GT) {
            const int b = (int)(i / ((PHIST - DEC_T) * PW)), r = (int)(i % ((PHIST - DEC_T) * PW));
            a.out[O_PS + (size_t)b * PHIST * PW + r] = a.state_pool[(size_t)b * PHIST * PW + DEC_T * PW + r];
        }
    }
    SEAM(0);
    if (IN(1)) {
        pg8::SegOrder<3> S{}; S.G = G; S.c = bx; S.pa = (size_t)256 * D * 2; S.pb = (size_t)256 * D * 2;
        S.s[0] = pg8::Seg{XN0, Win_t, M / 256, INW / 256, 0};
        S.s[1] = pg8::Seg{HM, Wckv_t, BATCH * NMEM / 256, 2 * D / 256, 1};
        S.s[2] = pg8::Seg{Wckv_t + (size_t)D * D, HM, D / 256, BATCH, 2};
        pg8::gemm_phase<pg8::EpiP1, pg8::SegOrder<3>, true, true>(L, D, D, D, S, pg8::EpiP1{Qb, Kb, Vb, Ub, MK, MV, MVt, a.out});
    }
    SEAM(1);
    if (IN(2)) {
        for (int unit = bx; unit < BATCH * NKV * (SEQ / 64); unit += G) win_attn_unit(Qb, Kb, Vb, A2, a.attn_sinks, unit, L);
        { LAS float* pl = (LAS float*)L + wave * 256;
          for (int task = gw; task < DEC_B * DEC_T * NH; task += NGW) win_attn_sample(Qb, Kb, Vb, a.cache_win_k, a.cache_win_v, A2, a.attn_sinks, task, pl, lane); }
        pool_diff(Ub, a.state_pool, A2, gt, GT);
    }
    SEAM(2);
    if (IN(3)) {
        pg8::SegOrder<1> S{}; S.G = G; S.c = bx; S.pa = (size_t)256 * D * 2; S.pb = (size_t)256 * D * 2;
        S.s[0] = pg8::Seg{A2, Wo2_t, M / 256, D / 256, 0};
        pg8::gemm_phase<pg8::EpiResidG, pg8::SegOrder<1>, true, true>(L, D, D, D, S, pg8::EpiResidG{a.x_prompt, a.x_sample - (size_t)MP * D, X, XB, rss1});
    }
    SEAM(3);
    if (IN(4)) {
        pg8::SegOrder<1> S{}; S.G = G; S.c = bx; S.pa = (size_t)256 * D * 2; S.pb = (size_t)256 * D * 2;
        S.s[0] = pg8::Seg{XB, Wcq_t, M / 256, D / 256, 0};
        pg8::gemm_phase<pg8::EpiRowScaleG<0>, pg8::SegOrder<1>, true, true>(L, D, D, D, S, pg8::EpiRowScaleG<0>{CQ, D, rss1, (1.0f / 16.0f) * LOG2E});
    }
    SEAM(4);
    if (IN(5)) {
        bf16_t* Pb = (bf16_t*)(ws + WS_P);
        const bool sample_first = ((bx >> 3) & 1) != 0;
        if (sample_first) for (int t0 = 2 * bx; t0 < DEC_B * NCH; t0 += 2 * G) cross_sample_pair(a.cache_mem_k, a.cache_mem_v, CQ, OC, t0, DEC_B * NCH, L);
        for (int Lu = bx; Lu < BATCH * NCH * (SEQ / 256); Lu += G) {
            const int xc = Lu & 7, idx = Lu >> 3, bh = xc * 2 + (idx >> 4), qp = idx & 15, b = bh >> 2, h = bh & 3;
            pg8::OneUnit S1; S1.u.pm = b * (SEQ / 256) + qp; S1.u.pn = h; S1.u.kind = 0;
            S1.u.a = (const char*)(CQ + ((size_t)(b * SEQ + qp * 256)) * D + h * CHD); S1.u.b = (const char*)(MK + (size_t)(b * NMEM) * D + h * CHD);
            pg8::gemm_phase<pg8::EpiSoftmaxP, pg8::OneUnit, false, true>(L, D, D, CHD, S1, pg8::EpiSoftmaxP{Pb});
            asm volatile("s_waitcnt vmcnt(0)" ::: "memory"); __syncthreads();
            pg8::OneUnit S2; S2.u.pm = S1.u.pm; S2.u.pn = h; S2.u.kind = 0;
            S2.u.a = (const char*)(Pb + ((size_t)(b * SEQ + qp * 256)) * D + h * CHD); S2.u.b = (const char*)(MVt + ((size_t)b * D + h * CHD) * NMEM);
            pg8::gemm_phase<pg8::EpiStoreBf16, pg8::OneUnit, true, true>(L, D, NMEM, NMEM, S2, pg8::EpiStoreBf16{OC});
            __syncthreads();
        }
        if (!sample_first) for (int t0 = 2 * bx; t0 < DEC_B * NCH; t0 += 2 * G) cross_sample_pair(a.cache_mem_k, a.cache_mem_v, CQ, OC, t0, DEC_B * NCH, L);
    }
    SEAM(5);
    if (IN(6)) {
        pg8::SegOrder<1> S{}; S.G = G; S.c = bx; S.pa = (size_t)256 * D * 2; S.pb = (size_t)256 * D * 2;
        S.s[0] = pg8::Seg{OC, Wco_t, M / 256, D / 256, 0};
        pg8::gemm_phase<pg8::EpiResidG, pg8::SegOrder<1>, true, true>(L, D, D, D, S, pg8::EpiResidG{X, X, X, XB, rss2});
    }
    SEAM(6);
    if (IN(7)) {
        pg8::SegOrder<1> S{}; S.G = G; S.c = bx; S.pa = (size_t)256 * D * 2; S.pb = (size_t)256 * D * 2;
        S.s[0] = pg8::Seg{XB, Wup_t, M / 256, DFF / 256, 0};
        pg8::gemm_phase<pg8::EpiRowScaleG<1>, pg8::SegOrder<1>, true, true>(L, D, D, D, S, pg8::EpiRowScaleG<1>{Hb, DFF, rss2, 1.0f});
    }
    SEAM(7);
    if (IN(8)) {
        pg8::SegOrder<1> S{}; S.G = G; S.c = bx; S.pa = (size_t)256 * DFF * 2; S.pb = (size_t)256 * DFF * 2;
        S.s[0] = pg8::Seg{Hb, Wdn_t, M / 256, D / 256, 0};
        pg8::gemm_phase<pg8::EpiResidG, pg8::SegOrder<1>, true, true>(L, DFF, DFF, DFF, S, pg8::EpiResidG{X, X, X, nullptr, rss3});
    }
    SEAM(8);
    if (IN(9)) {
        for (int r = gw; r < M; r += NGW) {
            const float rs = rsqrtf(rss3[r] * (1.f / D) + EPS);
            f32x4* xr = (f32x4*)(X + (size_t)r * D) + lane; const f32x4* gp = (const f32x4*)a.g_final + lane;
#pragma unroll
            for (int j = 0; j < 4; ++j) xr[64 * j] = xr[64 * j] * rs * gp[64 * j];
        }
    }
#undef IN
#undef SEAM
}

constexpr int N_PHASES = 10;
extern "C" void kernel_launch(void* const* d_in, const int* in_sizes, int n_in, void* d_out, int out_size, void* d_ws, size_t ws_size, hipStream_t stream) {
    static int grid = 0;
    if (grid == 0) {
        if (n_in != 24 || in_sizes[0] != MP * D || out_size != (int)O_END || ws_size < WS_END) {
            fprintf(stderr, "kernel_launch: unexpected shapes: n_in %d in0 %d out %d ws %zu (need %zu)\n", n_in, n_in > 0 ? in_sizes[0] : -1, out_size, ws_size, (size_t)WS_END); grid = -1; return; }
        int dev = 0, cus = 0, per_cu = 0;
        if (hipGetDevice(&dev) != hipSuccess || hipDeviceGetAttribute(&cus, hipDeviceAttributeMultiprocessorCount, dev) != hipSuccess) { grid = -1; return; }
        if (hipFuncSetAttribute((const void*)fwd, hipFuncAttributeMaxDynamicSharedMemorySize, LDS_BYTES) != hipSuccess) { fprintf(stderr, "kernel_launch: hipFuncSetAttribute failed\n"); grid = -1; return; }
        if (hipOccupancyMaxActiveBlocksPerMultiprocessor(&per_cu, (const void*)fwd, NTHREADS, LDS_BYTES) != hipSuccess || per_cu < 1) { fprintf(stderr, "kernel_launch: occupancy query says %d\n", per_cu); grid = -1; (void)hipGetLastError(); return; }
        grid = cus;
    }
    if (grid < 0) return;
    (void)hipMemsetAsync((char*)d_ws + WS_CTL, 0, CTL_ZERO_BYTES, stream);
    Args a{};
    const float** p = (const float**)&a;
    for (int i = 0; i < 24; ++i) p[i] = (const float*)d_in[i];
    a.out = (float*)d_out; a.ws = (unsigned char*)d_ws;
    if (MK_N_LAUNCHES == 1) { a.ph_lo = 0; a.ph_hi = N_PHASES; hipLaunchKernelGGL(fwd, dim3(grid), dim3(NTHREADS), LDS_BYTES, stream, a); }
    else for (int ph = 0; ph < N_PHASES; ++ph) { a.ph_lo = ph; a.ph_hi = ph + 1; hipLaunchKernelGGL(fwd, dim3(grid), dim3(NTHREADS), LDS_BYTES, stream, a); }
}
```

```cpp
#include <hip/hip_runtime.h>
#include <cstdio>
#include <cstdint>

#ifndef MK_N_LAUNCHES
#define MK_N_LAUNCHES 1
#endif

constexpr int D = 1024, BATCH = 4, SEQ = 4096, DEC_B = 128, DEC_T = 8, PAST = 16384;
constexpr int HD = 64, AW = 512, NH = 8, NKV = 2, KVW = 128, WIN = 128, PW = 512, PHIST = 15, INW = 1280;
constexpr int NMEM = 256, NCH = 4, CHD = 256, DFF = 4096;
constexpr int MP = BATCH * SEQ, MS = DEC_B * DEC_T, M = MP + MS;
constexpr float EPS = 1e-5f;
constexpr float LOG2E = 1.4426950408889634f;

constexpr size_t O_YP = 0, O_YS = O_YP + (size_t)MP * D, O_WKP = O_YS + (size_t)MS * D, O_WVP = O_WKP + (size_t)BATCH * WIN * KVW,
                 O_PP = O_WVP + (size_t)BATCH * WIN * KVW, O_MKP = O_PP + (size_t)BATCH * PHIST * PW, O_MVP = O_MKP + (size_t)BATCH * NMEM * D,
                 O_WKS = O_MVP + (size_t)BATCH * NMEM * D, O_WVS = O_WKS + (size_t)DEC_B * WIN * KVW, O_PS = O_WVS + (size_t)DEC_B * WIN * KVW,
                 O_END = O_PS + (size_t)DEC_B * PHIST * PW;
static_assert(O_END == 25262080, "output size");

constexpr size_t MiB = 1u << 20;
constexpr size_t WS_CTL = 0, CTL_ZERO_BYTES = 1 * MiB;
constexpr size_t WS_WIN = 5 * MiB;
constexpr size_t WS_WCKV = 8 * MiB;
constexpr size_t WS_WO2 = 12 * MiB;
constexpr size_t WS_WCQ = 14 * MiB, WS_WCO = 16 * MiB;
constexpr size_t WS_WUP = 18 * MiB;
constexpr size_t WS_WDN = 26 * MiB;
constexpr size_t WS_HM = 34 * MiB;
constexpr size_t WS_MK = 36 * MiB, WS_MV = 38 * MiB;
constexpr size_t WS_MVT = 40 * MiB;
constexpr size_t WS_XN0 = 42 * MiB;
constexpr size_t WS_Q = 76 * MiB;
constexpr size_t WS_K = 93 * MiB, WS_V = 98 * MiB;
constexpr size_t WS_U = 103 * MiB;
constexpr size_t WS_A2 = 120 * MiB;
constexpr size_t WS_XB = 154 * MiB;
constexpr size_t WS_CQ = 188 * MiB;
constexpr size_t WS_OC = 222 * MiB;
constexpr size_t WS_P = 256 * MiB;
constexpr size_t WS_H = 288 * MiB;
constexpr size_t WS_END = 424 * MiB;
constexpr int CW_BAR = 4096;
constexpr size_t WS_RSS = 1 * MiB;
constexpr size_t RSS_BYTES = (size_t)M * 16 * 4;

constexpr int LDS_BYTES = 147456;
constexpr int NTHREADS = 512, NWAVES = 8;

typedef unsigned short bf16_t;
typedef short bf16x8 __attribute__((ext_vector_type(8)));
typedef float f32x4 __attribute__((ext_vector_type(4)));
typedef unsigned u32x2 __attribute__((ext_vector_type(2)));
typedef unsigned u32x4 __attribute__((ext_vector_type(4)));
#define LAS __attribute__((address_space(3)))

__device__ __forceinline__ unsigned f2bf(float f) { unsigned u = __builtin_bit_cast(unsigned, f); return (u + 0x7fffu + ((u >> 16) & 1u)) >> 16; }
__device__ __forceinline__ unsigned pk2(float lo, float hi) { return f2bf(lo) | (f2bf(hi) << 16); }
__device__ __forceinline__ float bf2f(bf16_t h) { return __builtin_bit_cast(float, (unsigned)h << 16); }
__device__ __forceinline__ float wave_sum(float v) {
#pragma unroll
    for (int o = 1; o < 64; o <<= 1) v += __shfl_xor(v, o);
    return v;
}
__device__ __forceinline__ float wave_max(float v) {
#pragma unroll
    for (int o = 1; o < 64; o <<= 1) v = fmaxf(v, __shfl_xor(v, o));
    return v;
}

__device__ __forceinline__ float rstd_from_slots(const float* rss, int row) {
    const f32x4* p = (const f32x4*)(rss + (size_t)row * 16); const f32x4 a = p[0], b = p[1], c = p[2], d = p[3];
    const float s = ((a[0] + a[1]) + (a[2] + a[3])) + ((b[0] + b[1]) + (b[2] + b[3])) + ((c[0] + c[1]) + (c[2] + c[3])) + ((d[0] + d[1]) + (d[2] + d[3]));
    return rsqrtf(s * (1.0f / D) + EPS);
}
#define XB_TMO      128
#define XB_XCNT(j)  (256  + 64 * (j))
#define XB_XSUB(j)  (1280 + 64 * (j))
#define XB_XGEN(j)  (2304 + 64 * (j))
#define XB_TOP      3328
#define XB_TOPGEN   3392
#define XCD_BAR_WORDS 3456
#define XB_SPIN_CAP (1u << 18)
__device__ __forceinline__ unsigned xb_ld(unsigned* p)              { return __hip_atomic_load(p, __ATOMIC_RELAXED, __HIP_MEMORY_SCOPE_AGENT); }
__device__ __forceinline__ unsigned xb_add(unsigned* p, unsigned v) { return __hip_atomic_fetch_add(p, v, __ATOMIC_RELAXED, __HIP_MEMORY_SCOPE_AGENT); }
__device__ __forceinline__ unsigned xb_xcc_id() { return (unsigned)__builtin_amdgcn_s_getreg((3 << 11) | 20) & 0xFu; }
#define XB_SPIN(cond, bar) do { unsigned _sp = 0; while (cond) { __builtin_amdgcn_s_sleep(1); \
    if ((++_sp & 255u) == 0u) { if (xb_ld(&(bar)[XB_TMO])) break; if (_sp > XB_SPIN_CAP) { atomicAdd(&(bar)[XB_TMO], 1u); break; } } } } while (0)
struct XcdBarrier { unsigned* bar; unsigned x; volatile LAS unsigned* st; };
__device__ __forceinline__ XcdBarrier xcd_barrier_post(unsigned* bar, volatile LAS unsigned* st) {
    XcdBarrier b; b.bar = bar; b.x = xb_xcc_id(); b.st = st;
    if (threadIdx.x == 0) (void)xb_add(&bar[XB_XCNT(b.x)], 1u);
    return b;
}
__device__ __forceinline__ void xcd_barrier_complete(unsigned* bar, unsigned x, unsigned& nloc, unsigned& nx) {
    const unsigned G = gridDim.x * gridDim.y * gridDim.z;
    unsigned sum, cnt, mine, sp = 0u;
    for (;;) {
        sum = 0u; cnt = 0u; mine = 0u;
#pragma unroll
        for (unsigned j = 0; j < 16; ++j) { const unsigned c = xb_ld(&bar[XB_XCNT(j)]); sum += c; cnt += (c > 0u) ? 1u : 0u; mine = (j == x) ? c : mine; }
        if (sum == G) break;
        __builtin_amdgcn_s_sleep(1);
        if ((++sp & 255u) == 0u) { if (xb_ld(&bar[XB_TMO])) break; if (sp > XB_SPIN_CAP) { atomicAdd(&bar[XB_TMO], 1u); break; } }
    }
    nloc = mine > 0u ? mine : 1u; nx = cnt > 0u ? cnt : 1u;
}
__device__ __forceinline__ void xcd_barrier(const XcdBarrier& b) {
    asm volatile("s_waitcnt vmcnt(0)" ::: "memory");
    __syncthreads();
    if (threadIdx.x == 0) {
        unsigned* bar = b.bar;
        __builtin_amdgcn_s_waitcnt(0);
        unsigned nloc = b.st[0], nx = b.st[1];
        if (nloc == 0u) { xcd_barrier_complete(bar, b.x, nloc, nx); b.st[0] = nloc; b.st[1] = nx; }
        const unsigned old = xb_add(&bar[XB_XSUB(b.x)], 1u);
        const unsigned gen = old / nloc;
        if (old + 1u == (gen + 1u) * nloc) {
            __builtin_amdgcn_fence(__ATOMIC_RELEASE, "agent");
            asm volatile("s_waitcnt vmcnt(0)" ::: "memory");
            const unsigned og = xb_add(&bar[XB_TOP], 1u);
            const unsigned tg = og / nx;
            if (og + 1u == (tg + 1u) * nx) xb_add(&bar[XB_TOPGEN], 1u);
            else XB_SPIN(xb_ld(&bar[XB_TOPGEN]) == tg, bar);
            __builtin_amdgcn_fence(__ATOMIC_ACQUIRE, "agent");
            xb_add(&bar[XB_XGEN(b.x)], 1u);
            asm volatile("s_waitcnt vmcnt(0)" ::: "memory");
        } else {
            XB_SPIN(xb_ld(&bar[XB_XGEN(b.x)]) == gen, bar);
            __builtin_amdgcn_fence(__ATOMIC_ACQUIRE, "agent");
            asm volatile("s_waitcnt vmcnt(0)" ::: "memory");
        }
    }
    __syncthreads();
}

struct Args {
    const float *x_prompt, *x_sample, *cache_win_k, *cache_win_v, *state_pool, *cache_mem_k, *cache_mem_v, *mem_prompt;
    const float *g_mix, *w_in, *attn_sinks, *w_pool, *pool_scale, *w_out, *g_cross, *g_mem, *w_cq, *w_ck, *w_cv, *w_co, *g_ffn, *w_up, *w_down, *g_final;
    float* out; unsigned char* ws; int ph_lo, ph_hi;
};

template <class Epi>
__device__ __forceinline__ void gemm_naive(const bf16_t* A, int lda, const bf16_t* Bt, int ldb, int Mr, int N, int K, const Epi& epi) {
    const int wid = threadIdx.x >> 6, lane = threadIdx.x & 63, wr = wid >> 2, wc = wid & 3, fr = lane & 15, fq = lane >> 4;
    const int tn_n = N / 256, ntiles = (Mr / 128) * tn_n;
    for (int t = blockIdx.x; t < ntiles; t += gridDim.x) {
        const int tm = t / tn_n, tn = t % tn_n;
        const int r0 = tm * 128 + wr * 64, c0 = tn * 256 + wc * 64;
        f32x4 acc[4][4];
#pragma unroll
        for (int i = 0; i < 4; ++i)
#pragma unroll
            for (int j = 0; j < 4; ++j) acc[i][j] = (f32x4){0.f, 0.f, 0.f, 0.f};
        const bf16_t* ap = A + (size_t)(r0 + fr) * lda + fq * 8;
        const bf16_t* bp = Bt + (size_t)(c0 + fr) * ldb + fq * 8;
        for (int k0 = 0; k0 < K; k0 += 32) {
            bf16x8 a[4], b[4];
#pragma unroll
            for (int i = 0; i < 4; ++i) a[i] = *(const bf16x8*)(ap + (size_t)(i * 16) * lda + k0);
#pragma unroll
            for (int j = 0; j < 4; ++j) b[j] = *(const bf16x8*)(bp + (size_t)(j * 16) * ldb + k0);
#pragma unroll
            for (int i = 0; i < 4; ++i)
#pragma unroll
                for (int j = 0; j < 4; ++j) acc[i][j] = __builtin_amdgcn_mfma_f32_16x16x32_bf16(b[j], a[i], acc[i][j], 0, 0, 0);
        }
        epi(acc, r0 + fr, c0 + 4 * fq, fq);
    }
}

struct EpiProj {
    bf16_t *Q, *Kb, *Vb, *U; float* out;
    __device__ __forceinline__ void operator()(const f32x4 (&acc)[4][4], int row0, int col0, int) const {
#pragma unroll
        for (int i = 0; i < 4; ++i) {
            const int row = row0 + 16 * i;
            const bool samp = row >= MP;
            int b, t; if (!samp) { b = row / SEQ; t = row % SEQ; } else { b = (row - MP) / DEC_T; t = (row - MP) % DEC_T; }
#pragma unroll
            for (int j = 0; j < 4; ++j) {
                const int col = col0 + 16 * j; const f32x4 v = acc[i][j];
                if (col < AW) {
                    const float s = 0.125f * LOG2E;
                    *(u32x2*)(Q + (size_t)row * AW + col) = (u32x2){pk2(v[0] * s, v[1] * s), pk2(v[2] * s, v[3] * s)};
                } else if (col < AW + 2 * KVW) {
                    const bool isv = col >= AW + KVW; const int c = col - AW - (isv ? KVW : 0);
                    *(u32x2*)((isv ? Vb : Kb) + (size_t)row * KVW + c) = (u32x2){pk2(v[0], v[1]), pk2(v[2], v[3])};
                    if (!samp) { if (t >= SEQ - WIN) *(f32x4*)(out + (isv ? O_WVP : O_WKP) + ((size_t)b * WIN + (t - (SEQ - WIN))) * KVW + c) = v; }
                    else *(f32x4*)(out + (isv ? O_WVS : O_WKS) + ((size_t)b * WIN + (WIN - DEC_T + t)) * KVW + c) = v;
                } else {
                    const int c = col - AW - 2 * KVW;
                    *(u32x2*)(U + (size_t)row * PW + c) = (u32x2){pk2(v[0], v[1]), pk2(v[2], v[3])};
                    if (!samp) { if (t >= SEQ - PHIST) *(f32x4*)(out + O_PP + ((size_t)b * PHIST + (t - (SEQ - PHIST))) * PW + c) = v; }
                    else *(f32x4*)(out + O_PS + ((size_t)b * PHIST + (PHIST - DEC_T + t)) * PW + c) = v;
                }
            }
        }
    }
};
struct EpiMemKV {
    bf16_t *MK, *MV; float* out;
    __device__ __forceinline__ void operator()(const f32x4 (&acc)[4][4], int row0, int col0, int) const {
#pragma unroll
        for (int i = 0; i < 4; ++i)
#pragma unroll
            for (int j = 0; j < 4; ++j) {
                const int row = row0 + 16 * i, col = col0 + 16 * j; const f32x4 v = acc[i][j];
                const bool isv = col >= D; const int c = col - (isv ? D : 0);
                *(f32x4*)(out + (isv ? O_MVP : O_MKP) + (size_t)row * D + c) = v;
                *(u32x2*)((isv ? MV : MK) + (size_t)row * D + c) = (u32x2){pk2(v[0], v[1]), pk2(v[2], v[3])};
            }
    }
};
struct EpiResid {
    const float* base; float* X; bf16_t* XB; float* rss;
    __device__ __forceinline__ void operator()(const f32x4 (&acc)[4][4], int row0, int col0, int fq) const {
#pragma unroll
        for (int i = 0; i < 4; ++i) {
            const int row = row0 + 16 * i; float s = 0.f;
#pragma unroll
            for (int j = 0; j < 4; ++j) {
                const int col = col0 + 16 * j;
                const f32x4 v = *(const f32x4*)(base + (size_t)row * D + col) + acc[i][j];
                *(f32x4*)(X + (size_t)row * D + col) = v;
                if (XB) *(u32x2*)(XB + (size_t)row * D + col) = (u32x2){pk2(v[0], v[1]), pk2(v[2], v[3])};
                s += (v[0] * v[0] + v[1] * v[1]) + (v[2] * v[2] + v[3] * v[3]);
            }
            s += __shfl_xor(s, 16); s += __shfl_xor(s, 32);
            if (fq == 0) atomicAdd(rss + row, s);
        }
    }
};
template <int ACT>
struct EpiRowScale {
    bf16_t* O; int ldo; const float* rss; float scale;
    __device__ __forceinline__ void operator()(const f32x4 (&acc)[4][4], int row0, int col0, int) const {
#pragma unroll
        for (int i = 0; i < 4; ++i) {
            const int row = row0 + 16 * i; const float rs = rsqrtf(rss[row] * (1.0f / D) + EPS);
#pragma unroll
            for (int j = 0; j < 4; ++j) {
                const int col = col0 + 16 * j; f32x4 v = acc[i][j] * rs;
                if (ACT == 1) {
#pragma unroll
                    for (int e = 0; e < 4; ++e) { const float r = fmaxf(v[e], 0.f); v[e] = r * r; }
                }
                v = v * scale;
                *(u32x2*)(O + (size_t)row * ldo + col) = (u32x2){pk2(v[0], v[1]), pk2(v[2], v[3])};
            }
        }
    }
};


namespace pg8 {
constexpr int BM = 256, BK = 64, HALF = 128, HTB = HALF * BK * 2, STAGE_BYTES = 8 * HTB, NXCD = 8, WGM = 8;
__host__ __device__ __forceinline__ int lds_byte(int r, int c) { const int st = (r >> 4) * 2 + (c >> 5), rr = r & 15, cc = c & 31, ob = rr * 64 + cc * 2; return st * 1024 + (ob ^ (((ob >> 9) & 1) << 5)); }
__host__ __device__ __forceinline__ void stage_rc(int b, int& R, int& C) { const int st = b / 1024, sb = b % 1024, swz = sb ^ (((sb >> 9) & 1) << 5); R = (st >> 1) * 16 + swz / 64; C = (st & 1) * 32 + (swz % 64) / 2; }
__host__ __device__ __forceinline__ int perm32(int rho) { const int n = rho >> 4, i = rho & 15; return 8 * (i >> 2) + 4 * n + (i & 3); }

struct Unit { const char* a; const char* b; int pm, pn, kind; };
struct Seg { const bf16_t* A; const bf16_t* B; int nM, nN, kind; };
template <int NSEG> struct SegOrder {
    Seg s[NSEG]; int G, c; size_t pa, pb;
    __device__ __forceinline__ bool next(int i, Unit& u) const {
        long L = (long)i * G + c;
#pragma unroll
        for (int k = 0; k < NSEG; ++k) {
            const int nM = s[k].nM, nN = s[k].nN, nwg = nM * nN;
            if (L < nwg) {
                int wgid = (int)L; { const int q = nwg / NXCD, r = nwg % NXCD, xcd = wgid % NXCD, off = wgid / NXCD; wgid = (xcd < r ? xcd * (q + 1) : r * (q + 1) + (xcd - r) * q) + off; }
                const int nig = WGM * nN, gid = wgid / nig, fm = gid * WGM, gsz = (nM - fm) < WGM ? (nM - fm) : WGM;
                u.pm = fm + ((wgid % nig) % gsz); u.pn = (wgid % nig) / gsz; u.kind = s[k].kind;
                u.a = (const char*)s[k].A + (size_t)u.pm * pa; u.b = (const char*)s[k].B + (size_t)u.pn * pb; return true;
            }
            L -= nwg;
        }
        return false;
    }
};
__device__ __forceinline__ unsigned cvt_pk_bf16(float lo, float hi) { unsigned r; asm volatile("v_cvt_pk_bf16_f32 %0, %1, %2" : "=v"(r) : "v"(lo), "v"(hi)); return r; }
__device__ __forceinline__ u32x4 pack8(const f32x4 v0, const f32x4 v1) { u32x4 w; w.x = cvt_pk_bf16(v0[0], v0[1]); w.y = cvt_pk_bf16(v0[2], v0[3]); w.z = cvt_pk_bf16(v1[0], v1[1]); w.w = cvt_pk_bf16(v1[2], v1[3]); return w; }

template <class Epi, class Sched, bool ALIGN_EPI, bool SP2>
__device__ __forceinline__ void gemm_phase(LAS unsigned char* lds, const int lda, const int ldb, const int K, const Sched& S, const Epi& E) {
    int tid_ = threadIdx.x; asm volatile("" : "+v"(tid_));
    const int tid = tid_, wid = __builtin_amdgcn_readfirstlane(tid >> 6), lane = tid & 63, wr = wid >> 2, wc = wid & 3, fr = lane & 15, fq = lane >> 4;
    const int nt = K / BK;
    unsigned voffA[2], voffB[2];
#pragma unroll
    for (int i = 0; i < 2; ++i) { int R, C; stage_rc(tid * 16 + i * 8192, R, C); const int Rb = Epi::PERM ? ((R & ~31) + perm32(R & 31)) : R;
        voffA[i] = (unsigned)(R * lda + C) * 2u; voffB[i] = (unsigned)(Rb * ldb + C) * 2u; }
    const size_t kstep = (size_t)(BK * 2);
    const size_t hstepA = (size_t)HALF * lda * 2, hstepB = (size_t)HALF * ldb * 2;
    const unsigned ldsw = (unsigned)wid * 1024u;
    const int aoff = lds_byte(wr * 64 + fr, fq * 8), boff = lds_byte(wc * 32 + fr, fq * 8);
#define PG8_SA(b, h) (((b) * 2 + (h)) * HTB)
#define PG8_SB(b, h) ((4 + (b) * 2 + (h)) * HTB)
#define PG8_STAGE(bufoff, gbase, voff) do { _Pragma("unroll") for (int _i = 0; _i < 2; ++_i) \
        __builtin_amdgcn_global_load_lds((const unsigned*)((const char*)(gbase) + (voff)[_i]), (LAS unsigned*)(lds + (bufoff) + ldsw + _i * 8192), 16, 0, 0); } while (0)
#define PG8_LDA(dst, b, h) do { _Pragma("unroll") for (int m = 0; m < 4; ++m) _Pragma("unroll") for (int k = 0; k < 2; ++k) dst[m][k] = *(const LAS bf16x8*)(lds + PG8_SA(b, h) + aoff + m * 2048 + k * 1024); } while (0)
#define PG8_LDB(dst, b, h) do { _Pragma("unroll") for (int n = 0; n < 2; ++n) _Pragma("unroll") for (int k = 0; k < 2; ++k) dst[n][k] = *(const LAS bf16x8*)(lds + PG8_SB(b, h) + boff + n * 2048 + k * 1024); } while (0)
#define PG8_MMA(ai, bj, At, Bt) do { __builtin_amdgcn_s_setprio(1); _Pragma("unroll") for (int m = 0; m < 4; ++m) _Pragma("unroll") for (int n = 0; n < 2; ++n) _Pragma("unroll") for (int k = 0; k < 2; ++k) \
        acc[ai][bj][m][n] = __builtin_amdgcn_mfma_f32_16x16x32_bf16(Bt[n][k], At[m][k], acc[ai][bj][m][n], 0, 0, 0); __builtin_amdgcn_s_setprio(0); } while (0)
#define PG8_WAIT_V(n) asm volatile("s_waitcnt vmcnt(" #n ")" ::: "memory")
#define PG8_WAIT_L(n) asm volatile("s_waitcnt lgkmcnt(" #n ")" ::: "memory")
#define PG8_BAR __builtin_amdgcn_s_barrier()
#define PG8_SCHED __builtin_amdgcn_sched_barrier(0)
    Unit cur, nxt; int ui = 0;
    if (!S.next(0, cur)) return;
    f32x4 acc[2][2][4][2];
#pragma unroll
    for (int a = 0; a < 2; ++a)
#pragma unroll
        for (int b = 0; b < 2; ++b)
#pragma unroll
            for (int m = 0; m < 4; ++m)
#pragma unroll
                for (int n = 0; n < 2; ++n) acc[a][b][m][n] = (f32x4){0.f, 0.f, 0.f, 0.f};
    bf16x8 At[4][2], B0[2][2], B1[2][2];
    const char* cA = cur.a; const char* cB = cur.b;
    if constexpr (SP2) {
        PG8_STAGE(PG8_SB(0, 0), cB, voffB); PG8_STAGE(PG8_SB(0, 1), cB + hstepB, voffB); PG8_STAGE(PG8_SA(0, 0), cA, voffA); PG8_STAGE(PG8_SA(0, 1), cA + hstepA, voffA);
        if (wr == 1) PG8_BAR;
        PG8_WAIT_V(2); PG8_BAR;
        PG8_STAGE(PG8_SB(1, 0), cB + kstep, voffB); PG8_STAGE(PG8_SA(1, 0), cA + kstep, voffA); PG8_STAGE(PG8_SB(1, 1), cB + hstepB + kstep, voffB);
        PG8_WAIT_V(6); PG8_BAR;
    } else {
        PG8_STAGE(PG8_SB(0, 0), cB, voffB); PG8_STAGE(PG8_SA(0, 0), cA, voffA); PG8_STAGE(PG8_SB(0, 1), cB + hstepB, voffB); PG8_STAGE(PG8_SA(0, 1), cA + hstepA, voffA);
        if (wr == 1) PG8_BAR;
        PG8_WAIT_V(4); PG8_BAR;
        PG8_STAGE(PG8_SB(1, 0), cB + kstep, voffB); PG8_STAGE(PG8_SA(1, 0), cA + kstep, voffA); PG8_STAGE(PG8_SB(1, 1), cB + hstepB + kstep, voffB);
        PG8_WAIT_V(6); PG8_BAR;
    }
    for (;;) {
        const bool has_next = S.next(ui + 1, nxt);
        const char* nA = has_next ? nxt.a : cA; const char* nB = has_next ? nxt.b : cB;
        for (int t = 0; t < nt; t += 2) {
            const bool last = (t == nt - 2);
            const char* a1 = cA + (size_t)(t + 1) * kstep;
            const char* a2 = last ? nA : cA + (size_t)(t + 2) * kstep; const char* b2 = last ? nB : cB + (size_t)(t + 2) * kstep;
            const char* a3 = a2 + kstep; const char* b3 = b2 + kstep;
            if constexpr (SP2) {
            PG8_LDB(B0, 0, 0); PG8_LDB(B1, 0, 1); PG8_SCHED; PG8_LDA(At, 0, 0); PG8_STAGE(PG8_SA(1, 1), a1 + hstepA, voffA);
            PG8_WAIT_V(8); PG8_WAIT_L(0); PG8_BAR; PG8_MMA(0, 0, At, B0); PG8_MMA(0, 1, At, B1); PG8_BAR; PG8_SCHED;
            PG8_LDA(At, 0, 1); PG8_STAGE(PG8_SB(0, 0), b2, voffB); PG8_STAGE(PG8_SB(0, 1), b2 + hstepB, voffB); PG8_STAGE(PG8_SA(0, 0), a2, voffA);
            PG8_WAIT_V(8); PG8_WAIT_L(0); PG8_BAR; PG8_MMA(1, 0, At, B0); PG8_MMA(1, 1, At, B1); PG8_BAR; PG8_SCHED;
            PG8_LDB(B0, 1, 0); PG8_LDB(B1, 1, 1); PG8_SCHED; PG8_LDA(At, 1, 0); PG8_STAGE(PG8_SA(0, 1), a2 + hstepA, voffA);
            PG8_WAIT_V(8); PG8_WAIT_L(0); PG8_BAR; PG8_MMA(0, 0, At, B0); PG8_MMA(0, 1, At, B1); PG8_BAR; PG8_SCHED;
            PG8_LDA(At, 1, 1); PG8_STAGE(PG8_SB(1, 0), b3, voffB); PG8_STAGE(PG8_SB(1, 1), b3 + hstepB, voffB); PG8_STAGE(PG8_SA(1, 0), a3, voffA);
            PG8_WAIT_V(8); PG8_WAIT_L(0); PG8_BAR; PG8_MMA(1, 0, At, B0); PG8_MMA(1, 1, At, B1); PG8_BAR; PG8_SCHED;
            } else {
            PG8_LDB(B0, 0, 0); PG8_SCHED; PG8_LDA(At, 0, 0); PG8_STAGE(PG8_SA(1, 1), a1 + hstepA, voffA);
            PG8_WAIT_L(8); PG8_BAR; PG8_WAIT_L(0); PG8_MMA(0, 0, At, B0); PG8_BAR; PG8_SCHED;
            PG8_LDB(B1, 0, 1); PG8_STAGE(PG8_SB(0, 0), b2, voffB);
            PG8_BAR; PG8_WAIT_L(0); PG8_MMA(0, 1, At, B1); PG8_BAR;
            PG8_LDA(At, 0, 1); PG8_STAGE(PG8_SA(0, 0), a2, voffA);
            PG8_BAR; PG8_WAIT_L(0); PG8_MMA(1, 0, At, B0); PG8_BAR; PG8_SCHED;
            PG8_STAGE(PG8_SB(0, 1), b2 + hstepB, voffB);
            PG8_WAIT_V(6); PG8_BAR; PG8_MMA(1, 1, At, B1); PG8_BAR;
            PG8_LDB(B0, 1, 0); PG8_SCHED; PG8_LDA(At, 1, 0); PG8_STAGE(PG8_SA(0, 1), a2 + hstepA, voffA);
            PG8_WAIT_L(8); PG8_BAR; PG8_WAIT_L(0); PG8_MMA(0, 0, At, B0); PG8_BAR; PG8_SCHED;
            PG8_LDB(B1, 1, 1); PG8_STAGE(PG8_SB(1, 0), b3, voffB);
            PG8_BAR; PG8_WAIT_L(0); PG8_MMA(0, 1, At, B1); PG8_BAR;
            PG8_LDA(At, 1, 1); PG8_STAGE(PG8_SA(1, 0), a3, voffA);
            PG8_BAR; PG8_WAIT_L(0); PG8_MMA(1, 0, At, B0); PG8_BAR; PG8_SCHED;
            PG8_STAGE(PG8_SB(1, 1), b3 + hstepB, voffB);
            PG8_WAIT_V(6); PG8_BAR; PG8_MMA(1, 1, At, B1); PG8_BAR;
            }
        }
        if constexpr (ALIGN_EPI) { if (wr == 0) PG8_BAR; }
        if constexpr (!Epi::AFTER_DRAIN) { E(acc, cur, wr, wc, fr, fq); }
        if (!has_next) break;
#pragma unroll
        for (int a = 0; a < 2; ++a)
#pragma unroll
            for (int b = 0; b < 2; ++b)
#pragma unroll
                for (int m = 0; m < 4; ++m)
#pragma unroll
                    for (int n = 0; n < 2; ++n) acc[a][b][m][n] = (f32x4){0.f, 0.f, 0.f, 0.f};
        cur = nxt; cA = nA; cB = nB; ++ui;
        if constexpr (ALIGN_EPI) { if (wr == 1) PG8_BAR; }
    }
    PG8_WAIT_V(0);
    if constexpr (!ALIGN_EPI) { if (wr == 0) PG8_BAR; }
    PG8_BAR;
    if constexpr (Epi::AFTER_DRAIN) { E.fused(acc, cur, wr, wc, fr, fq, lds, wid, lane); }
#undef PG8_SA
#undef PG8_SB
#undef PG8_STAGE
#undef PG8_LDA
#undef PG8_LDB
#undef PG8_MMA
#undef PG8_WAIT_V
#undef PG8_WAIT_L
#undef PG8_BAR
#undef PG8_SCHED
}

struct EpiP1 {
    static constexpr bool PERM = true, AFTER_DRAIN = false;
    bf16_t *Q, *Kb, *Vb, *U, *MK, *MV, *MVt; float* out;
    __device__ __forceinline__ void operator()(const f32x4 (&acc)[2][2][4][2], const Unit& u, int wr, int wc, int fr, int fq) const {
        const int cl = wc * 32 + 8 * fq;
        if (u.kind == 0) {
            const bool samp = u.pm >= MP / 256;
#pragma unroll
            for (int ai = 0; ai < 2; ++ai)
#pragma unroll
                for (int m = 0; m < 4; ++m) {
                    const int row = u.pm * 256 + ai * 128 + wr * 64 + m * 16 + fr;
                    int b, t; if (!samp) { b = row / SEQ; t = row % SEQ; } else { b = (row - MP) / DEC_T; t = (row - MP) % DEC_T; }
#pragma unroll
                    for (int bj = 0; bj < 2; ++bj) {
                        const f32x4 v0 = acc[ai][bj][m][0], v1 = acc[ai][bj][m][1];
                        if (u.pn < 2) { const float s = 0.125f * LOG2E; *(u32x4*)(Q + (size_t)row * AW + u.pn * 256 + bj * 128 + cl) = pack8(v0 * s, v1 * s); }
                        else if (u.pn == 2) {
                            *(u32x4*)((bj ? Vb : Kb) + (size_t)row * KVW + cl) = pack8(v0, v1);
                            float* o = nullptr;
                            if (!samp) { if (t >= SEQ - WIN) o = out + (bj ? O_WVP : O_WKP) + ((size_t)b * WIN + (t - (SEQ - WIN))) * KVW + cl; }
                            else o = out + (bj ? O_WVS : O_WKS) + ((size_t)b * WIN + (WIN - DEC_T + t)) * KVW + cl;
                            if (o) { *(f32x4*)o = v0; *(f32x4*)(o + 4) = v1; }
                        } else {
                            const int c = (u.pn - 3) * 256 + bj * 128 + cl;
                            *(u32x4*)(U + (size_t)row * PW + c) = pack8(v0, v1);
                            float* o = nullptr;
                            if (!samp) { if (t >= SEQ - PHIST) o = out + O_PP + ((size_t)b * PHIST + (t - (SEQ - PHIST))) * PW + c; }
                            else o = out + O_PS + ((size_t)b * PHIST + (PHIST - DEC_T + t)) * PW + c;
                            if (o) { *(f32x4*)o = v0; *(f32x4*)(o + 4) = v1; }
                        }
                    }
                }
        } else if (u.kind == 1) {
            const bool isv = u.pn >= 4;
#pragma unroll
            for (int ai = 0; ai < 2; ++ai)
#pragma unroll
                for (int m = 0; m < 4; ++m) {
                    const int row = u.pm * 256 + ai * 128 + wr * 64 + m * 16 + fr;
#pragma unroll
                    for (int bj = 0; bj < 2; ++bj) {
                        const f32x4 v0 = acc[ai][bj][m][0], v1 = acc[ai][bj][m][1];
                        const int c = (u.pn & 3) * 256 + bj * 128 + cl;
                        float* o = out + (isv ? O_MVP : O_MKP) + (size_t)row * D + c; *(f32x4*)o = v0; *(f32x4*)(o + 4) = v1;
                        *(u32x4*)((isv ? MV : MK) + (size_t)row * D + c) = pack8(v0, v1);
                    }
                }
        } else {
#pragma unroll
            for (int ai = 0; ai < 2; ++ai)
#pragma unroll
                for (int m = 0; m < 4; ++m) {
                    const int dd = u.pm * 256 + ai * 128 + wr * 64 + m * 16 + fr;
#pragma unroll
                    for (int bj = 0; bj < 2; ++bj) *(u32x4*)(MVt + ((size_t)u.pn * D + dd) * NMEM + bj * 128 + cl) = pack8(acc[ai][bj][m][0], acc[ai][bj][m][1]);
                }
        }
    }
};
struct EpiResidG {
    static constexpr bool PERM = true, AFTER_DRAIN = false;
    const float* baseP; const float* baseS; float* X; bf16_t* XB; float* rss;
    __device__ __forceinline__ void operator()(const f32x4 (&acc)[2][2][4][2], const Unit& u, int wr, int wc, int fr, int fq) const {
        const float* base = u.pm >= MP / 256 ? baseS : baseP;
        const int col0 = u.pn * 256 + wc * 32 + 8 * fq;
#pragma unroll
        for (int ai = 0; ai < 2; ++ai)
#pragma unroll
            for (int m = 0; m < 4; ++m) {
                const int row = u.pm * 256 + ai * 128 + wr * 64 + m * 16 + fr; float s = 0.f;
#pragma unroll
                for (int bj = 0; bj < 2; ++bj) {
                    const size_t off = (size_t)row * D + col0 + bj * 128;
                    const f32x4 v0 = *(const f32x4*)(base + off) + acc[ai][bj][m][0], v1 = *(const f32x4*)(base + off + 4) + acc[ai][bj][m][1];
                    *(f32x4*)(X + off) = v0; *(f32x4*)(X + off + 4) = v1;
                    if (XB) *(u32x4*)(XB + off) = pack8(v0, v1);
                    s += ((v0[0] * v0[0] + v0[1] * v0[1]) + (v0[2] * v0[2] + v0[3] * v0[3])) + ((v1[0] * v1[0] + v1[1] * v1[1]) + (v1[2] * v1[2] + v1[3] * v1[3]));
                }
                s += __shfl_xor(s, 16); s += __shfl_xor(s, 32);
                if (fq == 0) rss[(size_t)row * 16 + u.pn * 4 + wc] = s;
            }
    }
};
template <int ACT>
struct EpiRowScaleG {
    static constexpr bool PERM = true, AFTER_DRAIN = false;
    bf16_t* O; int ldo; const float* rss; float scale;
    __device__ __forceinline__ void operator()(const f32x4 (&acc)[2][2][4][2], const Unit& u, int wr, int wc, int fr, int fq) const {
        const int col0 = u.pn * 256 + wc * 32 + 8 * fq;
#pragma unroll
        for (int ai = 0; ai < 2; ++ai)
#pragma unroll
            for (int m = 0; m < 4; ++m) {
                const int row = u.pm * 256 + ai * 128 + wr * 64 + m * 16 + fr;
                const float rs = rstd_from_slots(rss, row);
#pragma unroll
                for (int bj = 0; bj < 2; ++bj) {
                    f32x4 v0 = acc[ai][bj][m][0] * rs, v1 = acc[ai][bj][m][1] * rs;
                    if (ACT == 1) {
#pragma unroll
                        for (int e = 0; e < 4; ++e) { const float r0 = fmaxf(v0[e], 0.f), r1 = fmaxf(v1[e], 0.f); v0[e] = r0 * r0; v1[e] = r1 * r1; }
                    }
                    *(u32x4*)(O + (size_t)row * ldo + col0 + bj * 128) = pack8(v0 * scale, v1 * scale);
                }
            }
    }
};

struct OneUnit { Unit u; __device__ __forceinline__ bool next(int i, Unit& o) const { if (i != 0) return false; o = u; return true; } };
struct EpiSoftmaxP {
    static constexpr bool PERM = true, AFTER_DRAIN = true;
    bf16_t* P;
    __device__ __forceinline__ void fused(f32x4 (&acc)[2][2][4][2], const Unit& u, int wr, int wc, int fr, int fq, LAS unsigned char* lds, int wid, int lane) const {
        LAS float* Pm = (LAS float*)lds; LAS float* Ps = Pm + 1024;
#pragma unroll
        for (int ai = 0; ai < 2; ++ai)
#pragma unroll
            for (int m = 0; m < 4; ++m) {
                float mx = -3.0e38f;
#pragma unroll
                for (int bj = 0; bj < 2; ++bj)
#pragma unroll
                    for (int n = 0; n < 2; ++n) { const f32x4 x = acc[ai][bj][m][n]; mx = fmaxf(mx, fmaxf(fmaxf(x[0], x[1]), fmaxf(x[2], x[3]))); }
                mx = fmaxf(mx, __shfl_xor(mx, 16)); mx = fmaxf(mx, __shfl_xor(mx, 32));
                if (fq == 0) Pm[(ai * 128 + wr * 64 + m * 16 + fr) * 4 + wc] = mx;
            }
        asm volatile("s_waitcnt lgkmcnt(0)" ::: "memory"); __builtin_amdgcn_s_barrier(); asm volatile("" ::: "memory");
#pragma unroll
        for (int ai = 0; ai < 2; ++ai)
#pragma unroll
            for (int m = 0; m < 4; ++m) {
                const int rl = ai * 128 + wr * 64 + m * 16 + fr;
                const f32x4 pm4 = *(const LAS f32x4*)(Pm + rl * 4); const float mr = fmaxf(fmaxf(pm4[0], pm4[1]), fmaxf(pm4[2], pm4[3]));
                float s = 0.f;
#pragma unroll
                for (int bj = 0; bj < 2; ++bj)
#pragma unroll
                    for (int n = 0; n < 2; ++n) { f32x4 x = acc[ai][bj][m][n];
#pragma unroll
                        for (int e = 0; e < 4; ++e) { x[e] = __builtin_amdgcn_exp2f(x[e] - mr); s += x[e]; }
                        acc[ai][bj][m][n] = x; }
                s += __shfl_xor(s, 16); s += __shfl_xor(s, 32);
                if (fq == 0) Ps[rl * 4 + wc] = s;
            }
        asm volatile("s_waitcnt lgkmcnt(0)" ::: "memory"); __builtin_amdgcn_s_barrier(); asm volatile("" ::: "memory");
#pragma unroll
        for (int ai = 0; ai < 2; ++ai)
#pragma unroll
            for (int m = 0; m < 4; ++m) {
                const int rl = ai * 128 + wr * 64 + m * 16 + fr;
                const f32x4 ps4 = *(const LAS f32x4*)(Ps + rl * 4); const float inv = 1.0f / ((ps4[0] + ps4[1]) + (ps4[2] + ps4[3]));
#pragma unroll
                for (int bj = 0; bj < 2; ++bj)
                    *(u32x4*)(P + (size_t)(u.pm * 256 + rl) * D + u.pn * 256 + bj * 128 + wc * 32 + 8 * fq) = pack8(acc[ai][bj][m][0] * inv, acc[ai][bj][m][1] * inv);
            }
    }
};
struct EpiStoreBf16 {
    static constexpr bool PERM = true, AFTER_DRAIN = false;
    bf16_t* O;
    __device__ __forceinline__ void operator()(const f32x4 (&acc)[2][2][4][2], const Unit& u, int wr, int wc, int fr, int fq) const {
#pragma unroll
        for (int ai = 0; ai < 2; ++ai)
#pragma unroll
            for (int m = 0; m < 4; ++m) {
                const int row = u.pm * 256 + ai * 128 + wr * 64 + m * 16 + fr;
#pragma unroll
                for (int bj = 0; bj < 2; ++bj) *(u32x4*)(O + (size_t)row * D + u.pn * 256 + bj * 128 + wc * 32 + 8 * fq) = pack8(acc[ai][bj][m][0], acc[ai][bj][m][1]);
            }
    }
};
}


template <class Epi>
__device__ __forceinline__ void gemm_mini(const bf16_t* __restrict__ A, int lda, const bf16_t* __restrict__ Bt, int ldb, int Mr, int N, int K, LAS unsigned char* lds, const Epi& epi) {
    int tid_ = threadIdx.x; asm volatile("" : "+v"(tid_));
    const int tid = tid_, lane = tid & 63, wid = __builtin_amdgcn_readfirstlane(tid >> 6), fr = lane & 15, fq = lane >> 4;
    const int tn_n = N / 64, ntiles = (Mr / 64) * tn_n, ks = K / 8;
    LAS float* red = (LAS float*)lds;
    for (int t = blockIdx.x; t < ntiles; t += gridDim.x) {
        const int tm = t / tn_n, tn = t % tn_n, r0 = tm * 64, c0 = tn * 64;
        f32x4 acc[4][4];
#pragma unroll
        for (int i = 0; i < 4; ++i)
#pragma unroll
            for (int j = 0; j < 4; ++j) acc[i][j] = (f32x4){0.f, 0.f, 0.f, 0.f};
        const bf16_t* ap = A + (size_t)(r0 + fr) * lda + wid * ks + fq * 8;
        const bf16_t* bp = Bt + (size_t)(c0 + fr) * ldb + wid * ks + fq * 8;
#pragma unroll 4
        for (int k0 = 0; k0 < ks; k0 += 32) {
            bf16x8 a[4], b[4];
#pragma unroll
            for (int i = 0; i < 4; ++i) a[i] = *(const bf16x8*)(ap + (size_t)(i * 16) * lda + k0);
#pragma unroll
            for (int j = 0; j < 4; ++j) b[j] = *(const bf16x8*)(bp + (size_t)(j * 16) * ldb + k0);
#pragma unroll
            for (int i = 0; i < 4; ++i)
#pragma unroll
                for (int j = 0; j < 4; ++j) acc[i][j] = __builtin_amdgcn_mfma_f32_16x16x32_bf16(b[j], a[i], acc[i][j], 0, 0, 0);
        }
#pragma unroll
        for (int i = 0; i < 4; ++i)
#pragma unroll
            for (int j = 0; j < 4; ++j) *(LAS f32x4*)(red + (wid * 64 + 16 * i + fr) * 68 + 16 * j + 4 * fq) = acc[i][j];
        __syncthreads();
        const int row = tid >> 3, c8 = (tid & 7) * 8;
        f32x4 v0 = (f32x4){0.f, 0.f, 0.f, 0.f}, v1 = v0;
#pragma unroll
        for (int w = 0; w < 8; ++w) { v0 += *(const LAS f32x4*)(red + (w * 64 + row) * 68 + c8); v1 += *(const LAS f32x4*)(red + (w * 64 + row) * 68 + c8 + 4); }
        epi(r0 + row, c0 + c8, v0, v1, tn);
        __syncthreads();
    }
}
struct MiniResid {
    const float* base; float* X; bf16_t* XB; float* rss;
    __device__ __forceinline__ void operator()(int row, int col, f32x4 v0, f32x4 v1, int tn) const {
        const size_t off = (size_t)row * D + col;
        v0 += *(const f32x4*)(base + off); v1 += *(const f32x4*)(base + off + 4);
        *(f32x4*)(X + off) = v0; *(f32x4*)(X + off + 4) = v1;
        if (XB) *(u32x4*)(XB + off) = pg8::pack8(v0, v1);
        float s = ((v0[0] * v0[0] + v0[1] * v0[1]) + (v0[2] * v0[2] + v0[3] * v0[3])) + ((v1[0] * v1[0] + v1[1] * v1[1]) + (v1[2] * v1[2] + v1[3] * v1[3]));
        s += __shfl_xor(s, 1); s += __shfl_xor(s, 2); s += __shfl_xor(s, 4);
        if ((threadIdx.x & 7) == 0) rss[(size_t)row * 16 + tn] = s;
    }
};
template <int ACT> struct MiniRowScale {
    bf16_t* O; int ldo; const float* rss; float scale;
    __device__ __forceinline__ void operator()(int row, int col, f32x4 v0, f32x4 v1, int) const {
        const float rs = rstd_from_slots(rss, row); v0 = v0 * rs; v1 = v1 * rs;
        if (ACT == 1) {
#pragma unroll
            for (int e = 0; e < 4; ++e) { const float r0 = fmaxf(v0[e], 0.f), r1 = fmaxf(v1[e], 0.f); v0[e] = r0 * r0; v1[e] = r1 * r1; }
        }
        *(u32x4*)(O + (size_t)row * ldo + col) = pg8::pack8(v0 * scale, v1 * scale);
    }
};

__device__ __forceinline__ void conv_weight(const float* W, const float* g, int K, int N, bf16_t* Wt, size_t gt, size_t GT) {
    for (size_t i = gt; i < (size_t)K * N; i += GT) { const int k = (int)(i / N), n = (int)(i % N); Wt[(size_t)n * K + k] = (bf16_t)f2bf(W[i] * (g ? g[k] : 1.f)); }
}
__device__ __forceinline__ void p0_transpose_item(const float* __restrict__ W, const float* __restrict__ g, int N, bf16_t* WT, int ldk, LAS float* scr, int item, int lane) {
    const int nblk = N / 32, kb = item / nblk, nb = item % nblk, k0 = 64 * kb, n0 = 32 * nb;
#pragma unroll 8
    for (int i = 0; i < 32; ++i) { const int kk = 2 * i + (lane >> 5); scr[kk * 33 + (lane & 31)] = W[(size_t)(k0 + kk) * N + n0 + (lane & 31)] * (g ? g[k0 + kk] : 1.0f); }
    asm volatile("s_waitcnt lgkmcnt(0)" ::: "memory");
    const int c = lane & 7;
#pragma unroll
    for (int j = 0; j < 4; ++j) { const int n = (lane >> 3) + 8 * j; const LAS float* s = scr + (8 * c) * 33 + n;
        u32x4 o; o.x = pk2(s[0 * 33], s[1 * 33]); o.y = pk2(s[2 * 33], s[3 * 33]); o.z = pk2(s[4 * 33], s[5 * 33]); o.w = pk2(s[6 * 33], s[7 * 33]);
        *(u32x4*)(WT + (size_t)(n0 + n) * ldk + k0 + 8 * c) = o; }
    asm volatile("s_waitcnt lgkmcnt(0)" ::: "memory");
}
__device__ __forceinline__ void norm_rows(const float* X, bf16_t* O, int rows, int gw, int NGW, int lane) {
    for (int r = gw; r < rows; r += NGW) {
        const f32x4* xr = (const f32x4*)(X + (size_t)r * D) + lane; f32x4 v[4]; float s = 0.f;
#pragma unroll
        for (int j = 0; j < 4; ++j) { v[j] = xr[64 * j]; s += (v[j][0] * v[j][0] + v[j][1] * v[j][1]) + (v[j][2] * v[j][2] + v[j][3] * v[j][3]); }
        const float rs = rsqrtf(wave_sum(s) * (1.f / D) + EPS);
        u32x2* o = (u32x2*)(O + (size_t)r * D) + lane;
#pragma unroll
        for (int j = 0; j < 4; ++j) o[64 * j] = (u32x2){pk2(v[j][0] * rs, v[j][1] * rs), pk2(v[j][2] * rs, v[j][3] * rs)};
    }
}


__device__ __forceinline__ void cross_sample_pair(const float* __restrict__ mk, const float* __restrict__ mv, const bf16_t* __restrict__ CQ, bf16_t* OC, int task0, int ntask, LAS unsigned char* lds) {
    int tid_ = threadIdx.x; asm volatile("" : "+v"(tid_));
    const int tid = tid_, lane = tid & 63, wave = __builtin_amdgcn_readfirstlane(tid >> 6), tk = wave >> 2, mq = wave & 3;
    const int task = task0 + tk; const bool live = task < ntask;
    const int b = (live ? task : 0) / NCH, h = (live ? task : 0) % NCH;
    const int t16 = lane & 15, dq = lane >> 4;
    LAS float* pl = (LAS float*)(lds + wave * 2048);
    LAS float* op = (LAS float*)(lds + 16384 + (tk * 4 + mq) * 8192);
    LAS float* st = (LAS float*)(lds + 81920);
    if (live) {
        bf16x8 qf[8];
#pragma unroll
        for (int ds = 0; ds < 8; ++ds) {
            u32x4 w = (u32x4){0u, 0u, 0u, 0u};
            if (t16 < DEC_T) w = *(const u32x4*)(CQ + (size_t)(MP + b * DEC_T + t16) * D + h * CHD + ds * 32 + dq * 8);
            qf[ds] = __builtin_bit_cast(bf16x8, w);
        }
        f32x4 s[4];
        const float* kb = mk + (((size_t)b * NMEM + mq * 64 + t16) * NCH + h) * CHD + dq * 8;
#pragma unroll
        for (int mt = 0; mt < 4; ++mt) {
            f32x4 kv[16];
#pragma unroll
            for (int ds = 0; ds < 8; ++ds) { const float* p = kb + (size_t)(mt * 16) * NCH * CHD + ds * 32; kv[2 * ds] = *(const f32x4*)p; kv[2 * ds + 1] = *(const f32x4*)(p + 4); }
            f32x4 acc = (f32x4){0.f, 0.f, 0.f, 0.f};
#pragma unroll
            for (int ds = 0; ds < 8; ++ds) acc = __builtin_amdgcn_mfma_f32_16x16x32_bf16(__builtin_bit_cast(bf16x8, pg8::pack8(kv[2 * ds], kv[2 * ds + 1])), qf[ds], acc, 0, 0, 0);
            s[mt] = acc;
        }
        float mx = -3.0e38f;
#pragma unroll
        for (int mt = 0; mt < 4; ++mt) mx = fmaxf(mx, fmaxf(fmaxf(s[mt][0], s[mt][1]), fmaxf(s[mt][2], s[mt][3])));
        mx = fmaxf(mx, __shfl_xor(mx, 16)); mx = fmaxf(mx, __shfl_xor(mx, 32));
        float sum = 0.f;
#pragma unroll
        for (int mt = 0; mt < 4; ++mt)
#pragma unroll
            for (int e = 0; e < 4; ++e) { const float p = __builtin_amdgcn_exp2f(s[mt][e] - mx); sum += p; if (t16 < DEC_T) pl[(mt * 16 + dq * 4 + e) * 8 + t16] = p; }
        sum += __shfl_xor(sum, 16); sum += __shfl_xor(sum, 32);
        if (lane < DEC_T) { st[((tk * 4 + mq) * 8 + lane) * 2] = mx; st[((tk * 4 + mq) * 8 + lane) * 2 + 1] = sum; }
        asm volatile("s_waitcnt lgkmcnt(0)" ::: "memory");
        f32x4 o[8];
#pragma unroll
        for (int t = 0; t < 8; ++t) o[t] = (f32x4){0.f, 0.f, 0.f, 0.f};
        const float* vb = mv + (((size_t)b * NMEM + mq * 64) * NCH + h) * CHD + lane * 4;
#pragma unroll 8
        for (int ml = 0; ml < 64; ++ml) {
            const f32x4 v = *(const f32x4*)(vb + (size_t)ml * NCH * CHD);
            const f32x4 p0 = *(const LAS f32x4*)(pl + ml * 8), p1 = *(const LAS f32x4*)(pl + ml * 8 + 4);
            o[0] += v * p0[0]; o[1] += v * p0[1]; o[2] += v * p0[2]; o[3] += v * p0[3];
            o[4] += v * p1[0]; o[5] += v * p1[1]; o[6] += v * p1[2]; o[7] += v * p1[3];
        }
#pragma unroll
        for (int t = 0; t < 8; ++t) *(LAS f32x4*)(op + t * 256 + lane * 4) = o[t];
    }
    __syncthreads();
    if (live) {
#pragma unroll
        for (int tt = 0; tt < 2; ++tt) {
            const int t = 2 * mq + tt; float m4[4], l4[4]; float M4 = -3.0e38f;
#pragma unroll
            for (int q = 0; q < 4; ++q) { m4[q] = st[((tk * 4 + q) * 8 + t) * 2]; l4[q] = st[((tk * 4 + q) * 8 + t) * 2 + 1]; M4 = fmaxf(M4, m4[q]); }
            float Ls = 0.f; f32x4 o = (f32x4){0.f, 0.f, 0.f, 0.f};
#pragma unroll
            for (int q = 0; q < 4; ++q) { const float f = __builtin_amdgcn_exp2f(m4[q] - M4); Ls += l4[q] * f; o += *(const LAS f32x4*)((LAS float*)(lds + 16384 + (tk * 4 + q) * 8192) + t * 256 + lane * 4) * f; }
            const float il = 1.0f / Ls;
            *(u32x2*)(OC + (size_t)(MP + b * DEC_T + t) * D + h * CHD + lane * 4) = (u32x2){pg8::cvt_pk_bf16(o[0] * il, o[1] * il), pg8::cvt_pk_bf16(o[2] * il, o[3] * il)};
        }
    }
    __syncthreads();
}


typedef float f32x16 __attribute__((ext_vector_type(16)));
typedef short v4i16_t __attribute__((ext_vector_type(4)));
__device__ __forceinline__ int crow(int r, int hi) { return (r & 3) + 8 * (r >> 2) + 4 * hi; }
__device__ __forceinline__ void win_attn_unit(const bf16_t* __restrict__ Qb, const bf16_t* __restrict__ Kb, const bf16_t* __restrict__ Vb, bf16_t* A2, const float* __restrict__ sinks, int unit, LAS unsigned char* lds) {
    int tid_ = threadIdx.x; asm volatile("" : "+v"(tid_));
    const int tid = tid_, lane = tid & 63, wid = __builtin_amdgcn_readfirstlane(tid >> 6), r32 = lane & 31, hi = lane >> 5;
    const int jb = unit & 63, kvh = (unit >> 6) & 1, b = unit >> 7;
    const int q0 = jb * 64, kp0 = q0 - 128;
    const size_t rowb = (size_t)b * SEQ;
#pragma unroll
    for (int tt = 0; tt < 3; ++tt) {
        const int kpos = kp0 + tt * 64 + lane, kr = kpos < 0 ? 0 : kpos;
        const u32x4 kx = *(const u32x4*)(Kb + (rowb + kr) * KVW + kvh * HD + wid * 8);
        const u32x4 vx = *(const u32x4*)(Vb + (rowb + kr) * KVW + kvh * HD + wid * 8);
        *(LAS u32x4*)(lds + tt * 8192 + wid * 1024 + lane * 16) = kx;
        *(LAS u32x4*)(lds + 24576 + tt * 8192 + (wid >> 2) * 4096 + (lane >> 4) * 1024 + (lane & 15) * 64 + (wid & 3) * 16) = vx;
    }
    const int g = wid >> 1, sb = wid & 1, h = kvh * 4 + g;
    const bf16_t* Qw = Qb + (rowb + q0 + sb * 32 + r32) * AW + h * HD;
    bf16x8 qr[4];
#pragma unroll
    for (int d0 = 0; d0 < 4; ++d0) qr[d0] = *(const bf16x8*)(Qw + d0 * 16 + hi * 8);
    __syncthreads();
    f32x16 p[3][2];
#pragma unroll
    for (int tt = 0; tt < 3; ++tt) {
        const LAS unsigned char* kb = lds + tt * 8192 + hi * 1024 + r32 * 16;
        f32x16 a0 = {}, a1 = {};
#pragma unroll
        for (int d0 = 0; d0 < 4; ++d0) {
            const bf16x8 b0 = *(const LAS bf16x8*)(kb + d0 * 2048), b1 = *(const LAS bf16x8*)(kb + d0 * 2048 + 512);
            a0 = __builtin_amdgcn_mfma_f32_32x32x16_bf16(b0, qr[d0], a0, 0, 0, 0); a1 = __builtin_amdgcn_mfma_f32_32x32x16_bf16(b1, qr[d0], a1, 0, 0, 0);
        }
        p[tt][0] = a0; p[tt][1] = a1;
    }
    const float slope = __builtin_amdgcn_exp2f(-(float)(h + 1)) * LOG2E, sink = sinks[h] * LOG2E;
    const int qrel = 128 + sb * 32 + r32;
    float mx = sink;
#pragma unroll
    for (int tt = 0; tt < 3; ++tt)
#pragma unroll
        for (int pp = 0; pp < 2; ++pp)
#pragma unroll
            for (int r = 0; r < 16; ++r) {
                const int krel = 64 * tt + 32 * pp + crow(r, hi), dist = qrel - krel;
                const bool valid = dist >= 0 && dist <= WIN && kp0 + krel >= 0;
                const float s = valid ? p[tt][pp][r] - slope * (float)dist : -3.0e38f;
                p[tt][pp][r] = s; mx = fmaxf(mx, s);
            }
    mx = fmaxf(mx, __shfl_xor(mx, 32));
    float l = 0.f;
#pragma unroll
    for (int tt = 0; tt < 3; ++tt)
#pragma unroll
        for (int pp = 0; pp < 2; ++pp)
#pragma unroll
            for (int r = 0; r < 16; ++r) { const float e = __builtin_amdgcn_exp2f(p[tt][pp][r] - mx); p[tt][pp][r] = e; l += e; }
    l += __shfl_xor(l, 32); l += __builtin_amdgcn_exp2f(sink - mx);
    LAS float* wsf = (LAS float*)(lds + 49152 + wid * 256);
    if (hi == 0) wsf[r32] = l;
    f32x16 o[2] = {{}, {}};
    const LAS unsigned char* vp0 = lds + 24576 + ((lane >> 4) & 1) * 32 + (lane & 3) * 8 + (4 * hi + ((lane & 15) >> 2)) * 64;
#pragma unroll
    for (int tt = 0; tt < 3; ++tt)
#pragma unroll
        for (int ks = 0; ks < 4; ++ks) {
            const f32x16& ps = p[tt][ks >> 1]; const int r0 = 8 * (ks & 1);
            u32x4 pw; pw.x = pg8::cvt_pk_bf16(ps[r0], ps[r0 + 1]); pw.y = pg8::cvt_pk_bf16(ps[r0 + 2], ps[r0 + 3]); pw.z = pg8::cvt_pk_bf16(ps[r0 + 4], ps[r0 + 5]); pw.w = pg8::cvt_pk_bf16(ps[r0 + 6], ps[r0 + 7]);
            const bf16x8 pa = __builtin_bit_cast(bf16x8, pw);
#pragma unroll
            for (int d0 = 0; d0 < 2; ++d0) {
                const LAS unsigned char* vp = vp0 + tt * 8192 + d0 * 4096 + ks * 1024;
                const v4i16_t lo = __builtin_amdgcn_ds_read_tr16_b64_v4i16((LAS v4i16_t*)vp), hh = __builtin_amdgcn_ds_read_tr16_b64_v4i16((LAS v4i16_t*)(vp + 512));
                const bf16x8 vf = (bf16x8){lo[0], lo[1], lo[2], lo[3], hh[0], hh[1], hh[2], hh[3]};
                o[d0] = __builtin_amdgcn_mfma_f32_32x32x16_bf16(pa, vf, o[d0], 0, 0, 0);
            }
        }
    asm volatile("s_waitcnt lgkmcnt(0)" ::: "memory");
    LAS bf16_t* stg = (LAS bf16_t*)(lds + 51200 + wid * 4096);
#pragma unroll
    for (int r = 0; r < 16; ++r) {
        const int orow = crow(r, hi); const float il = 1.0f / wsf[orow];
        stg[orow * 64 + r32] = (bf16_t)f2bf(o[0][r] * il); stg[orow * 64 + 32 + r32] = (bf16_t)f2bf(o[1][r] * il);
    }
    asm volatile("s_waitcnt lgkmcnt(0)" ::: "memory");
    bf16_t* Ow = A2 + (rowb + q0 + sb * 32) * D + h * HD;
#pragma unroll
    for (int i = 0; i < 4; ++i) { const int row = i * 8 + (lane >> 3), ch = lane & 7; *(u32x4*)(Ow + (size_t)row * D + ch * 8) = *(const LAS u32x4*)(stg + row * 64 + ch * 8); }
    __syncthreads();
}
__device__ __forceinline__ void win_attn_sample(const bf16_t* __restrict__ Qb, const bf16_t* __restrict__ Kb, const bf16_t* __restrict__ Vb, const float* __restrict__ ck, const float* __restrict__ cv,
                                                bf16_t* A2, const float* __restrict__ sinks, int task, LAS float* pl, int lane) {
    const int h = task & 7, t = (task >> 3) & 7, b = task >> 6, kvh = h >> 2, row = MP + b * DEC_T + t;
    float q[HD];
    { const u32x4* qp = (const u32x4*)(Qb + (size_t)row * AW + h * HD);
#pragma unroll
      for (int c = 0; c < 8; ++c) { const u32x4 w = qp[c];
#pragma unroll
          for (int e = 0; e < 4; ++e) { q[c * 8 + 2 * e] = __builtin_bit_cast(float, w[e] << 16); q[c * 8 + 2 * e + 1] = __builtin_bit_cast(float, w[e] & 0xffff0000u); } } }
    const float slope = __builtin_amdgcn_exp2f(-(float)(h + 1)) * LOG2E, sink = sinks[h] * LOG2E;
    float sv[3]; float mx = sink;
#pragma unroll
    for (int k = 0; k < 3; ++k) {
        const int i = lane + 64 * k; float s = -3.0e38f;
        if (i <= WIN) {
            float acc = 0.f;
            if (i > t) { const f32x4* kp = (const f32x4*)(ck + ((size_t)b * WIN + (WIN + t - i)) * KVW + kvh * HD);
#pragma unroll
                for (int c = 0; c < 16; ++c) { const f32x4 w = kp[c]; acc += q[4 * c] * w[0] + q[4 * c + 1] * w[1] + q[4 * c + 2] * w[2] + q[4 * c + 3] * w[3]; } }
            else { const u32x4* kp = (const u32x4*)(Kb + (size_t)(row - i) * KVW + kvh * HD);
#pragma unroll
                for (int c = 0; c < 8; ++c) { const u32x4 w = kp[c];
#pragma unroll
                    for (int e = 0; e < 4; ++e) acc += q[c * 8 + 2 * e] * __builtin_bit_cast(float, w[e] << 16) + q[c * 8 + 2 * e + 1] * __builtin_bit_cast(float, w[e] & 0xffff0000u); } }
            s = acc - slope * (float)i;
        }
        sv[k] = s; mx = fmaxf(mx, s);
    }
    mx = wave_max(mx);
    float l = 0.f;
#pragma unroll
    for (int k = 0; k < 3; ++k) { const int i = lane + 64 * k; const float e = (i <= WIN) ? __builtin_amdgcn_exp2f(sv[k] - mx) : 0.f; l += e; if (i <= WIN) pl[i] = e; }
    l = wave_sum(l) + __builtin_amdgcn_exp2f(sink - mx);
    asm volatile("s_waitcnt lgkmcnt(0)" ::: "memory");
    float o = 0.f;
    for (int i = 0; i <= t; ++i) o += pl[i] * bf2f(Vb[(size_t)(row - i) * KVW + kvh * HD + lane]);
    const float* vc = cv + ((size_t)b * WIN) * KVW + kvh * HD + lane;
#pragma unroll 8
    for (int j = t; j < WIN; ++j) o += pl[WIN + t - j] * vc[(size_t)j * KVW];
    A2[(size_t)row * D + h * HD + lane] = (bf16_t)f2bf(o / l);
    asm volatile("s_waitcnt lgkmcnt(0)" ::: "memory");
}
__device__ __forceinline__ void pool_diff(const bf16_t* __restrict__ Ub, const float* __restrict__ sp, bf16_t* A2, size_t gt, size_t GT) {
    for (size_t task = gt; task < (size_t)M * (PW / 8); task += GT) {
        const int row = (int)(task / (PW / 8)), c0 = (int)(task % (PW / 8)) * 8, w = 2 << (c0 / 128);
        float s[8]; float cur[8];
#pragma unroll
        for (int e = 0; e < 8; ++e) s[e] = 0.f;
        const bool samp = row >= MP; int nb, t, b = 0;
        if (!samp) { t = row % SEQ; nb = t + 1 < w ? t + 1 : w; } else { b = (row - MP) / DEC_T; t = (row - MP) % DEC_T; nb = t + 1 < w ? t + 1 : w; }
        for (int i = 0; i < nb; ++i) { const u32x4 x = *(const u32x4*)(Ub + (size_t)(row - i) * PW + c0);
#pragma unroll
            for (int e = 0; e < 4; ++e) { const float lo = __builtin_bit_cast(float, x[e] << 16), hh = __builtin_bit_cast(float, x[e] & 0xffff0000u); s[2 * e] += lo; s[2 * e + 1] += hh; if (i == 0) { cur[2 * e] = lo; cur[2 * e + 1] = hh; } } }
        float cnt = (float)nb;
        if (samp) { for (int i = nb; i < w; ++i) { const float* p = sp + ((size_t)b * PHIST + (PHIST + t - i)) * PW + c0; const f32x4 x0 = *(const f32x4*)p, x1 = *(const f32x4*)(p + 4);
#pragma unroll
                for (int e = 0; e < 4; ++e) { s[e] += x0[e]; s[4 + e] += x1[e]; } } cnt = (float)w; }
        const float ic = 1.0f / cnt;
        *(u32x4*)(A2 + (size_t)row * D + AW + c0) = (u32x4){pk2(s[0] * ic - cur[0], s[1] * ic - cur[1]), pk2(s[2] * ic - cur[2], s[3] * ic - cur[3]), pk2(s[4] * ic - cur[4], s[5] * ic - cur[5]), pk2(s[6] * ic - cur[6], s[7] * ic - cur[7])};
    }
}

__global__ void __launch_bounds__(NTHREADS, 2) fwd(Args a) {
    extern __shared__ __attribute__((aligned(16))) unsigned char lds[];
    const int tid = threadIdx.x, lane = tid & 63, wave = tid >> 6;
    const int G = gridDim.x, bx = blockIdx.x;
    const size_t gt = (size_t)bx * NTHREADS + tid, GT = (size_t)G * NTHREADS;
    const int gw = bx * NWAVES + wave, NGW = G * NWAVES;
    unsigned char* ws = a.ws;
    unsigned* ctl = (unsigned*)(ws + WS_CTL);
    float* rss1 = (float*)(ws + WS_RSS); float* rss2 = (float*)(ws + WS_RSS + RSS_BYTES); float* rss3 = (float*)(ws + WS_RSS + 2 * RSS_BYTES);
    bf16_t* Win_t = (bf16_t*)(ws + WS_WIN); bf16_t* Wckv_t = (bf16_t*)(ws + WS_WCKV); bf16_t* Wo2_t = (bf16_t*)(ws + WS_WO2);
    bf16_t* Wcq_t = (bf16_t*)(ws + WS_WCQ); bf16_t* Wco_t = (bf16_t*)(ws + WS_WCO); bf16_t* Wup_t = (bf16_t*)(ws + WS_WUP); bf16_t* Wdn_t = (bf16_t*)(ws + WS_WDN);
    bf16_t* HM = (bf16_t*)(ws + WS_HM); bf16_t* MK = (bf16_t*)(ws + WS_MK); bf16_t* MV = (bf16_t*)(ws + WS_MV); bf16_t* MVt = (bf16_t*)(ws + WS_MVT);
    LAS unsigned char* L = (LAS unsigned char*)lds;
    bf16_t* XN0 = (bf16_t*)(ws + WS_XN0); bf16_t* Qb = (bf16_t*)(ws + WS_Q); bf16_t* Kb = (bf16_t*)(ws + WS_K); bf16_t* Vb = (bf16_t*)(ws + WS_V); bf16_t* Ub = (bf16_t*)(ws + WS_U);
    bf16_t* A2 = (bf16_t*)(ws + WS_A2); bf16_t* XB = (bf16_t*)(ws + WS_XB); bf16_t* CQ = (bf16_t*)(ws + WS_CQ); bf16_t* OC = (bf16_t*)(ws + WS_OC); bf16_t* Hb = (bf16_t*)(ws + WS_H);
    float* X = a.out;

    volatile LAS unsigned* MISC = (volatile LAS unsigned*)((LAS unsigned char*)lds + (LDS_BYTES - 256));
    if (tid < 32) MISC[tid] = 0u;
    __syncthreads();
    XcdBarrier bar; bar.bar = ctl + CW_BAR; bar.x = 0; bar.st = nullptr;
    if (MK_N_LAUNCHES == 1) bar = xcd_barrier_post(ctl + CW_BAR, MISC + 8);
    const int lo = a.ph_lo, hi = a.ph_hi;
#ifndef PHASE_MASK
#define PHASE_MASK 0x3ff
#endif
#define IN(k) (((PHASE_MASK >> (k)) & 1) && lo <= (k) && (k) < hi)
#ifndef REPEAT_MASK
#define REPEAT_MASK 0
#endif
#define REPS(k) for (int rep_ = 0; rep_ < (((REPEAT_MASK >> (k)) & 1) ? 2 : 1); ++rep_)
#define SEAM(k) do { if (IN(k) && IN((k) + 1)) xcd_barrier(bar); } while (0)

    if (IN(0)) {
        {
            LAS float* scr = (LAS float*)(L + wave * 16384);
            constexpr int I_IN = (D / 64) * (INW / 32), I_SQ = (D / 64) * (D / 32), I_O = (AW / 64) * (D / 32), I_UP = (D / 64) * (DFF / 32), I_DN = (DFF / 64) * (D / 32);
            constexpr int NITEMS = I_IN + 4 * I_SQ + I_O + I_UP + I_DN;
            for (int it = gw; it < NITEMS; it += NGW) {
                int r = it;
                if (r < I_UP) { p0_transpose_item(a.w_up, a.g_ffn, DFF, Wup_t, D, scr, r, lane); continue; } r -= I_UP;
                if (r < I_DN) { p0_transpose_item(a.w_down, nullptr, D, Wdn_t, DFF, scr, r, lane); continue; } r -= I_DN;
                if (r < I_IN) { p0_transpose_item(a.w_in, a.g_mix, INW, Win_t, D, scr, r, lane); continue; } r -= I_IN;
                if (r < I_SQ) { p0_transpose_item(a.w_ck, a.g_mem, D, Wckv_t, D, scr, r, lane); continue; } r -= I_SQ;
                if (r < I_SQ) { p0_transpose_item(a.w_cv, a.g_mem, D, Wckv_t + (size_t)D * D, D, scr, r, lane); continue; } r -= I_SQ;
                if (r < I_SQ) { p0_transpose_item(a.w_cq, a.g_cross, D, Wcq_t, D, scr, r, lane); continue; } r -= I_SQ;
                if (r < I_SQ) { p0_transpose_item(a.w_co, nullptr, D, Wco_t, D, scr, r, lane); continue; } r -= I_SQ;
                p0_transpose_item(a.w_out, nullptr, D, Wo2_t, D, scr, r, lane);
            }
        }
        for (size_t i = gt; i < (size_t)PW * D; i += GT) {
            const int cc = (int)(i / D), n = (int)(i % D), g = cc / 128, c = cc % 128; float s = 0.f;
            for (int e = 0; e < 128; ++e) s += a.w_pool[((size_t)g * 128 + c) * 128 + e] * a.pool_scale[g * 128 + e] * a.w_out[(size_t)(AW + g * 128 + e) * D + n];
            Wo2_t[(size_t)n * D + AW + cc] = (bf16_t)f2bf(s);
        }
        norm_rows(a.x_prompt, XN0, MP, gw, NGW, lane);
        norm_rows(a.x_sample, XN0 + (size_t)MP * D, MS, gw, NGW, lane);
        norm_rows(a.mem_prompt, HM, BATCH * NMEM, gw, NGW, lane);
        for (size_t i = gt; i < (size_t)DEC_B * (WIN - DEC_T) * KVW; i += GT) {
            const int b = (int)(i / ((WIN - DEC_T) * KVW)), r = (int)(i % ((WIN - DEC_T) * KVW));
            a.out[O_WKS + (size_t)b * WIN * KVW + r] = a.cache_win_k[(size_t)b * WIN * KVW + DEC_T * KVW + r];
            a.out[O_WVS + (size_t)b * WIN * KVW + r] = a.cache_win_v[(size_t)b * WIN * KVW + DEC_T * KVW + r];
        }
        for (size_t i = gt; i < (size_t)DEC_B * (PHIST - DEC_T) * PW; i += GT) {
            const int b = (int)(i / ((PHIST - DEC_T) * PW)), r = (int)(i % ((PHIST - DEC_T) * PW));
            a.out[O_PS + (size_t)b * PHIST * PW + r] = a.state_pool[(size_t)b * PHIST * PW + DEC_T * PW + r];
        }
    }
    SEAM(0);
    if (IN(1)) {
        pg8::SegOrder<3> S{}; S.G = G; S.c = bx; S.pa = (size_t)256 * D * 2; S.pb = (size_t)256 * D * 2;
        S.s[0] = pg8::Seg{XN0, Win_t, M / 256, INW / 256, 0};
        S.s[1] = pg8::Seg{HM, Wckv_t, BATCH * NMEM / 256, 2 * D / 256, 1};
        S.s[2] = pg8::Seg{Wckv_t + (size_t)D * D, HM, D / 256, BATCH, 2};
        pg8::gemm_phase<pg8::EpiP1, pg8::SegOrder<3>, true, true>(L, D, D, D, S, pg8::EpiP1{Qb, Kb, Vb, Ub, MK, MV, MVt, a.out});
    }
    SEAM(1);
    if (IN(2)) {
        for (int unit = bx; unit < BATCH * NKV * (SEQ / 64); unit += G) win_attn_unit(Qb, Kb, Vb, A2, a.attn_sinks, unit, L);
        { LAS float* pl = (LAS float*)L + wave * 256;
          for (int task = gw; task < DEC_B * DEC_T * NH; task += NGW) win_attn_sample(Qb, Kb, Vb, a.cache_win_k, a.cache_win_v, A2, a.attn_sinks, task, pl, lane); }
        pool_diff(Ub, a.state_pool, A2, gt, GT);
    }
    SEAM(2);
    if (IN(3)) {
        pg8::SegOrder<1> S{}; S.G = G; S.c = bx; S.pa = (size_t)256 * D * 2; S.pb = (size_t)256 * D * 2;
        S.s[0] = pg8::Seg{A2, Wo2_t, MP / 256, D / 256, 0};
        pg8::gemm_phase<pg8::EpiResidG, pg8::SegOrder<1>, true, true>(L, D, D, D, S, pg8::EpiResidG{a.x_prompt, a.x_sample - (size_t)MP * D, X, XB, rss1});
        gemm_mini(A2 + (size_t)MP * D, D, Wo2_t, D, MS, D, D, L, MiniResid{a.x_sample, X + (size_t)MP * D, XB + (size_t)MP * D, rss1 + (size_t)MP * 16});
    }
    SEAM(3);
    if (IN(4)) {
        pg8::SegOrder<1> S{}; S.G = G; S.c = bx; S.pa = (size_t)256 * D * 2; S.pb = (size_t)256 * D * 2;
        S.s[0] = pg8::Seg{XB, Wcq_t, MP / 256, D / 256, 0};
        pg8::gemm_phase<pg8::EpiRowScaleG<0>, pg8::SegOrder<1>, true, true>(L, D, D, D, S, pg8::EpiRowScaleG<0>{CQ, D, rss1, (1.0f / 16.0f) * LOG2E});
        gemm_mini(XB + (size_t)MP * D, D, Wcq_t, D, MS, D, D, L, MiniRowScale<0>{CQ + (size_t)MP * D, D, rss1 + (size_t)MP * 16, (1.0f / 16.0f) * LOG2E});
    }
    SEAM(4);
    if (IN(5)) {
        bf16_t* Pb = (bf16_t*)(ws + WS_P);
        const bool sample_first = ((bx >> 3) & 1) != 0;
        if (sample_first) for (int t0 = 2 * bx; t0 < DEC_B * NCH; t0 += 2 * G) cross_sample_pair(a.cache_mem_k, a.cache_mem_v, CQ, OC, t0, DEC_B * NCH, L);
        for (int Lu = bx; Lu < BATCH * NCH * (SEQ / 256); Lu += G) {
            const int xc = Lu & 7, idx = Lu >> 3, bh = xc * 2 + (idx >> 4), qp = idx & 15, b = bh >> 2, h = bh & 3;
            pg8::OneUnit S1; S1.u.pm = b * (SEQ / 256) + qp; S1.u.pn = h; S1.u.kind = 0;
            S1.u.a = (const char*)(CQ + ((size_t)(b * SEQ + qp * 256)) * D + h * CHD); S1.u.b = (const char*)(MK + (size_t)(b * NMEM) * D + h * CHD);
            pg8::gemm_phase<pg8::EpiSoftmaxP, pg8::OneUnit, false, true>(L, D, D, CHD, S1, pg8::EpiSoftmaxP{Pb});
            asm volatile("s_waitcnt vmcnt(0)" ::: "memory"); __syncthreads();
            pg8::OneUnit S2; S2.u.pm = S1.u.pm; S2.u.pn = h; S2.u.kind = 0;
            S2.u.a = (const char*)(Pb + ((size_t)(b * SEQ + qp * 256)) * D + h * CHD); S2.u.b = (const char*)(MVt + ((size_t)b * D + h * CHD) * NMEM);
            pg8::gemm_phase<pg8::EpiStoreBf16, pg8::OneUnit, true, true>(L, D, NMEM, NMEM, S2, pg8::EpiStoreBf16{OC});
            __syncthreads();
        }
        if (!sample_first) for (int t0 = 2 * bx; t0 < DEC_B * NCH; t0 += 2 * G) cross_sample_pair(a.cache_mem_k, a.cache_mem_v, CQ, OC, t0, DEC_B * NCH, L);
    }
    SEAM(5);
    if (IN(6)) {
        pg8::SegOrder<1> S{}; S.G = G; S.c = bx; S.pa = (size_t)256 * D * 2; S.pb = (size_t)256 * D * 2;
        S.s[0] = pg8::Seg{OC, Wco_t, MP / 256, D / 256, 0};
        pg8::gemm_phase<pg8::EpiResidG, pg8::SegOrder<1>, true, true>(L, D, D, D, S, pg8::EpiResidG{X, X, X, XB, rss2});
        gemm_mini(OC + (size_t)MP * D, D, Wco_t, D, MS, D, D, L, MiniResid{X + (size_t)MP * D, X + (size_t)MP * D, XB + (size_t)MP * D, rss2 + (size_t)MP * 16});
    }
    SEAM(6);
    if (IN(7)) {
        pg8::SegOrder<1> S{}; S.G = G; S.c = bx; S.pa = (size_t)256 * D * 2; S.pb = (size_t)256 * D * 2;
        S.s[0] = pg8::Seg{XB, Wup_t, MP / 256, DFF / 256, 0};
        pg8::gemm_phase<pg8::EpiRowScaleG<1>, pg8::SegOrder<1>, true, true>(L, D, D, D, S, pg8::EpiRowScaleG<1>{Hb, DFF, rss2, 1.0f});
        gemm_mini(XB + (size_t)MP * D, D, Wup_t, D, MS, DFF, D, L, MiniRowScale<1>{Hb + (size_t)MP * DFF, DFF, rss2 + (size_t)MP * 16, 1.0f});
    }
    SEAM(7);
    if (IN(8)) {
        pg8::SegOrder<1> S{}; S.G = G; S.c = bx; S.pa = (size_t)256 * DFF * 2; S.pb = (size_t)256 * DFF * 2;
        S.s[0] = pg8::Seg{Hb, Wdn_t, MP / 256, D / 256, 0};
        pg8::gemm_phase<pg8::EpiResidG, pg8::SegOrder<1>, true, true>(L, DFF, DFF, DFF, S, pg8::EpiResidG{X, X, X, nullptr, rss3});
        gemm_mini(Hb + (size_t)MP * DFF, DFF, Wdn_t, DFF, MS, D, DFF, L, MiniResid{X + (size_t)MP * D, X + (size_t)MP * D, nullptr, rss3 + (size_t)MP * 16});
    }
    SEAM(8);
    if (IN(9)) {
        for (int r = gw; r < M; r += NGW) {
            const float rs = rstd_from_slots(rss3, r);
            f32x4* xr = (f32x4*)(X + (size_t)r * D) + lane; const f32x4* gp = (const f32x4*)a.g_final + lane;
#pragma unroll
            for (int j = 0; j < 4; ++j) xr[64 * j] = xr[64 * j] * rs * gp[64 * j];
        }
    }
#undef IN
#undef SEAM
}

constexpr int N_PHASES = 10;
extern "C" void kernel_launch(void* const* d_in, const int* in_sizes, int n_in, void* d_out, int out_size, void* d_ws, size_t ws_size, hipStream_t stream) {
    static int grid = 0;
    if (grid == 0) {
        if (n_in != 24 || in_sizes[0] != MP * D || out_size != (int)O_END || ws_size < WS_END) {
            fprintf(stderr, "kernel_launch: unexpected shapes: n_in %d in0 %d out %d ws %zu (need %zu)\n", n_in, n_in > 0 ? in_sizes[0] : -1, out_size, ws_size, (size_t)WS_END); grid = -1; return; }
        int dev = 0, cus = 0, per_cu = 0;
        if (hipGetDevice(&dev) != hipSuccess || hipDeviceGetAttribute(&cus, hipDeviceAttributeMultiprocessorCount, dev) != hipSuccess) { grid = -1; return; }
        if (hipFuncSetAttribute((const void*)fwd, hipFuncAttributeMaxDynamicSharedMemorySize, LDS_BYTES) != hipSuccess) { fprintf(stderr, "kernel_launch: hipFuncSetAttribute failed\n"); grid = -1; return; }
        if (hipOccupancyMaxActiveBlocksPerMultiprocessor(&per_cu, (const void*)fwd, NTHREADS, LDS_BYTES) != hipSuccess || per_cu < 1) { fprintf(stderr, "kernel_launch: occupancy query says %d\n", per_cu); grid = -1; (void)hipGetLastError(); return; }
        grid = cus;
    }
    if (grid < 0) return;
    (void)hipMemsetAsync((char*)d_ws + WS_CTL, 0, CTL_ZERO_BYTES, stream);
    Args a{};
    const float** p = (const float**)&a;
    for (int i = 0; i < 24; ++i) p[i] = (const float*)d_in[i];
    a.out = (float*)d_out; a.ws = (unsigned char*)d_ws;
    if (MK_N_LAUNCHES == 1) { a.ph_lo = 0; a.ph_hi = N_PHASES; hipLaunchKernelGGL(fwd, dim3(grid), dim3(NTHREADS), LDS_BYTES, stream, a); }
    else for (int ph = 0; ph < N_PHASES; ++ph) { a.ph_lo = ph; a.ph_hi = ph + 1; hipLaunchKernelGGL(fwd, dim3(grid), dim3(NTHREADS), LDS_BYTES, stream, a); }
}
```

```cpp
#include <hip/hip_runtime.h>
#include <cstdio>
#include <cstdint>

#ifndef MK_N_LAUNCHES
#define MK_N_LAUNCHES 1
#endif

constexpr int D = 1024, BATCH = 4, SEQ = 4096, DEC_B = 128, DEC_T = 8, PAST = 16384;
constexpr int HD = 64, AW = 512, NH = 8, NKV = 2, KVW = 128, WIN = 128, PW = 512, PHIST = 15, INW = 1280;
constexpr int NMEM = 256, NCH = 4, CHD = 256, DFF = 4096;
constexpr int MP = BATCH * SEQ, MS = DEC_B * DEC_T, M = MP + MS;
constexpr float EPS = 1e-5f;
constexpr float LOG2E = 1.4426950408889634f;

constexpr size_t O_YP = 0, O_YS = O_YP + (size_t)MP * D, O_WKP = O_YS + (size_t)MS * D, O_WVP = O_WKP + (size_t)BATCH * WIN * KVW,
                 O_PP = O_WVP + (size_t)BATCH * WIN * KVW, O_MKP = O_PP + (size_t)BATCH * PHIST * PW, O_MVP = O_MKP + (size_t)BATCH * NMEM * D,
                 O_WKS = O_MVP + (size_t)BATCH * NMEM * D, O_WVS = O_WKS + (size_t)DEC_B * WIN * KVW, O_PS = O_WVS + (size_t)DEC_B * WIN * KVW,
                 O_END = O_PS + (size_t)DEC_B * PHIST * PW;
static_assert(O_END == 25262080, "output size");

constexpr size_t MiB = 1u << 20;
constexpr size_t WS_CTL = 0, CTL_ZERO_BYTES = 1 * MiB;
constexpr size_t WS_WIN = 5 * MiB;
constexpr size_t WS_WCKV = 8 * MiB;
constexpr size_t WS_WO2 = 12 * MiB;
constexpr size_t WS_WCQ = 14 * MiB, WS_WCO = 16 * MiB;
constexpr size_t WS_WUP = 18 * MiB;
constexpr size_t WS_WDN = 26 * MiB;
constexpr size_t WS_HM = 34 * MiB;
constexpr size_t WS_MK = 36 * MiB, WS_MV = 38 * MiB;
constexpr size_t WS_MVT = 40 * MiB;
constexpr size_t WS_XN0 = 42 * MiB;
constexpr size_t WS_Q = 76 * MiB;
constexpr size_t WS_K = 93 * MiB, WS_V = 98 * MiB;
constexpr size_t WS_U = 103 * MiB;
constexpr size_t WS_A2 = 120 * MiB;
constexpr size_t WS_XB = 154 * MiB;
constexpr size_t WS_CQ = 188 * MiB;
constexpr size_t WS_OC = 222 * MiB;
constexpr size_t WS_P = 256 * MiB;
constexpr size_t WS_H = 288 * MiB;
constexpr size_t WS_WOB = 424 * MiB;
constexpr size_t WS_BD = 425 * MiB;
constexpr size_t WS_END = 426 * MiB;
constexpr int CW_BAR = 4096;
constexpr size_t WS_RSS = 1 * MiB;
constexpr size_t RSS_BYTES = (size_t)M * 16 * 4;

constexpr int LDS_BYTES = 147456;
constexpr int NTHREADS = 512, NWAVES = 8;

typedef unsigned short bf16_t;
typedef short bf16x8 __attribute__((ext_vector_type(8)));
typedef float f32x4 __attribute__((ext_vector_type(4)));
typedef unsigned u32x2 __attribute__((ext_vector_type(2)));
typedef unsigned u32x4 __attribute__((ext_vector_type(4)));
#define LAS __attribute__((address_space(3)))

__device__ __forceinline__ unsigned f2bf(float f) { unsigned u = __builtin_bit_cast(unsigned, f); return (u + 0x7fffu + ((u >> 16) & 1u)) >> 16; }
__device__ __forceinline__ unsigned pk2(float lo, float hi) { return f2bf(lo) | (f2bf(hi) << 16); }
__device__ __forceinline__ float bf2f(bf16_t h) { return __builtin_bit_cast(float, (unsigned)h << 16); }
__device__ __forceinline__ float wave_sum(float v) {
#pragma unroll
    for (int o = 1; o < 64; o <<= 1) v += __shfl_xor(v, o);
    return v;
}
__device__ __forceinline__ float wave_max(float v) {
#pragma unroll
    for (int o = 1; o < 64; o <<= 1) v = fmaxf(v, __shfl_xor(v, o));
    return v;
}

__device__ __forceinline__ float rstd_from_slots(const float* rss, int row) {
    const f32x4* p = (const f32x4*)(rss + (size_t)row * 16); const f32x4 a = p[0], b = p[1], c = p[2], d = p[3];
    const float s = ((a[0] + a[1]) + (a[2] + a[3])) + ((b[0] + b[1]) + (b[2] + b[3])) + ((c[0] + c[1]) + (c[2] + c[3])) + ((d[0] + d[1]) + (d[2] + d[3]));
    return rsqrtf(s * (1.0f / D) + EPS);
}
#define XB_TMO      128
#define XB_XCNT(j)  (256  + 64 * (j))
#define XB_XSUB(j)  (1280 + 64 * (j))
#define XB_XGEN(j)  (2304 + 64 * (j))
#define XB_TOP      3328
#define XB_TOPGEN   3392
#define XCD_BAR_WORDS 3456
#define XB_SPIN_CAP (1u << 18)
__device__ __forceinline__ unsigned xb_ld(unsigned* p)              { return __hip_atomic_load(p, __ATOMIC_RELAXED, __HIP_MEMORY_SCOPE_AGENT); }
__device__ __forceinline__ unsigned xb_add(unsigned* p, unsigned v) { return __hip_atomic_fetch_add(p, v, __ATOMIC_RELAXED, __HIP_MEMORY_SCOPE_AGENT); }
__device__ __forceinline__ unsigned xb_xcc_id() { return (unsigned)__builtin_amdgcn_s_getreg((3 << 11) | 20) & 0xFu; }
#define XB_SPIN(cond, bar) do { unsigned _sp = 0; while (cond) { __builtin_amdgcn_s_sleep(1); \
    if ((++_sp & 255u) == 0u) { if (xb_ld(&(bar)[XB_TMO])) break; if (_sp > XB_SPIN_CAP) { atomicAdd(&(bar)[XB_TMO], 1u); break; } } } } while (0)
struct XcdBarrier { unsigned* bar; unsigned x; volatile LAS unsigned* st; };
__device__ __forceinline__ XcdBarrier xcd_barrier_post(unsigned* bar, volatile LAS unsigned* st) {
    XcdBarrier b; b.bar = bar; b.x = xb_xcc_id(); b.st = st;
    if (threadIdx.x == 0) (void)xb_add(&bar[XB_XCNT(b.x)], 1u);
    return b;
}
__device__ __forceinline__ void xcd_barrier_complete(unsigned* bar, unsigned x, unsigned& nloc, unsigned& nx) {
    const unsigned G = gridDim.x * gridDim.y * gridDim.z;
    unsigned sum, cnt, mine, sp = 0u;
    for (;;) {
        sum = 0u; cnt = 0u; mine = 0u;
#pragma unroll
        for (unsigned j = 0; j < 16; ++j) { const unsigned c = xb_ld(&bar[XB_XCNT(j)]); sum += c; cnt += (c > 0u) ? 1u : 0u; mine = (j == x) ? c : mine; }
        if (sum == G) break;
        __builtin_amdgcn_s_sleep(1);
        if ((++sp & 255u) == 0u) { if (xb_ld(&bar[XB_TMO])) break; if (sp > XB_SPIN_CAP) { atomicAdd(&bar[XB_TMO], 1u); break; } }
    }
    nloc = mine > 0u ? mine : 1u; nx = cnt > 0u ? cnt : 1u;
}
__device__ __forceinline__ void xcd_barrier(const XcdBarrier& b) {
    asm volatile("s_waitcnt vmcnt(0)" ::: "memory");
    __syncthreads();
    if (threadIdx.x == 0) {
        unsigned* bar = b.bar;
        __builtin_amdgcn_s_waitcnt(0);
        unsigned nloc = b.st[0], nx = b.st[1];
        if (nloc == 0u) { xcd_barrier_complete(bar, b.x, nloc, nx); b.st[0] = nloc; b.st[1] = nx; }
        const unsigned old = xb_add(&bar[XB_XSUB(b.x)], 1u);
        const unsigned gen = old / nloc;
        if (old + 1u == (gen + 1u) * nloc) {
            __builtin_amdgcn_fence(__ATOMIC_RELEASE, "agent");
            asm volatile("s_waitcnt vmcnt(0)" ::: "memory");
            const unsigned og = xb_add(&bar[XB_TOP], 1u);
            const unsigned tg = og / nx;
            if (og + 1u == (tg + 1u) * nx) xb_add(&bar[XB_TOPGEN], 1u);
            else XB_SPIN(xb_ld(&bar[XB_TOPGEN]) == tg, bar);
            __builtin_amdgcn_fence(__ATOMIC_ACQUIRE, "agent");
            xb_add(&bar[XB_XGEN(b.x)], 1u);
            asm volatile("s_waitcnt vmcnt(0)" ::: "memory");
        } else {
            XB_SPIN(xb_ld(&bar[XB_XGEN(b.x)]) == gen, bar);
            __builtin_amdgcn_fence(__ATOMIC_ACQUIRE, "agent");
            asm volatile("s_waitcnt vmcnt(0)" ::: "memory");
        }
    }
    __syncthreads();
}

struct Args {
    const float *x_prompt, *x_sample, *cache_win_k, *cache_win_v, *state_pool, *cache_mem_k, *cache_mem_v, *mem_prompt;
    const float *g_mix, *w_in, *attn_sinks, *w_pool, *pool_scale, *w_out, *g_cross, *g_mem, *w_cq, *w_ck, *w_cv, *w_co, *g_ffn, *w_up, *w_down, *g_final;
    float* out; unsigned char* ws; int ph_lo, ph_hi;
};

namespace pg8 {
constexpr int BM = 256, BK = 64, HALF = 128, HTB = HALF * BK * 2, STAGE_BYTES = 8 * HTB, NXCD = 8, WGM = 8;
__host__ __device__ __forceinline__ int lds_byte(int r, int c) { const int st = (r >> 4) * 2 + (c >> 5), rr = r & 15, cc = c & 31, ob = rr * 64 + cc * 2; return st * 1024 + (ob ^ (((ob >> 9) & 1) << 5)); }
__host__ __device__ __forceinline__ void stage_rc(int b, int& R, int& C) { const int st = b / 1024, sb = b % 1024, swz = sb ^ (((sb >> 9) & 1) << 5); R = (st >> 1) * 16 + swz / 64; C = (st & 1) * 32 + (swz % 64) / 2; }
__host__ __device__ __forceinline__ int perm32(int rho) { const int n = rho >> 4, i = rho & 15; return 8 * (i >> 2) + 4 * n + (i & 3); }

struct Unit { const char* a; const char* b; int pm, pn, kind; };
struct Seg { const bf16_t* A; const bf16_t* B; int nM, nN, kind; };
template <int NSEG> struct SegOrder {
    Seg s[NSEG]; int G, c; size_t pa, pb;
    __device__ __forceinline__ bool next(int i, Unit& u) const {
        long L = (long)i * G + c;
#pragma unroll
        for (int k = 0; k < NSEG; ++k) {
            const int nM = s[k].nM, nN = s[k].nN, nwg = nM * nN;
            if (L < nwg) {
                int wgid = (int)L; { const int q = nwg / NXCD, r = nwg % NXCD, xcd = wgid % NXCD, off = wgid / NXCD; wgid = (xcd < r ? xcd * (q + 1) : r * (q + 1) + (xcd - r) * q) + off; }
                const int nig = WGM * nN, gid = wgid / nig, fm = gid * WGM, gsz = (nM - fm) < WGM ? (nM - fm) : WGM;
                u.pm = fm + ((wgid % nig) % gsz); u.pn = (wgid % nig) / gsz; u.kind = s[k].kind;
                u.a = (const char*)s[k].A + (size_t)u.pm * pa; u.b = (const char*)s[k].B + (size_t)u.pn * pb; return true;
            }
            L -= nwg;
        }
        return false;
    }
};
__device__ __forceinline__ unsigned cvt_pk_bf16(float lo, float hi) { unsigned r; asm volatile("v_cvt_pk_bf16_f32 %0, %1, %2" : "=v"(r) : "v"(lo), "v"(hi)); return r; }
__device__ __forceinline__ u32x4 pack8(const f32x4 v0, const f32x4 v1) { u32x4 w; w.x = cvt_pk_bf16(v0[0], v0[1]); w.y = cvt_pk_bf16(v0[2], v0[3]); w.z = cvt_pk_bf16(v1[0], v1[1]); w.w = cvt_pk_bf16(v1[2], v1[3]); return w; }

template <class Epi, class Sched, bool ALIGN_EPI, bool SP2>
__device__ __forceinline__ void gemm_phase(LAS unsigned char* lds, const int lda, const int ldb, const int K, const Sched& S, const Epi& E) {
    int tid_ = threadIdx.x; asm volatile("" : "+v"(tid_));
    const int tid = tid_, wid = __builtin_amdgcn_readfirstlane(tid >> 6), lane = tid & 63, wr = wid >> 2, wc = wid & 3, fr = lane & 15, fq = lane >> 4;
    const int nt = K / BK;
    unsigned voffA[2], voffB[2];
#pragma unroll
    for (int i = 0; i < 2; ++i) { int R, C; stage_rc(tid * 16 + i * 8192, R, C); const int Rb = Epi::PERM ? ((R & ~31) + perm32(R & 31)) : R;
        voffA[i] = (unsigned)(R * lda + C) * 2u; voffB[i] = (unsigned)(Rb * ldb + C) * 2u; }
    const size_t kstep = (size_t)(BK * 2);
    const size_t hstepA = (size_t)HALF * lda * 2, hstepB = (size_t)HALF * ldb * 2;
    const unsigned ldsw = (unsigned)wid * 1024u;
    const int aoff = lds_byte(wr * 64 + fr, fq * 8), boff = lds_byte(wc * 32 + fr, fq * 8);
#define PG8_SA(b, h) (((b) * 2 + (h)) * HTB)
#define PG8_SB(b, h) ((4 + (b) * 2 + (h)) * HTB)
#define PG8_STAGE(bufoff, gbase, voff) do { _Pragma("unroll") for (int _i = 0; _i < 2; ++_i) \
        __builtin_amdgcn_global_load_lds((const unsigned*)((const char*)(gbase) + (voff)[_i]), (LAS unsigned*)(lds + (bufoff) + ldsw + _i * 8192), 16, 0, 0); } while (0)
#define PG8_LDA(dst, b, h) do { _Pragma("unroll") for (int m = 0; m < 4; ++m) _Pragma("unroll") for (int k = 0; k < 2; ++k) dst[m][k] = *(const LAS bf16x8*)(lds + PG8_SA(b, h) + aoff + m * 2048 + k * 1024); } while (0)
#define PG8_LDB(dst, b, h) do { _Pragma("unroll") for (int n = 0; n < 2; ++n) _Pragma("unroll") for (int k = 0; k < 2; ++k) dst[n][k] = *(const LAS bf16x8*)(lds + PG8_SB(b, h) + boff + n * 2048 + k * 1024); } while (0)
#define PG8_MMA(ai, bj, At, Bt) do { __builtin_amdgcn_s_setprio(1); _Pragma("unroll") for (int m = 0; m < 4; ++m) _Pragma("unroll") for (int n = 0; n < 2; ++n) _Pragma("unroll") for (int k = 0; k < 2; ++k) \
        acc[ai][bj][m][n] = __builtin_amdgcn_mfma_f32_16x16x32_bf16(Bt[n][k], At[m][k], acc[ai][bj][m][n], 0, 0, 0); __builtin_amdgcn_s_setprio(0); } while (0)
#define PG8_WAIT_V(n) asm volatile("s_waitcnt vmcnt(" #n ")" ::: "memory")
#define PG8_WAIT_L(n) asm volatile("s_waitcnt lgkmcnt(" #n ")" ::: "memory")
#define PG8_BAR __builtin_amdgcn_s_barrier()
#define PG8_SCHED __builtin_amdgcn_sched_barrier(0)
    Unit cur, nxt; int ui = 0;
    if (!S.next(0, cur)) return;
    f32x4 acc[2][2][4][2];
#pragma unroll
    for (int a = 0; a < 2; ++a)
#pragma unroll
        for (int b = 0; b < 2; ++b)
#pragma unroll
            for (int m = 0; m < 4; ++m)
#pragma unroll
                for (int n = 0; n < 2; ++n) acc[a][b][m][n] = (f32x4){0.f, 0.f, 0.f, 0.f};
    bf16x8 At[4][2], B0[2][2], B1[2][2];
    const char* cA = cur.a; const char* cB = cur.b;
    if constexpr (SP2) {
        PG8_STAGE(PG8_SB(0, 0), cB, voffB); PG8_STAGE(PG8_SB(0, 1), cB + hstepB, voffB); PG8_STAGE(PG8_SA(0, 0), cA, voffA); PG8_STAGE(PG8_SA(0, 1), cA + hstepA, voffA);
        if (wr == 1) PG8_BAR;
        PG8_WAIT_V(2); PG8_BAR;
        PG8_STAGE(PG8_SB(1, 0), cB + kstep, voffB); PG8_STAGE(PG8_SA(1, 0), cA + kstep, voffA); PG8_STAGE(PG8_SB(1, 1), cB + hstepB + kstep, voffB);
        PG8_WAIT_V(6); PG8_BAR;
    } else {
        PG8_STAGE(PG8_SB(0, 0), cB, voffB); PG8_STAGE(PG8_SA(0, 0), cA, voffA); PG8_STAGE(PG8_SB(0, 1), cB + hstepB, voffB); PG8_STAGE(PG8_SA(0, 1), cA + hstepA, voffA);
        if (wr == 1) PG8_BAR;
        PG8_WAIT_V(4); PG8_BAR;
        PG8_STAGE(PG8_SB(1, 0), cB + kstep, voffB); PG8_STAGE(PG8_SA(1, 0), cA + kstep, voffA); PG8_STAGE(PG8_SB(1, 1), cB + hstepB + kstep, voffB);
        PG8_WAIT_V(6); PG8_BAR;
    }
    for (;;) {
        const bool has_next = S.next(ui + 1, nxt);
        const char* nA = has_next ? nxt.a : cA; const char* nB = has_next ? nxt.b : cB;
        for (int t = 0; t < nt; t += 2) {
            const bool last = (t == nt - 2);
            const char* a1 = cA + (size_t)(t + 1) * kstep;
            const char* a2 = last ? nA : cA + (size_t)(t + 2) * kstep; const char* b2 = last ? nB : cB + (size_t)(t + 2) * kstep;
            const char* a3 = a2 + kstep; const char* b3 = b2 + kstep;
            if constexpr (SP2) {
            PG8_LDB(B0, 0, 0); PG8_LDB(B1, 0, 1); PG8_SCHED; PG8_LDA(At, 0, 0); PG8_STAGE(PG8_SA(1, 1), a1 + hstepA, voffA);
            PG8_WAIT_V(8); PG8_WAIT_L(0); PG8_BAR; PG8_MMA(0, 0, At, B0); PG8_MMA(0, 1, At, B1); PG8_BAR; PG8_SCHED;
            PG8_LDA(At, 0, 1); PG8_STAGE(PG8_SB(0, 0), b2, voffB); PG8_STAGE(PG8_SB(0, 1), b2 + hstepB, voffB); PG8_STAGE(PG8_SA(0, 0), a2, voffA);
            PG8_WAIT_V(8); PG8_WAIT_L(0); PG8_BAR; PG8_MMA(1, 0, At, B0); PG8_MMA(1, 1, At, B1); PG8_BAR; PG8_SCHED;
            PG8_LDB(B0, 1, 0); PG8_LDB(B1, 1, 1); PG8_SCHED; PG8_LDA(At, 1, 0); PG8_STAGE(PG8_SA(0, 1), a2 + hstepA, voffA);
            PG8_WAIT_V(8); PG8_WAIT_L(0); PG8_BAR; PG8_MMA(0, 0, At, B0); PG8_MMA(0, 1, At, B1); PG8_BAR; PG8_SCHED;
            PG8_LDA(At, 1, 1); PG8_STAGE(PG8_SB(1, 0), b3, voffB); PG8_STAGE(PG8_SB(1, 1), b3 + hstepB, voffB); PG8_STAGE(PG8_SA(1, 0), a3, voffA);
            PG8_WAIT_V(8); PG8_WAIT_L(0); PG8_BAR; PG8_MMA(1, 0, At, B0); PG8_MMA(1, 1, At, B1); PG8_BAR; PG8_SCHED;
            } else {
            PG8_LDB(B0, 0, 0); PG8_SCHED; PG8_LDA(At, 0, 0); PG8_STAGE(PG8_SA(1, 1), a1 + hstepA, voffA);
            PG8_WAIT_L(8); PG8_BAR; PG8_WAIT_L(0); PG8_MMA(0, 0, At, B0); PG8_BAR; PG8_SCHED;
            PG8_LDB(B1, 0, 1); PG8_STAGE(PG8_SB(0, 0), b2, voffB);
            PG8_BAR; PG8_WAIT_L(0); PG8_MMA(0, 1, At, B1); PG8_BAR;
            PG8_LDA(At, 0, 1); PG8_STAGE(PG8_SA(0, 0), a2, voffA);
            PG8_BAR; PG8_WAIT_L(0); PG8_MMA(1, 0, At, B0); PG8_BAR; PG8_SCHED;
            PG8_STAGE(PG8_SB(0, 1), b2 + hstepB, voffB);
            PG8_WAIT_V(6); PG8_BAR; PG8_MMA(1, 1, At, B1); PG8_BAR;
            PG8_LDB(B0, 1, 0); PG8_SCHED; PG8_LDA(At, 1, 0); PG8_STAGE(PG8_SA(0, 1), a2 + hstepA, voffA);
            PG8_WAIT_L(8); PG8_BAR; PG8_WAIT_L(0); PG8_MMA(0, 0, At, B0); PG8_BAR; PG8_SCHED;
            PG8_LDB(B1, 1, 1); PG8_STAGE(PG8_SB(1, 0), b3, voffB);
            PG8_BAR; PG8_WAIT_L(0); PG8_MMA(0, 1, At, B1); PG8_BAR;
            PG8_LDA(At, 1, 1); PG8_STAGE(PG8_SA(1, 0), a3, voffA);
            PG8_BAR; PG8_WAIT_L(0); PG8_MMA(1, 0, At, B0); PG8_BAR; PG8_SCHED;
            PG8_STAGE(PG8_SB(1, 1), b3 + hstepB, voffB);
            PG8_WAIT_V(6); PG8_BAR; PG8_MMA(1, 1, At, B1); PG8_BAR;
            }
        }
        if constexpr (ALIGN_EPI) { if (wr == 0) PG8_BAR; }
        if constexpr (!Epi::AFTER_DRAIN) { E(acc, cur, wr, wc, fr, fq); }
        if (!has_next) break;
#pragma unroll
        for (int a = 0; a < 2; ++a)
#pragma unroll
            for (int b = 0; b < 2; ++b)
#pragma unroll
                for (int m = 0; m < 4; ++m)
#pragma unroll
                    for (int n = 0; n < 2; ++n) acc[a][b][m][n] = (f32x4){0.f, 0.f, 0.f, 0.f};
        cur = nxt; cA = nA; cB = nB; ++ui;
        if constexpr (ALIGN_EPI) { if (wr == 1) PG8_BAR; }
    }
    PG8_WAIT_V(0);
    if constexpr (!ALIGN_EPI) { if (wr == 0) PG8_BAR; }
    PG8_BAR;
    if constexpr (Epi::AFTER_DRAIN) { E.fused(acc, cur, wr, wc, fr, fq, lds, wid, lane); }
#undef PG8_SA
#undef PG8_SB
#undef PG8_STAGE
#undef PG8_LDA
#undef PG8_LDB
#undef PG8_MMA
#undef PG8_WAIT_V
#undef PG8_WAIT_L
#undef PG8_BAR
#undef PG8_SCHED
}

struct EpiP1 {
    static constexpr bool PERM = true, AFTER_DRAIN = false;
    bf16_t *Q, *Kb, *Vb, *U, *MK, *MV, *MVt; float* out;
    __device__ __forceinline__ void operator()(const f32x4 (&acc)[2][2][4][2], const Unit& u, int wr, int wc, int fr, int fq) const {
        const int cl = wc * 32 + 8 * fq;
        if (u.kind == 0) {
            const bool samp = u.pm >= MP / 256;
#pragma unroll
            for (int ai = 0; ai < 2; ++ai)
#pragma unroll
                for (int m = 0; m < 4; ++m) {
                    const int row = u.pm * 256 + ai * 128 + wr * 64 + m * 16 + fr;
                    int b, t; if (!samp) { b = row / SEQ; t = row % SEQ; } else { b = (row - MP) / DEC_T; t = (row - MP) % DEC_T; }
#pragma unroll
                    for (int bj = 0; bj < 2; ++bj) {
                        const f32x4 v0 = acc[ai][bj][m][0], v1 = acc[ai][bj][m][1];
                        if (u.pn < 2) { const float s = 0.125f * LOG2E; *(u32x4*)(Q + (size_t)row * AW + u.pn * 256 + bj * 128 + cl) = pack8(v0 * s, v1 * s); }
                        else if (u.pn == 2) {
                            *(u32x4*)((bj ? Vb : Kb) + (size_t)row * KVW + cl) = pack8(v0, v1);
                            float* o = nullptr;
                            if (!samp) { if (t >= SEQ - WIN) o = out + (bj ? O_WVP : O_WKP) + ((size_t)b * WIN + (t - (SEQ - WIN))) * KVW + cl; }
                            else o = out + (bj ? O_WVS : O_WKS) + ((size_t)b * WIN + (WIN - DEC_T + t)) * KVW + cl;
                            if (o) { *(f32x4*)o = v0; *(f32x4*)(o + 4) = v1; }
                        } else {
                            const int c = (u.pn - 3) * 256 + bj * 128 + cl;
                            *(u32x4*)(U + (size_t)row * PW + c) = pack8(v0, v1);
                            float* o = nullptr;
                            if (!samp) { if (t >= SEQ - PHIST) o = out + O_PP + ((size_t)b * PHIST + (t - (SEQ - PHIST))) * PW + c; }
                            else o = out + O_PS + ((size_t)b * PHIST + (PHIST - DEC_T + t)) * PW + c;
                            if (o) { *(f32x4*)o = v0; *(f32x4*)(o + 4) = v1; }
                        }
                    }
                }
        } else if (u.kind == 1) {
            const bool isv = u.pn >= 4;
#pragma unroll
            for (int ai = 0; ai < 2; ++ai)
#pragma unroll
                for (int m = 0; m < 4; ++m) {
                    const int row = u.pm * 256 + ai * 128 + wr * 64 + m * 16 + fr;
#pragma unroll
                    for (int bj = 0; bj < 2; ++bj) {
                        const f32x4 v0 = acc[ai][bj][m][0], v1 = acc[ai][bj][m][1];
                        const int c = (u.pn & 3) * 256 + bj * 128 + cl;
                        float* o = out + (isv ? O_MVP : O_MKP) + (size_t)row * D + c; *(f32x4*)o = v0; *(f32x4*)(o + 4) = v1;
                        *(u32x4*)((isv ? MV : MK) + (size_t)row * D + c) = pack8(v0, v1);
                    }
                }
        } else {
#pragma unroll
            for (int ai = 0; ai < 2; ++ai)
#pragma unroll
                for (int m = 0; m < 4; ++m) {
                    const int dd = u.pm * 256 + ai * 128 + wr * 64 + m * 16 + fr;
#pragma unroll
                    for (int bj = 0; bj < 2; ++bj) *(u32x4*)(MVt + ((size_t)u.pn * D + dd) * NMEM + bj * 128 + cl) = pack8(acc[ai][bj][m][0], acc[ai][bj][m][1]);
                }
        }
    }
};
struct EpiResidG {
    static constexpr bool PERM = true, AFTER_DRAIN = false;
    const float* baseP; const float* baseS; float* X; bf16_t* XB; float* rss;
    __device__ __forceinline__ void operator()(const f32x4 (&acc)[2][2][4][2], const Unit& u, int wr, int wc, int fr, int fq) const {
        const float* base = u.pm >= MP / 256 ? baseS : baseP;
        const int col0 = u.pn * 256 + wc * 32 + 8 * fq;
#pragma unroll
        for (int ai = 0; ai < 2; ++ai)
#pragma unroll
            for (int m = 0; m < 4; ++m) {
                const int row = u.pm * 256 + ai * 128 + wr * 64 + m * 16 + fr; float s = 0.f;
#pragma unroll
                for (int bj = 0; bj < 2; ++bj) {
                    const size_t off = (size_t)row * D + col0 + bj * 128;
                    const f32x4 v0 = *(const f32x4*)(base + off) + acc[ai][bj][m][0], v1 = *(const f32x4*)(base + off + 4) + acc[ai][bj][m][1];
                    *(f32x4*)(X + off) = v0; *(f32x4*)(X + off + 4) = v1;
                    if (XB) *(u32x4*)(XB + off) = pack8(v0, v1);
                    s += ((v0[0] * v0[0] + v0[1] * v0[1]) + (v0[2] * v0[2] + v0[3] * v0[3])) + ((v1[0] * v1[0] + v1[1] * v1[1]) + (v1[2] * v1[2] + v1[3] * v1[3]));
                }
                s += __shfl_xor(s, 16); s += __shfl_xor(s, 32);
                if (fq == 0) rss[(size_t)row * 16 + u.pn * 4 + wc] = s;
            }
    }
};
template <int ACT>
struct EpiRowScaleG {
    static constexpr bool PERM = true, AFTER_DRAIN = false;
    bf16_t* O; int ldo; const float* rss; float scale;
    __device__ __forceinline__ void operator()(const f32x4 (&acc)[2][2][4][2], const Unit& u, int wr, int wc, int fr, int fq) const {
        const int col0 = u.pn * 256 + wc * 32 + 8 * fq;
#pragma unroll
        for (int ai = 0; ai < 2; ++ai)
#pragma unroll
            for (int m = 0; m < 4; ++m) {
                const int row = u.pm * 256 + ai * 128 + wr * 64 + m * 16 + fr;
                const float rs = rstd_from_slots(rss, row);
#pragma unroll
                for (int bj = 0; bj < 2; ++bj) {
                    f32x4 v0 = acc[ai][bj][m][0] * rs, v1 = acc[ai][bj][m][1] * rs;
                    if (ACT == 1) {
#pragma unroll
                        for (int e = 0; e < 4; ++e) { const float r0 = fmaxf(v0[e], 0.f), r1 = fmaxf(v1[e], 0.f); v0[e] = r0 * r0; v1[e] = r1 * r1; }
                    }
                    *(u32x4*)(O + (size_t)row * ldo + col0 + bj * 128) = pack8(v0 * scale, v1 * scale);
                }
            }
    }
};

struct OneUnit { Unit u; __device__ __forceinline__ bool next(int i, Unit& o) const { if (i != 0) return false; o = u; return true; } };
struct EpiSoftmaxP {
    static constexpr bool PERM = true, AFTER_DRAIN = true;
    bf16_t* P;
    __device__ __forceinline__ void fused(f32x4 (&acc)[2][2][4][2], const Unit& u, int wr, int wc, int fr, int fq, LAS unsigned char* lds, int wid, int lane) const {
        LAS float* Pm = (LAS float*)lds; LAS float* Ps = Pm + 1024;
#pragma unroll
        for (int ai = 0; ai < 2; ++ai)
#pragma unroll
            for (int m = 0; m < 4; ++m) {
                float mx = -3.0e38f;
#pragma unroll
                for (int bj = 0; bj < 2; ++bj)
#pragma unroll
                    for (int n = 0; n < 2; ++n) { const f32x4 x = acc[ai][bj][m][n]; mx = fmaxf(mx, fmaxf(fmaxf(x[0], x[1]), fmaxf(x[2], x[3]))); }
                mx = fmaxf(mx, __shfl_xor(mx, 16)); mx = fmaxf(mx, __shfl_xor(mx, 32));
                if (fq == 0) Pm[(ai * 128 + wr * 64 + m * 16 + fr) * 4 + wc] = mx;
            }
        asm volatile("s_waitcnt lgkmcnt(0)" ::: "memory"); __builtin_amdgcn_s_barrier(); asm volatile("" ::: "memory");
#pragma unroll
        for (int ai = 0; ai < 2; ++ai)
#pragma unroll
            for (int m = 0; m < 4; ++m) {
                const int rl = ai * 128 + wr * 64 + m * 16 + fr;
                const f32x4 pm4 = *(const LAS f32x4*)(Pm + rl * 4); const float mr = fmaxf(fmaxf(pm4[0], pm4[1]), fmaxf(pm4[2], pm4[3]));
                float s = 0.f;
#pragma unroll
                for (int bj = 0; bj < 2; ++bj)
#pragma unroll
                    for (int n = 0; n < 2; ++n) { f32x4 x = acc[ai][bj][m][n];
#pragma unroll
                        for (int e = 0; e < 4; ++e) { x[e] = __builtin_amdgcn_exp2f(x[e] - mr); s += x[e]; }
                        acc[ai][bj][m][n] = x; }
                s += __shfl_xor(s, 16); s += __shfl_xor(s, 32);
                if (fq == 0) Ps[rl * 4 + wc] = s;
            }
        asm volatile("s_waitcnt lgkmcnt(0)" ::: "memory"); __builtin_amdgcn_s_barrier(); asm volatile("" ::: "memory");
#pragma unroll
        for (int ai = 0; ai < 2; ++ai)
#pragma unroll
            for (int m = 0; m < 4; ++m) {
                const int rl = ai * 128 + wr * 64 + m * 16 + fr;
                const f32x4 ps4 = *(const LAS f32x4*)(Ps + rl * 4); const float inv = 1.0f / ((ps4[0] + ps4[1]) + (ps4[2] + ps4[3]));
#pragma unroll
                for (int bj = 0; bj < 2; ++bj)
                    *(u32x4*)(P + (size_t)(u.pm * 256 + rl) * D + u.pn * 256 + bj * 128 + wc * 32 + 8 * fq) = pack8(acc[ai][bj][m][0] * inv, acc[ai][bj][m][1] * inv);
            }
    }
};
struct EpiStoreBf16 {
    static constexpr bool PERM = true, AFTER_DRAIN = false;
    bf16_t* O;
    __device__ __forceinline__ void operator()(const f32x4 (&acc)[2][2][4][2], const Unit& u, int wr, int wc, int fr, int fq) const {
#pragma unroll
        for (int ai = 0; ai < 2; ++ai)
#pragma unroll
            for (int m = 0; m < 4; ++m) {
                const int row = u.pm * 256 + ai * 128 + wr * 64 + m * 16 + fr;
#pragma unroll
                for (int bj = 0; bj < 2; ++bj) *(u32x4*)(O + (size_t)row * D + u.pn * 256 + bj * 128 + wc * 32 + 8 * fq) = pack8(acc[ai][bj][m][0], acc[ai][bj][m][1]);
            }
    }
};
}


template <class Epi>
__device__ __forceinline__ void gemm_mini(const bf16_t* __restrict__ A, int lda, const bf16_t* __restrict__ Bt, int ldb, int Mr, int N, int K, LAS unsigned char* lds, const Epi& epi) {
    int tid_ = threadIdx.x; asm volatile("" : "+v"(tid_));
    const int tid = tid_, lane = tid & 63, wid = __builtin_amdgcn_readfirstlane(tid >> 6), fr = lane & 15, fq = lane >> 4;
    const int tn_n = N / 64, ntiles = (Mr / 64) * tn_n, ks = K / 8;
    LAS float* red = (LAS float*)lds;
    for (int t = blockIdx.x; t < ntiles; t += gridDim.x) {
        const int tm = t / tn_n, tn = t % tn_n, r0 = tm * 64, c0 = tn * 64;
        f32x4 acc[4][4];
#pragma unroll
        for (int i = 0; i < 4; ++i)
#pragma unroll
            for (int j = 0; j < 4; ++j) acc[i][j] = (f32x4){0.f, 0.f, 0.f, 0.f};
        const bf16_t* ap = A + (size_t)(r0 + fr) * lda + wid * ks + fq * 8;
        const bf16_t* bp = Bt + (size_t)(c0 + fr) * ldb + wid * ks + fq * 8;
#pragma unroll 4
        for (int k0 = 0; k0 < ks; k0 += 32) {
            bf16x8 a[4], b[4];
#pragma unroll
            for (int i = 0; i < 4; ++i) a[i] = *(const bf16x8*)(ap + (size_t)(i * 16) * lda + k0);
#pragma unroll
            for (int j = 0; j < 4; ++j) b[j] = *(const bf16x8*)(bp + (size_t)(j * 16) * ldb + k0);
#pragma unroll
            for (int i = 0; i < 4; ++i)
#pragma unroll
                for (int j = 0; j < 4; ++j) acc[i][j] = __builtin_amdgcn_mfma_f32_16x16x32_bf16(b[j], a[i], acc[i][j], 0, 0, 0);
        }
#pragma unroll
        for (int i = 0; i < 4; ++i)
#pragma unroll
            for (int j = 0; j < 4; ++j) *(LAS f32x4*)(red + (wid * 64 + 16 * i + fr) * 68 + 16 * j + 4 * fq) = acc[i][j];
        __syncthreads();
        const int row = tid >> 3, c8 = (tid & 7) * 8;
        f32x4 v0 = (f32x4){0.f, 0.f, 0.f, 0.f}, v1 = v0;
#pragma unroll
        for (int w = 0; w < 8; ++w) { v0 += *(const LAS f32x4*)(red + (w * 64 + row) * 68 + c8); v1 += *(const LAS f32x4*)(red + (w * 64 + row) * 68 + c8 + 4); }
        epi(r0 + row, c0 + c8, v0, v1, tn);
        __syncthreads();
    }
}
struct MiniResid {
    const float* base; float* X; bf16_t* XB; float* rss;
    __device__ __forceinline__ void operator()(int row, int col, f32x4 v0, f32x4 v1, int tn) const {
        const size_t off = (size_t)row * D + col;
        v0 += *(const f32x4*)(base + off); v1 += *(const f32x4*)(base + off + 4);
        *(f32x4*)(X + off) = v0; *(f32x4*)(X + off + 4) = v1;
        if (XB) *(u32x4*)(XB + off) = pg8::pack8(v0, v1);
        float s = ((v0[0] * v0[0] + v0[1] * v0[1]) + (v0[2] * v0[2] + v0[3] * v0[3])) + ((v1[0] * v1[0] + v1[1] * v1[1]) + (v1[2] * v1[2] + v1[3] * v1[3]));
        s += __shfl_xor(s, 1); s += __shfl_xor(s, 2); s += __shfl_xor(s, 4);
        if ((threadIdx.x & 7) == 0) rss[(size_t)row * 16 + tn] = s;
    }
};
template <int ACT> struct MiniRowScale {
    bf16_t* O; int ldo; const float* rss; float scale;
    __device__ __forceinline__ void operator()(int row, int col, f32x4 v0, f32x4 v1, int) const {
        const float rs = rstd_from_slots(rss, row); v0 = v0 * rs; v1 = v1 * rs;
        if (ACT == 1) {
#pragma unroll
            for (int e = 0; e < 4; ++e) { const float r0 = fmaxf(v0[e], 0.f), r1 = fmaxf(v1[e], 0.f); v0[e] = r0 * r0; v1[e] = r1 * r1; }
        }
        *(u32x4*)(O + (size_t)row * ldo + col) = pg8::pack8(v0 * scale, v1 * scale);
    }
};

__device__ __forceinline__ void p0_transpose_item(const float* __restrict__ W, const float* __restrict__ g, int N, bf16_t* WT, int ldk, LAS float* scr, int item, int lane) {
    const int nblk = N / 32, kb = item / nblk, nb = item % nblk, k0 = 64 * kb, n0 = 32 * nb;
    float wv[32];
#pragma unroll
    for (int i = 0; i < 32; ++i) wv[i] = W[(size_t)(k0 + 2 * i + (lane >> 5)) * N + n0 + (lane & 31)];
#pragma unroll
    for (int i = 0; i < 32; ++i) { const int kk = 2 * i + (lane >> 5); scr[kk * 33 + (lane & 31)] = wv[i] * (g ? g[k0 + kk] : 1.0f); }
    asm volatile("s_waitcnt lgkmcnt(0)" ::: "memory");
    const int c = lane & 7;
#pragma unroll
    for (int j = 0; j < 4; ++j) { const int n = (lane >> 3) + 8 * j; const LAS float* s = scr + (8 * c) * 33 + n;
        u32x4 o; o.x = pk2(s[0 * 33], s[1 * 33]); o.y = pk2(s[2 * 33], s[3 * 33]); o.z = pk2(s[4 * 33], s[5 * 33]); o.w = pk2(s[6 * 33], s[7 * 33]);
        *(u32x4*)(WT + (size_t)(n0 + n) * ldk + k0 + 8 * c) = o; }
    asm volatile("s_waitcnt lgkmcnt(0)" ::: "memory");
}
__device__ __forceinline__ void norm_rows(const float* __restrict__ X, bf16_t* O, int rows, int gw, int NGW, int lane) {
    for (int r = gw; r < rows; r += 2 * NGW) {
        const int r2 = r + NGW < rows ? r + NGW : r;
        const f32x4* xa = (const f32x4*)(X + (size_t)r * D) + lane; const f32x4* xb = (const f32x4*)(X + (size_t)r2 * D) + lane; f32x4 va[4], vb[4]; float sa = 0.f, sb = 0.f;
#pragma unroll
        for (int j = 0; j < 4; ++j) { va[j] = xa[64 * j]; vb[j] = xb[64 * j]; }
#pragma unroll
        for (int j = 0; j < 4; ++j) { sa += (va[j][0] * va[j][0] + va[j][1] * va[j][1]) + (va[j][2] * va[j][2] + va[j][3] * va[j][3]); sb += (vb[j][0] * vb[j][0] + vb[j][1] * vb[j][1]) + (vb[j][2] * vb[j][2] + vb[j][3] * vb[j][3]); }
        const float ra = rsqrtf(wave_sum(sa) * (1.f / D) + EPS), rb = rsqrtf(wave_sum(sb) * (1.f / D) + EPS);
        u32x2* oa = (u32x2*)(O + (size_t)r * D) + lane; u32x2* ob = (u32x2*)(O + (size_t)r2 * D) + lane;
#pragma unroll
        for (int j = 0; j < 4; ++j) { oa[64 * j] = (u32x2){pk2(va[j][0] * ra, va[j][1] * ra), pk2(va[j][2] * ra, va[j][3] * ra)}; ob[64 * j] = (u32x2){pk2(vb[j][0] * rb, vb[j][1] * rb), pk2(vb[j][2] * rb, vb[j][3] * rb)}; }
    }
}


__device__ __forceinline__ void cross_sample_pair(const float* __restrict__ mk, const float* __restrict__ mv, const bf16_t* __restrict__ CQ, bf16_t* OC, int task0, int ntask, LAS unsigned char* lds) {
    int tid_ = threadIdx.x; asm volatile("" : "+v"(tid_));
    const int tid = tid_, lane = tid & 63, wave = __builtin_amdgcn_readfirstlane(tid >> 6), tk = wave >> 2, mq = wave & 3;
    const int task = task0 + tk; const bool live = task < ntask;
    const int b = (live ? task : 0) / NCH, h = (live ? task : 0) % NCH;
    const int t16 = lane & 15, dq = lane >> 4;
    LAS float* pl = (LAS float*)(lds + wave * 2048);
    LAS float* op = (LAS float*)(lds + 16384 + (tk * 4 + mq) * 8192);
    LAS float* st = (LAS float*)(lds + 81920);
    if (live) {
        bf16x8 qf[8];
#pragma unroll
        for (int ds = 0; ds < 8; ++ds) {
            u32x4 w = (u32x4){0u, 0u, 0u, 0u};
            if (t16 < DEC_T) w = *(const u32x4*)(CQ + (size_t)(MP + b * DEC_T + t16) * D + h * CHD + ds * 32 + dq * 8);
            qf[ds] = __builtin_bit_cast(bf16x8, w);
        }
        f32x4 s[4];
        const float* kb = mk + (((size_t)b * NMEM + mq * 64 + t16) * NCH + h) * CHD + dq * 8;
#pragma unroll
        for (int mt = 0; mt < 4; ++mt) {
            f32x4 kv[16];
#pragma unroll
            for (int ds = 0; ds < 8; ++ds) { const float* p = kb + (size_t)(mt * 16) * NCH * CHD + ds * 32; kv[2 * ds] = *(const f32x4*)p; kv[2 * ds + 1] = *(const f32x4*)(p + 4); }
            f32x4 acc = (f32x4){0.f, 0.f, 0.f, 0.f};
#pragma unroll
            for (int ds = 0; ds < 8; ++ds) acc = __builtin_amdgcn_mfma_f32_16x16x32_bf16(__builtin_bit_cast(bf16x8, pg8::pack8(kv[2 * ds], kv[2 * ds + 1])), qf[ds], acc, 0, 0, 0);
            s[mt] = acc;
        }
        float mx = -3.0e38f;
#pragma unroll
        for (int mt = 0; mt < 4; ++mt) mx = fmaxf(mx, fmaxf(fmaxf(s[mt][0], s[mt][1]), fmaxf(s[mt][2], s[mt][3])));
        mx = fmaxf(mx, __shfl_xor(mx, 16)); mx = fmaxf(mx, __shfl_xor(mx, 32));
        float sum = 0.f;
#pragma unroll
        for (int mt = 0; mt < 4; ++mt)
#pragma unroll
            for (int e = 0; e < 4; ++e) { const float p = __builtin_amdgcn_exp2f(s[mt][e] - mx); sum += p; if (t16 < DEC_T) pl[(mt * 16 + dq * 4 + e) * 8 + t16] = p; }
        sum += __shfl_xor(sum, 16); sum += __shfl_xor(sum, 32);
        if (lane < DEC_T) { st[((tk * 4 + mq) * 8 + lane) * 2] = mx; st[((tk * 4 + mq) * 8 + lane) * 2 + 1] = sum; }
        asm volatile("s_waitcnt lgkmcnt(0)" ::: "memory");
        f32x4 o[8];
#pragma unroll
        for (int t = 0; t < 8; ++t) o[t] = (f32x4){0.f, 0.f, 0.f, 0.f};
        const float* vb = mv + (((size_t)b * NMEM + mq * 64) * NCH + h) * CHD + lane * 4;
#pragma unroll 8
        for (int ml = 0; ml < 64; ++ml) {
            const f32x4 v = *(const f32x4*)(vb + (size_t)ml * NCH * CHD);
            const f32x4 p0 = *(const LAS f32x4*)(pl + ml * 8), p1 = *(const LAS f32x4*)(pl + ml * 8 + 4);
            o[0] += v * p0[0]; o[1] += v * p0[1]; o[2] += v * p0[2]; o[3] += v * p0[3];
            o[4] += v * p1[0]; o[5] += v * p1[1]; o[6] += v * p1[2]; o[7] += v * p1[3];
        }
#pragma unroll
        for (int t = 0; t < 8; ++t) *(LAS f32x4*)(op + t * 256 + lane * 4) = o[t];
    }
    __syncthreads();
    if (live) {
#pragma unroll
        for (int tt = 0; tt < 2; ++tt) {
            const int t = 2 * mq + tt; float m4[4], l4[4]; float M4 = -3.0e38f;
#pragma unroll
            for (int q = 0; q < 4; ++q) { m4[q] = st[((tk * 4 + q) * 8 + t) * 2]; l4[q] = st[((tk * 4 + q) * 8 + t) * 2 + 1]; M4 = fmaxf(M4, m4[q]); }
            float Ls = 0.f; f32x4 o = (f32x4){0.f, 0.f, 0.f, 0.f};
#pragma unroll
            for (int q = 0; q < 4; ++q) { const float f = __builtin_amdgcn_exp2f(m4[q] - M4); Ls += l4[q] * f; o += *(const LAS f32x4*)((LAS float*)(lds + 16384 + (tk * 4 + q) * 8192) + t * 256 + lane * 4) * f; }
            const float il = 1.0f / Ls;
            *(u32x2*)(OC + (size_t)(MP + b * DEC_T + t) * D + h * CHD + lane * 4) = (u32x2){pg8::cvt_pk_bf16(o[0] * il, o[1] * il), pg8::cvt_pk_bf16(o[2] * il, o[3] * il)};
        }
    }
    __syncthreads();
}


typedef float f32x16 __attribute__((ext_vector_type(16)));
typedef short v4i16_t __attribute__((ext_vector_type(4)));
__device__ __forceinline__ int crow(int r, int hi) { return (r & 3) + 8 * (r >> 2) + 4 * hi; }
__device__ __forceinline__ void win_attn_unit(const bf16_t* __restrict__ Qb, const bf16_t* __restrict__ Kb, const bf16_t* __restrict__ Vb, bf16_t* A2, const float* __restrict__ sinks, int unit, LAS unsigned char* lds) {
    int tid_ = threadIdx.x; asm volatile("" : "+v"(tid_));
    const int tid = tid_, lane = tid & 63, wid = __builtin_amdgcn_readfirstlane(tid >> 6), r32 = lane & 31, hi = lane >> 5;
    const int jb = unit & 63, kvh = (unit >> 6) & 1, b = unit >> 7;
    const int q0 = jb * 64, kp0 = q0 - 128;
    const size_t rowb = (size_t)b * SEQ;
#pragma unroll
    for (int tt = 0; tt < 3; ++tt) {
        const int kpos = kp0 + tt * 64 + lane, kr = kpos < 0 ? 0 : kpos;
        const u32x4 kx = *(const u32x4*)(Kb + (rowb + kr) * KVW + kvh * HD + wid * 8);
        const u32x4 vx = *(const u32x4*)(Vb + (rowb + kr) * KVW + kvh * HD + wid * 8);
        *(LAS u32x4*)(lds + tt * 8192 + wid * 1024 + lane * 16) = kx;
        *(LAS u32x4*)(lds + 24576 + tt * 8192 + (wid >> 2) * 4096 + (lane >> 4) * 1024 + (lane & 15) * 64 + (wid & 3) * 16) = vx;
    }
    const int g = wid >> 1, sb = wid & 1, h = kvh * 4 + g;
    const bf16_t* Qw = Qb + (rowb + q0 + sb * 32 + r32) * AW + h * HD;
    bf16x8 qr[4];
#pragma unroll
    for (int d0 = 0; d0 < 4; ++d0) qr[d0] = *(const bf16x8*)(Qw + d0 * 16 + hi * 8);
    __syncthreads();
    f32x16 p[3][2];
#pragma unroll
    for (int tt = 0; tt < 3; ++tt) {
        const LAS unsigned char* kb = lds + tt * 8192 + hi * 1024 + r32 * 16;
        f32x16 a0 = {}, a1 = {};
#pragma unroll
        for (int d0 = 0; d0 < 4; ++d0) {
            const bf16x8 b0 = *(const LAS bf16x8*)(kb + d0 * 2048), b1 = *(const LAS bf16x8*)(kb + d0 * 2048 + 512);
            a0 = __builtin_amdgcn_mfma_f32_32x32x16_bf16(b0, qr[d0], a0, 0, 0, 0); a1 = __builtin_amdgcn_mfma_f32_32x32x16_bf16(b1, qr[d0], a1, 0, 0, 0);
        }
        p[tt][0] = a0; p[tt][1] = a1;
    }
    const float slope = __builtin_amdgcn_exp2f(-(float)(h + 1)) * LOG2E, sink = sinks[h] * LOG2E;
    const int qrel = 128 + sb * 32 + r32;
    float mx = sink;
#pragma unroll
    for (int tt = 0; tt < 3; ++tt)
#pragma unroll
        for (int pp = 0; pp < 2; ++pp)
#pragma unroll
            for (int r = 0; r < 16; ++r) {
                const int krel = 64 * tt + 32 * pp + crow(r, hi), dist = qrel - krel;
                const bool valid = dist >= 0 && dist <= WIN && kp0 + krel >= 0;
                const float s = valid ? p[tt][pp][r] - slope * (float)dist : -3.0e38f;
                p[tt][pp][r] = s; mx = fmaxf(mx, s);
            }
    mx = fmaxf(mx, __shfl_xor(mx, 32));
    float l = 0.f;
#pragma unroll
    for (int tt = 0; tt < 3; ++tt)
#pragma unroll
        for (int pp = 0; pp < 2; ++pp)
#pragma unroll
            for (int r = 0; r < 16; ++r) { const float e = __builtin_amdgcn_exp2f(p[tt][pp][r] - mx); p[tt][pp][r] = e; l += e; }
    l += __shfl_xor(l, 32); l += __builtin_amdgcn_exp2f(sink - mx);
    LAS float* wsf = (LAS float*)(lds + 49152 + wid * 256);
    if (hi == 0) wsf[r32] = l;
    f32x16 o[2] = {{}, {}};
    const LAS unsigned char* vp0 = lds + 24576 + ((lane >> 4) & 1) * 32 + (lane & 3) * 8 + (4 * hi + ((lane & 15) >> 2)) * 64;
#pragma unroll
    for (int tt = 0; tt < 3; ++tt)
#pragma unroll
        for (int ks = 0; ks < 4; ++ks) {
            const f32x16& ps = p[tt][ks >> 1]; const int r0 = 8 * (ks & 1);
            u32x4 pw; pw.x = pg8::cvt_pk_bf16(ps[r0], ps[r0 + 1]); pw.y = pg8::cvt_pk_bf16(ps[r0 + 2], ps[r0 + 3]); pw.z = pg8::cvt_pk_bf16(ps[r0 + 4], ps[r0 + 5]); pw.w = pg8::cvt_pk_bf16(ps[r0 + 6], ps[r0 + 7]);
            const bf16x8 pa = __builtin_bit_cast(bf16x8, pw);
#pragma unroll
            for (int d0 = 0; d0 < 2; ++d0) {
                const LAS unsigned char* vp = vp0 + tt * 8192 + d0 * 4096 + ks * 1024;
                const v4i16_t lo = __builtin_amdgcn_ds_read_tr16_b64_v4i16((LAS v4i16_t*)vp), hh = __builtin_amdgcn_ds_read_tr16_b64_v4i16((LAS v4i16_t*)(vp + 512));
                const bf16x8 vf = (bf16x8){lo[0], lo[1], lo[2], lo[3], hh[0], hh[1], hh[2], hh[3]};
                o[d0] = __builtin_amdgcn_mfma_f32_32x32x16_bf16(pa, vf, o[d0], 0, 0, 0);
            }
        }
    asm volatile("s_waitcnt lgkmcnt(0)" ::: "memory");
    LAS bf16_t* stg = (LAS bf16_t*)(lds + 51200 + wid * 4096);
#pragma unroll
    for (int r = 0; r < 16; ++r) {
        const int orow = crow(r, hi); const float il = 1.0f / wsf[orow];
        stg[orow * 64 + r32] = (bf16_t)f2bf(o[0][r] * il); stg[orow * 64 + 32 + r32] = (bf16_t)f2bf(o[1][r] * il);
    }
    asm volatile("s_waitcnt lgkmcnt(0)" ::: "memory");
    bf16_t* Ow = A2 + (rowb + q0 + sb * 32) * D + h * HD;
#pragma unroll
    for (int i = 0; i < 4; ++i) { const int row = i * 8 + (lane >> 3), ch = lane & 7; *(u32x4*)(Ow + (size_t)row * D + ch * 8) = *(const LAS u32x4*)(stg + row * 64 + ch * 8); }
    __syncthreads();
}
__device__ __forceinline__ void win_attn_sample(const bf16_t* __restrict__ Qb, const bf16_t* __restrict__ Kb, const bf16_t* __restrict__ Vb, const float* __restrict__ ck, const float* __restrict__ cv,
                                                bf16_t* A2, const float* __restrict__ sinks, int task, LAS unsigned char* wl, int lane_in) {
    int lane = lane_in; asm volatile("" : "+v"(lane));
    const int b = task >> 1, kvh = task & 1, r32 = lane & 31, hi = lane >> 5, g = r32 >> 3, t = r32 & 7, h = kvh * 4 + g;
    const size_t row = (size_t)MP + b * DEC_T + t;
    bf16x8 qr[4];
#pragma unroll
    for (int d0 = 0; d0 < 4; ++d0) qr[d0] = *(const bf16x8*)(Qb + row * AW + h * HD + d0 * 16 + hi * 8);
    f32x16 p[5];
#pragma unroll
    for (int tile = 0; tile < 5; ++tile) {
        f32x16 acc = {};
        if (tile < 4) {
            const float* kp = ck + ((size_t)b * WIN + tile * 32 + r32) * KVW + kvh * HD + hi * 8;
            f32x4 kv[8];
#pragma unroll
            for (int d0 = 0; d0 < 4; ++d0) { kv[2 * d0] = *(const f32x4*)(kp + d0 * 16); kv[2 * d0 + 1] = *(const f32x4*)(kp + d0 * 16 + 4); }
#pragma unroll
            for (int d0 = 0; d0 < 4; ++d0) acc = __builtin_amdgcn_mfma_f32_32x32x16_bf16(__builtin_bit_cast(bf16x8, pg8::pack8(kv[2 * d0], kv[2 * d0 + 1])), qr[d0], acc, 0, 0, 0);
        } else {
            const int rr = r32 < DEC_T ? r32 : DEC_T - 1;
            const bf16_t* kp = Kb + ((size_t)MP + b * DEC_T + rr) * KVW + kvh * HD + hi * 8;
#pragma unroll
            for (int d0 = 0; d0 < 4; ++d0) acc = __builtin_amdgcn_mfma_f32_32x32x16_bf16(*(const bf16x8*)(kp + d0 * 16), qr[d0], acc, 0, 0, 0);
        }
        p[tile] = acc;
    }
    const float slope = __builtin_amdgcn_exp2f(-(float)(h + 1)) * LOG2E, sink = sinks[h] * LOG2E;
    float mx = sink;
#pragma unroll
    for (int tile = 0; tile < 5; ++tile)
#pragma unroll
        for (int r = 0; r < 16; ++r) {
            const int dist = 128 + t - (32 * tile + crow(r, hi));
            const float s = (dist >= 0 && dist <= WIN) ? p[tile][r] - slope * (float)dist : -3.0e38f;
            p[tile][r] = s; mx = fmaxf(mx, s);
        }
    mx = fmaxf(mx, __shfl_xor(mx, 32));
    float l = 0.f;
#pragma unroll
    for (int tile = 0; tile < 5; ++tile)
#pragma unroll
        for (int r = 0; r < 16; ++r) { const float e = __builtin_amdgcn_exp2f(p[tile][r] - mx); p[tile][r] = e; l += e; }
    l += __shfl_xor(l, 32); l += __builtin_amdgcn_exp2f(sink - mx);
    LAS float* wsf = (LAS float*)wl;
    if (hi == 0) wsf[r32] = l;
    f32x16 o[2] = {{}, {}};
#pragma unroll
    for (int ks = 0; ks < 9; ++ks) {
        const f32x16& ps = p[ks >> 1]; const int r0 = 8 * (ks & 1);
        u32x4 pw; pw.x = pg8::cvt_pk_bf16(ps[r0], ps[r0 + 1]); pw.y = pg8::cvt_pk_bf16(ps[r0 + 2], ps[r0 + 3]); pw.z = pg8::cvt_pk_bf16(ps[r0 + 4], ps[r0 + 5]); pw.w = pg8::cvt_pk_bf16(ps[r0 + 6], ps[r0 + 7]);
        const bf16x8 pa = __builtin_bit_cast(bf16x8, pw);
#pragma unroll
        for (int d0 = 0; d0 < 2; ++d0) {
            bf16x8 vf;
            if (ks < 8) {
                const float* vp = cv + ((size_t)b * WIN + 16 * ks + 4 * hi) * KVW + kvh * HD + d0 * 32 + r32;
                float f[8];
#pragma unroll
                for (int j = 0; j < 8; ++j) f[j] = vp[(size_t)(8 * (j >> 2) + (j & 3)) * KVW];
                u32x4 w; w.x = pg8::cvt_pk_bf16(f[0], f[1]); w.y = pg8::cvt_pk_bf16(f[2], f[3]); w.z = pg8::cvt_pk_bf16(f[4], f[5]); w.w = pg8::cvt_pk_bf16(f[6], f[7]);
                vf = __builtin_bit_cast(bf16x8, w);
            } else {
#pragma unroll
                for (int j = 0; j < 8; ++j) { int nr = 8 * (j >> 2) + 4 * hi + (j & 3); nr = nr < DEC_T ? nr : DEC_T - 1; vf[j] = (short)Vb[((size_t)MP + b * DEC_T + nr) * KVW + kvh * HD + d0 * 32 + r32]; }
            }
            o[d0] = __builtin_amdgcn_mfma_f32_32x32x16_bf16(pa, vf, o[d0], 0, 0, 0);
        }
    }
    asm volatile("s_waitcnt lgkmcnt(0)" ::: "memory");
    LAS bf16_t* stg = (LAS bf16_t*)(wl + 256);
#pragma unroll
    for (int r = 0; r < 16; ++r) {
        const int orow = crow(r, hi); const float il = 1.0f / wsf[orow];
        stg[orow * 64 + r32] = (bf16_t)f2bf(o[0][r] * il); stg[orow * 64 + 32 + r32] = (bf16_t)f2bf(o[1][r] * il);
    }
    asm volatile("s_waitcnt lgkmcnt(0)" ::: "memory");
#pragma unroll
    for (int i = 0; i < 4; ++i) { const int q = i * 8 + (lane >> 3), ch = lane & 7;
        *(u32x4*)(A2 + ((size_t)MP + b * DEC_T + (q & 7)) * D + (kvh * 4 + (q >> 3)) * HD + ch * 8) = *(const LAS u32x4*)(stg + q * 64 + ch * 8); }
    asm volatile("s_waitcnt lgkmcnt(0)" ::: "memory");
}
__device__ __forceinline__ void pool_diff(const bf16_t* __restrict__ Ub, const float* __restrict__ sp, bf16_t* A2, size_t gt, size_t GT) {
    for (size_t task = gt; task < (size_t)M * (PW / 8); task += GT) {
        const int row = (int)(task / (PW / 8)), c0 = (int)(task % (PW / 8)) * 8, w = 2 << (c0 / 128);
        float s[8]; float cur[8];
#pragma unroll
        for (int e = 0; e < 8; ++e) s[e] = 0.f;
        const bool samp = row >= MP; int nb, t, b = 0;
        if (!samp) { t = row % SEQ; nb = t + 1 < w ? t + 1 : w; } else { b = (row - MP) / DEC_T; t = (row - MP) % DEC_T; nb = t + 1 < w ? t + 1 : w; }
        for (int i = 0; i < nb; ++i) { const u32x4 x = *(const u32x4*)(Ub + (size_t)(row - i) * PW + c0);
#pragma unroll
            for (int e = 0; e < 4; ++e) { const float lo = __builtin_bit_cast(float, x[e] << 16), hh = __builtin_bit_cast(float, x[e] & 0xffff0000u); s[2 * e] += lo; s[2 * e + 1] += hh; if (i == 0) { cur[2 * e] = lo; cur[2 * e + 1] = hh; } } }
        float cnt = (float)nb;
        if (samp) { for (int i = nb; i < w; ++i) { const float* p = sp + ((size_t)b * PHIST + (PHIST + t - i)) * PW + c0; const f32x4 x0 = *(const f32x4*)p, x1 = *(const f32x4*)(p + 4);
#pragma unroll
                for (int e = 0; e < 4; ++e) { s[e] += x0[e]; s[4 + e] += x1[e]; } } cnt = (float)w; }
        const float ic = 1.0f / cnt;
        *(u32x4*)(A2 + (size_t)row * D + AW + c0) = (u32x4){pk2(s[0] * ic - cur[0], s[1] * ic - cur[1]), pk2(s[2] * ic - cur[2], s[3] * ic - cur[3]), pk2(s[4] * ic - cur[4], s[5] * ic - cur[5]), pk2(s[6] * ic - cur[6], s[7] * ic - cur[7])};
    }
}

__global__ void __launch_bounds__(NTHREADS, 2) fwd(Args a) {
    extern __shared__ __attribute__((aligned(16))) unsigned char lds[];
    const int G = gridDim.x, bx = blockIdx.x;
    const size_t GT = (size_t)G * NTHREADS; const int NGW = G * NWAVES;
#define LOCAL_IDS int tid_o = threadIdx.x; asm volatile("" : "+v"(tid_o)); const int tid = tid_o, lane = tid & 63, wave = tid >> 6; const size_t gt = (size_t)bx * NTHREADS + tid; const int gw = bx * NWAVES + wave; (void)lane; (void)gt; (void)gw;
    unsigned char* ws = a.ws;
    unsigned* ctl = (unsigned*)(ws + WS_CTL);
    float* rss1 = (float*)(ws + WS_RSS); float* rss2 = (float*)(ws + WS_RSS + RSS_BYTES); float* rss3 = (float*)(ws + WS_RSS + 2 * RSS_BYTES);
    bf16_t* Win_t = (bf16_t*)(ws + WS_WIN); bf16_t* Wckv_t = (bf16_t*)(ws + WS_WCKV); bf16_t* Wo2_t = (bf16_t*)(ws + WS_WO2);
    bf16_t* Wcq_t = (bf16_t*)(ws + WS_WCQ); bf16_t* Wco_t = (bf16_t*)(ws + WS_WCO); bf16_t* Wup_t = (bf16_t*)(ws + WS_WUP); bf16_t* Wdn_t = (bf16_t*)(ws + WS_WDN);
    bf16_t* HM = (bf16_t*)(ws + WS_HM); bf16_t* MK = (bf16_t*)(ws + WS_MK); bf16_t* MV = (bf16_t*)(ws + WS_MV); bf16_t* MVt = (bf16_t*)(ws + WS_MVT);
    LAS unsigned char* L = (LAS unsigned char*)lds;
    bf16_t* WoB_t = (bf16_t*)(ws + WS_WOB); bf16_t* BDm = (bf16_t*)(ws + WS_BD);
    bf16_t* XN0 = (bf16_t*)(ws + WS_XN0); bf16_t* Qb = (bf16_t*)(ws + WS_Q); bf16_t* Kb = (bf16_t*)(ws + WS_K); bf16_t* Vb = (bf16_t*)(ws + WS_V); bf16_t* Ub = (bf16_t*)(ws + WS_U);
    bf16_t* A2 = (bf16_t*)(ws + WS_A2); bf16_t* XB = (bf16_t*)(ws + WS_XB); bf16_t* CQ = (bf16_t*)(ws + WS_CQ); bf16_t* OC = (bf16_t*)(ws + WS_OC); bf16_t* Hb = (bf16_t*)(ws + WS_H);
    float* X = a.out;

    volatile LAS unsigned* MISC = (volatile LAS unsigned*)((LAS unsigned char*)lds + (LDS_BYTES - 256));
    if (threadIdx.x < 32) MISC[threadIdx.x] = 0u;
    __syncthreads();
    XcdBarrier bar; bar.bar = ctl + CW_BAR; bar.x = 0; bar.st = nullptr;
    if (MK_N_LAUNCHES == 1) bar = xcd_barrier_post(ctl + CW_BAR, MISC + 8);
    const int lo = a.ph_lo, hi = a.ph_hi;
#ifndef PHASE_MASK
#define PHASE_MASK 0x3ff
#endif
#define IN(k) (((PHASE_MASK >> (k)) & 1) && lo <= (k) && (k) < hi)
#ifndef REPEAT_MASK
#define REPEAT_MASK 0
#endif
#define REPS(k) for (int rep_ = 0; rep_ < (((REPEAT_MASK >> (k)) & 1) ? 2 : 1); ++rep_)
#define SEAM(k) do { if (IN(k) && IN((k) + 1)) xcd_barrier(bar); } while (0)

    if (IN(0)) {
        LOCAL_IDS
        {
            LAS float* scr = (LAS float*)(L + wave * 16384);
            constexpr int I_IN = (D / 64) * (INW / 32), I_SQ = (D / 64) * (D / 32), I_O = (AW / 64) * (D / 32), I_UP = (D / 64) * (DFF / 32), I_DN = (DFF / 64) * (D / 32);
            constexpr int NITEMS = I_IN + 4 * I_SQ + 2 * I_O + I_UP + I_DN;
            for (int it = gw; it < NITEMS; it += NGW) {
                int r = it;
                if (r < I_UP) { p0_transpose_item(a.w_up, a.g_ffn, DFF, Wup_t, D, scr, r, lane); continue; } r -= I_UP;
                if (r < I_DN) { p0_transpose_item(a.w_down, nullptr, D, Wdn_t, DFF, scr, r, lane); continue; } r -= I_DN;
                if (r < I_IN) { p0_transpose_item(a.w_in, a.g_mix, INW, Win_t, D, scr, r, lane); continue; } r -= I_IN;
                if (r < I_SQ) { p0_transpose_item(a.w_ck, a.g_mem, D, Wckv_t, D, scr, r, lane); continue; } r -= I_SQ;
                if (r < I_SQ) { p0_transpose_item(a.w_cv, a.g_mem, D, Wckv_t + (size_t)D * D, D, scr, r, lane); continue; } r -= I_SQ;
                if (r < I_SQ) { p0_transpose_item(a.w_cq, a.g_cross, D, Wcq_t, D, scr, r, lane); continue; } r -= I_SQ;
                if (r < I_SQ) { p0_transpose_item(a.w_co, nullptr, D, Wco_t, D, scr, r, lane); continue; } r -= I_SQ;
                if (r < I_O) { p0_transpose_item(a.w_out, nullptr, D, Wo2_t, D, scr, r, lane); continue; } r -= I_O;
                p0_transpose_item(a.w_out + (size_t)AW * D, nullptr, D, WoB_t, PW, scr, r, lane);
            }
        }
        for (size_t i = gt; i < (size_t)PW * PW / 8; i += GT) {
            const int cc = (int)(i / (PW / 8)), e0 = (int)(i % (PW / 8)) * 8, g = cc / 128;
            u32x4 w = (u32x4){0u, 0u, 0u, 0u};
            if (e0 / 128 == g) { const float* wp = a.w_pool + (size_t)cc * 128 + (e0 & 127); const float* sc = a.pool_scale + e0;
                const f32x4 w0 = *(const f32x4*)wp * *(const f32x4*)sc, w1 = *(const f32x4*)(wp + 4) * *(const f32x4*)(sc + 4);
                w = (u32x4){pk2(w0[0], w0[1]), pk2(w0[2], w0[3]), pk2(w1[0], w1[1]), pk2(w1[2], w1[3])}; }
            *(u32x4*)(BDm + (size_t)cc * PW + e0) = w;
        }
        norm_rows(a.x_prompt, XN0, MP, gw, NGW, lane);
        norm_rows(a.x_sample, XN0 + (size_t)MP * D, MS, gw, NGW, lane);
        norm_rows(a.mem_prompt, HM, BATCH * NMEM, gw, NGW, lane);
        for (size_t i = gt; i < (size_t)DEC_B * (WIN - DEC_T) * KVW; i += GT) {
            const int b = (int)(i / ((WIN - DEC_T) * KVW)), r = (int)(i % ((WIN - DEC_T) * KVW));
            a.out[O_WKS + (size_t)b * WIN * KVW + r] = a.cache_win_k[(size_t)b * WIN * KVW + DEC_T * KVW + r];
            a.out[O_WVS + (size_t)b * WIN * KVW + r] = a.cache_win_v[(size_t)b * WIN * KVW + DEC_T * KVW + r];
        }
        for (size_t i = gt; i < (size_t)DEC_B * (PHIST - DEC_T) * PW; i += GT) {
            const int b = (int)(i / ((PHIST - DEC_T) * PW)), r = (int)(i % ((PHIST - DEC_T) * PW));
            a.out[O_PS + (size_t)b * PHIST * PW + r] = a.state_pool[(size_t)b * PHIST * PW + DEC_T * PW + r];
        }
    }
    SEAM(0);
    if (IN(1)) {
        pg8::SegOrder<3> S{}; S.G = G; S.c = bx; S.pa = (size_t)256 * D * 2; S.pb = (size_t)256 * D * 2;
        S.s[0] = pg8::Seg{XN0, Win_t, M / 256, INW / 256, 0};
        S.s[1] = pg8::Seg{HM, Wckv_t, BATCH * NMEM / 256, 2 * D / 256, 1};
        S.s[2] = pg8::Seg{Wckv_t + (size_t)D * D, HM, D / 256, BATCH, 2};
        pg8::gemm_phase<pg8::EpiP1, pg8::SegOrder<3>, true, true>(L, D, D, D, S, pg8::EpiP1{Qb, Kb, Vb, Ub, MK, MV, MVt, a.out});
        if (bx >= G - 8) {
            pg8::SegOrder<1> S2{}; S2.G = 8; S2.c = bx - (G - 8); S2.pa = (size_t)256 * PW * 2; S2.pb = (size_t)256 * PW * 2;
            S2.s[0] = pg8::Seg{WoB_t, BDm, D / 256, PW / 256, 0};
            pg8::gemm_phase<pg8::EpiStoreBf16, pg8::SegOrder<1>, true, true>(L, PW, PW, PW, S2, pg8::EpiStoreBf16{Wo2_t + AW});
        }
    }
    SEAM(1);
    if (IN(2)) {
        LOCAL_IDS
        for (int unit = bx; unit < BATCH * NKV * (SEQ / 64); unit += G) win_attn_unit(Qb, Kb, Vb, A2, a.attn_sinks, unit, L);
        if (wave == 0) for (int task = bx; task < DEC_B * NKV; task += G) win_attn_sample(Qb, Kb, Vb, a.cache_win_k, a.cache_win_v, A2, a.attn_sinks, task, L, lane);
        pool_diff(Ub, a.state_pool, A2, gt, GT);
    }
    SEAM(2);
    if (IN(3)) {
        pg8::SegOrder<1> S{}; S.G = G; S.c = bx; S.pa = (size_t)256 * D * 2; S.pb = (size_t)256 * D * 2;
        S.s[0] = pg8::Seg{A2, Wo2_t, MP / 256, D / 256, 0};
        pg8::gemm_phase<pg8::EpiResidG, pg8::SegOrder<1>, true, true>(L, D, D, D, S, pg8::EpiResidG{a.x_prompt, a.x_sample - (size_t)MP * D, X, XB, rss1});
        gemm_mini(A2 + (size_t)MP * D, D, Wo2_t, D, MS, D, D, L, MiniResid{a.x_sample, X + (size_t)MP * D, XB + (size_t)MP * D, rss1 + (size_t)MP * 16});
    }
    SEAM(3);
    if (IN(4)) {
        pg8::SegOrder<1> S{}; S.G = G; S.c = bx; S.pa = (size_t)256 * D * 2; S.pb = (size_t)256 * D * 2;
        S.s[0] = pg8::Seg{XB, Wcq_t, MP / 256, D / 256, 0};
        pg8::gemm_phase<pg8::EpiRowScaleG<0>, pg8::SegOrder<1>, true, true>(L, D, D, D, S, pg8::EpiRowScaleG<0>{CQ, D, rss1, (1.0f / 16.0f) * LOG2E});
        gemm_mini(XB + (size_t)MP * D, D, Wcq_t, D, MS, D, D, L, MiniRowScale<0>{CQ + (size_t)MP * D, D, rss1 + (size_t)MP * 16, (1.0f / 16.0f) * LOG2E});
    }
    SEAM(4);
    if (IN(5)) {
        bf16_t* Pb = (bf16_t*)(ws + WS_P);
        const bool sample_first = ((bx >> 3) & 1) != 0;
        if (sample_first) for (int t0 = 2 * bx; t0 < DEC_B * NCH; t0 += 2 * G) cross_sample_pair(a.cache_mem_k, a.cache_mem_v, CQ, OC, t0, DEC_B * NCH, L);
        for (int Lu = bx; Lu < BATCH * NCH * (SEQ / 256); Lu += G) {
            const int xc = Lu & 7, idx = Lu >> 3, bh = xc * 2 + (idx >> 4), qp = idx & 15, b = bh >> 2, h = bh & 3;
            pg8::OneUnit S1; S1.u.pm = b * (SEQ / 256) + qp; S1.u.pn = h; S1.u.kind = 0;
            S1.u.a = (const char*)(CQ + ((size_t)(b * SEQ + qp * 256)) * D + h * CHD); S1.u.b = (const char*)(MK + (size_t)(b * NMEM) * D + h * CHD);
            pg8::gemm_phase<pg8::EpiSoftmaxP, pg8::OneUnit, false, true>(L, D, D, CHD, S1, pg8::EpiSoftmaxP{Pb});
            asm volatile("s_waitcnt vmcnt(0)" ::: "memory"); __syncthreads();
            pg8::OneUnit S2; S2.u.pm = S1.u.pm; S2.u.pn = h; S2.u.kind = 0;
            S2.u.a = (const char*)(Pb + ((size_t)(b * SEQ + qp * 256)) * D + h * CHD); S2.u.b = (const char*)(MVt + ((size_t)b * D + h * CHD) * NMEM);
            pg8::gemm_phase<pg8::EpiStoreBf16, pg8::OneUnit, true, true>(L, D, NMEM, NMEM, S2, pg8::EpiStoreBf16{OC});
            __syncthreads();
        }
        if (!sample_first) for (int t0 = 2 * bx; t0 < DEC_B * NCH; t0 += 2 * G) cross_sample_pair(a.cache_mem_k, a.cache_mem_v, CQ, OC, t0, DEC_B * NCH, L);
    }
    SEAM(5);
    if (IN(6)) {
        pg8::SegOrder<1> S{}; S.G = G; S.c = bx; S.pa = (size_t)256 * D * 2; S.pb = (size_t)256 * D * 2;
        S.s[0] = pg8::Seg{OC, Wco_t, MP / 256, D / 256, 0};
        pg8::gemm_phase<pg8::EpiResidG, pg8::SegOrder<1>, true, true>(L, D, D, D, S, pg8::EpiResidG{X, X, X, XB, rss2});
        gemm_mini(OC + (size_t)MP * D, D, Wco_t, D, MS, D, D, L, MiniResid{X + (size_t)MP * D, X + (size_t)MP * D, XB + (size_t)MP * D, rss2 + (size_t)MP * 16});
    }
    SEAM(6);
    if (IN(7)) {
        pg8::SegOrder<1> S{}; S.G = G; S.c = bx; S.pa = (size_t)256 * D * 2; S.pb = (size_t)256 * D * 2;
        S.s[0] = pg8::Seg{XB, Wup_t, MP / 256, DFF / 256, 0};
        pg8::gemm_phase<pg8::EpiRowScaleG<1>, pg8::SegOrder<1>, true, true>(L, D, D, D, S, pg8::EpiRowScaleG<1>{Hb, DFF, rss2, 1.0f});
        gemm_mini(XB + (size_t)MP * D, D, Wup_t, D, MS, DFF, D, L, MiniRowScale<1>{Hb + (size_t)MP * DFF, DFF, rss2 + (size_t)MP * 16, 1.0f});
    }
    SEAM(7);
    if (IN(8)) {
        pg8::SegOrder<1> S{}; S.G = G; S.c = bx; S.pa = (size_t)256 * DFF * 2; S.pb = (size_t)256 * DFF * 2;
        S.s[0] = pg8::Seg{Hb, Wdn_t, MP / 256, D / 256, 0};
        pg8::gemm_phase<pg8::EpiResidG, pg8::SegOrder<1>, true, true>(L, DFF, DFF, DFF, S, pg8::EpiResidG{X, X, X, nullptr, rss3});
        gemm_mini(Hb + (size_t)MP * DFF, DFF, Wdn_t, DFF, MS, D, DFF, L, MiniResid{X + (size_t)MP * D, X + (size_t)MP * D, nullptr, rss3 + (size_t)MP * 16});
    }
    SEAM(8);
    if (IN(9)) {
        LOCAL_IDS
        for (int r = gw; r < M; r += NGW) {
            const float rs = rstd_from_slots(rss3, r);
            f32x4* xr = (f32x4*)(X + (size_t)r * D) + lane; const f32x4* gp = (const f32x4*)a.g_final + lane;
#pragma unroll
            for (int j = 0; j < 4; ++j) xr[64 * j] = xr[64 * j] * rs * gp[64 * j];
        }
    }
#undef IN
#undef SEAM
}

constexpr int N_PHASES = 10;
extern "C" void kernel_launch(void* const* d_in, const int* in_sizes, int n_in, void* d_out, int out_size, void* d_ws, size_t ws_size, hipStream_t stream) {
    static int grid = 0;
    if (grid == 0) {
        if (n_in != 24 || in_sizes[0] != MP * D || out_size != (int)O_END || ws_size < WS_END) {
            fprintf(stderr, "kernel_launch: unexpected shapes: n_in %d in0 %d out %d ws %zu (need %zu)\n", n_in, n_in > 0 ? in_sizes[0] : -1, out_size, ws_size, (size_t)WS_END); grid = -1; return; }
        int dev = 0, cus = 0, per_cu = 0;
        if (hipGetDevice(&dev) != hipSuccess || hipDeviceGetAttribute(&cus, hipDeviceAttributeMultiprocessorCount, dev) != hipSuccess) { grid = -1; return; }
        if (hipFuncSetAttribute((const void*)fwd, hipFuncAttributeMaxDynamicSharedMemorySize, LDS_BYTES) != hipSuccess) { fprintf(stderr, "kernel_launch: hipFuncSetAttribute failed\n"); grid = -1; return; }
        if (hipOccupancyMaxActiveBlocksPerMultiprocessor(&per_cu, (const void*)fwd, NTHREADS, LDS_BYTES) != hipSuccess || per_cu < 1) { fprintf(stderr, "kernel_launch: occupancy query says %d\n", per_cu); grid = -1; (void)hipGetLastError(); return; }
        grid = cus;
    }
    if (grid < 0) return;
    (void)hipMemsetAsync((char*)d_ws + WS_CTL, 0, CTL_ZERO_BYTES, stream);
    Args a{};
    const float** p = (const float**)&a;
    for (int i = 0; i < 24; ++i) p[i] = (const float*)d_in[i];
    a.out = (float*)d_out; a.ws = (unsigned char*)d_ws;
    if (MK_N_LAUNCHES == 1) { a.ph_lo = 0; a.ph_hi = N_PHASES; hipLaunchKernelGGL(fwd, dim3(grid), dim3(NTHREADS), LDS_BYTES, stream, a); }
    else for (int ph = 0; ph < N_PHASES; ++ph) { a.ph_lo = ph; a.ph_hi = ph + 1; hipLaunchKernelGGL(fwd, dim3(grid), dim3(NTHREADS), LDS_BYTES, stream, a); }
}
```
